# Optimizing an MI355X kernel written in HIP

```python
import math
import jax, jax.numpy as jnp
from jax import lax
import numpy as np

D_MODEL = 1024
BATCH = 2
SEQ = 16384
DEPTH = 2

HEAD_DIM = 64
N_Q_HEADS = D_MODEL // HEAD_DIM
N_KV_HEADS = 4
GQA_REP = N_Q_HEADS // N_KV_HEADS
ROPE_DIM = HEAD_DIM // 4
ROPE_THETA = 500000.0
ATTN_SCALE = HEAD_DIM ** -0.5
Q_BLOCK = 128
KV_COLS = N_KV_HEADS * HEAD_DIM
N_BRANCH = 3
CMP_LEN = 32
CMP_STRIDE = 16
CMP_HIDDEN = 256
SEL_LEN = 64
N_SELECT = 16
WIN_LEN = 512
FORCE_SCORE = 1.0e4
NSA_COLS = D_MODEL + N_BRANCH * 2 * KV_COLS + N_Q_HEADS * N_BRANCH
DIL_PATTERNS = ((128, 1), (512, 4), (2048, 16))
DIL_BLOCK = 128
DIL_COLS = D_MODEL + len(DIL_PATTERNS) * 2 * KV_COLS
N_EXPERTS = 32
N_GROUPS = 4
EXPERTS_PER_GROUP = N_EXPERTS // N_GROUPS
TOP_K = 2
D_EXPERT = 512
MOE_BLOCK = 128
DN_ALPHA = (2.0 * DEPTH) ** 0.25
DN_BETA = (8.0 * DEPTH) ** -0.25
LN_EPS = 1e-5
N_A = (DEPTH + 1) // 2
N_B = DEPTH // 2

kernel_name = 'hybrid_nsa_dilated_grouped_moe_deepnorm'


def layer_norm(x, g, b):
    xf = x.astype(jnp.float32)
    mu = xf.mean(-1, keepdims=True)
    var = jnp.square(xf - mu).mean(-1, keepdims=True)
    return ((xf - mu) * lax.rsqrt(var + LN_EPS) * g.astype(jnp.float32) + b.astype(jnp.float32)).astype(x.dtype)


def partial_rope(t, pos):
    half = ROPE_DIM // 2
    inv = ROPE_THETA ** (-jnp.arange(half, dtype=jnp.float32) * (2.0 / ROPE_DIM))
    ang = pos.astype(jnp.float32)[:, :, None, None] * inv
    cos, sin = jnp.cos(ang), jnp.sin(ang)
    tf = t.astype(jnp.float32)
    t1, t2, rest = tf[..., :half], tf[..., half:ROPE_DIM], tf[..., ROPE_DIM:]
    return jnp.concatenate([t1 * cos - t2 * sin, t1 * sin + t2 * cos, rest], -1).astype(t.dtype)


def masked_softmax(s, mask):
    s = jnp.where(mask, s.astype(jnp.float32), -jnp.inf)
    m = jnp.max(s, axis=-1, keepdims=True)
    m = jnp.where(jnp.isfinite(m), m, 0.0)
    e = jnp.where(mask, jnp.exp(s - m), 0.0)
    return e / jnp.maximum(e.sum(-1, keepdims=True), 1e-30)


def nsa_mixer(h, positions, w_in, pos_k, w1_k, w2_k, pos_v, w1_v, w2_v, w_o):
    B, S, _ = h.shape
    G, R, E, H = N_KV_HEADS, GQA_REP, HEAD_DIM, N_Q_HEADS
    proj = h @ w_in
    q = partial_rope(proj[..., :D_MODEL].reshape(B, S, H, E), positions)
    kv = proj[..., D_MODEL:D_MODEL + N_BRANCH * 2 * KV_COLS].reshape(B, S, N_BRANCH, 2, G, E)
    gate = jax.nn.sigmoid(proj[..., D_MODEL + N_BRANCH * 2 * KV_COLS:].astype(jnp.float32)).reshape(B, S, H, N_BRANCH)

    n_cmp = (S - CMP_LEN) // CMP_STRIDE + 1
    blk_idx = jnp.arange(n_cmp)[:, None] * CMP_STRIDE + jnp.arange(CMP_LEN)[None, :]

    def compress(t, pos_emb, w1, w2):
        blocks = t[:, blk_idx] + pos_emb[:, None, :]
        flat = blocks.transpose(0, 1, 3, 2, 4).reshape(B, n_cmp, G, CMP_LEN * E)
        return jax.nn.gelu(flat @ w1) @ w2

    cmp_end = blk_idx[:, -1]
    kc = partial_rope(compress(kv[:, :, 0, 0], pos_k, w1_k, w2_k), positions[:, cmp_end])
    vc = compress(kv[:, :, 0, 1], pos_v, w1_v, w2_v)

    n_sel = S // SEL_LEN
    k_top = min(N_SELECT, n_sel)
    ksb = partial_rope(kv[:, :, 1, 0], positions).reshape(B, n_sel, SEL_LEN, G, E).transpose(0, 3, 1, 2, 4)
    vsb = kv[:, :, 1, 1].reshape(B, n_sel, SEL_LEN, G, E).transpose(0, 3, 1, 2, 4)
    cs = jnp.arange(n_cmp) * CMP_STRIDE
    ss = jnp.arange(n_sel) * SEL_LEN
    overlap = ((cs[:, None] < ss[None, :] + SEL_LEN) & (cs[:, None] + CMP_LEN > ss[None, :])).astype(jnp.float32)

    pad = ((0, 0), (WIN_LEN, 0), (0, 0), (0, 0))
    kwp = jnp.pad(partial_rope(kv[:, :, 2, 0], positions), pad)
    vwp = jnp.pad(kv[:, :, 2, 1], pad)

    nqb = S // Q_BLOCK
    q_blocks = q.reshape(B, nqb, Q_BLOCK, G, R, E).transpose(1, 0, 2, 3, 4, 5)
    g_blocks = gate.reshape(B, nqb, Q_BLOCK, H, N_BRANCH).transpose(1, 0, 2, 3, 4)
    bi = jnp.arange(B)[:, None, None, None]
    gi = jnp.arange(G)[None, :, None, None]
    cmp_last = cs + CMP_LEN - 1
    sel_ids = jnp.arange(n_sel)

    def block_fn(args):
        qb_idx, qb, gb = args
        t = qb_idx * Q_BLOCK + jnp.arange(Q_BLOCK)
        s_c = jnp.einsum('bqgre,bnge->bgrqn', qb, kc) * ATTN_SCALE
        p_c = masked_softmax(s_c, cmp_last[None, :] <= t[:, None])
        o_c = jnp.einsum('bgrqn,bnge->bqgre', p_c.astype(vc.dtype), vc)
        imp = jnp.einsum('bgrqn,ns->bgqs', p_c, overlap)
        cur = t // SEL_LEN
        forced = (sel_ids[None, :] == 0) | (sel_ids[None, :] == cur[:, None]) | (sel_ids[None, :] == cur[:, None] - 1)
        imp = jnp.where(forced, FORCE_SCORE, imp)
        imp = jnp.where(sel_ids[None, :] <= cur[:, None], imp, -jnp.inf)
        _, idx = lax.top_k(imp, k_top)
        ks = ksb[bi, gi, idx]
        vs = vsb[bi, gi, idx]
        s_s = jnp.einsum('bqgre,bgqjle->bgrqjl', qb, ks) * ATTN_SCALE
        tok = idx[..., None] * SEL_LEN + jnp.arange(SEL_LEN)
        valid_s = (tok <= t[None, None, :, None, None]).reshape(B, G, 1, Q_BLOCK, k_top * SEL_LEN)
        p_s = masked_softmax(s_s.reshape(B, G, R, Q_BLOCK, k_top * SEL_LEN), valid_s)
        p_s = p_s.reshape(B, G, R, Q_BLOCK, k_top, SEL_LEN)
        o_s = jnp.einsum('bgrqjl,bgqjle->bqgre', p_s.astype(vs.dtype), vs)
        kw = lax.dynamic_slice_in_dim(kwp, qb_idx * Q_BLOCK, WIN_LEN + Q_BLOCK, axis=1)
        vw = lax.dynamic_slice_in_dim(vwp, qb_idx * Q_BLOCK, WIN_LEN + Q_BLOCK, axis=1)
        kpos = qb_idx * Q_BLOCK - WIN_LEN + jnp.arange(WIN_LEN + Q_BLOCK)
        dist = t[:, None] - kpos[None, :]
        valid_w = (dist >= 0) & (dist < WIN_LEN) & (kpos[None, :] >= 0)
        s_w = jnp.einsum('bqgre,bkge->bgrqk', qb, kw) * ATTN_SCALE
        p_w = masked_softmax(s_w, valid_w)
        o_w = jnp.einsum('bgrqk,bkge->bqgre', p_w.astype(vw.dtype), vw)
        o = (o_c.reshape(B, Q_BLOCK, H, E) * gb[..., 0:1]
             + o_s.reshape(B, Q_BLOCK, H, E) * gb[..., 1:2]
             + o_w.reshape(B, Q_BLOCK, H, E) * gb[..., 2:3])
        return o.reshape(B, Q_BLOCK, D_MODEL).astype(h.dtype)

    outs = lax.map(block_fn, (jnp.arange(nqb), q_blocks, g_blocks))
    return outs.transpose(1, 0, 2, 3).reshape(B, S, D_MODEL) @ w_o


def dilated_band_attention(q, k, v, dil, steps):
    B, S, G, R, E = q.shape
    L = S // dil
    nb = -(-L // DIL_BLOCK)
    pad = nb * DIL_BLOCK - L
    qd = q.reshape(B, L, dil, G, R, E).transpose(0, 2, 3, 4, 1, 5)
    kd = k.reshape(B, L, dil, G, E).transpose(0, 2, 3, 1, 4)
    vd = v.reshape(B, L, dil, G, E).transpose(0, 2, 3, 1, 4)
    qd = jnp.pad(qd, ((0, 0),) * 4 + ((0, pad), (0, 0)))
    kd = jnp.pad(kd, ((0, 0),) * 3 + ((0, pad), (0, 0)))
    vd = jnp.pad(vd, ((0, 0),) * 3 + ((0, pad), (0, 0)))
    qb = qd.reshape(B, dil, G, R, nb, DIL_BLOCK, E)
    kb = kd.reshape(B, dil, G, nb, DIL_BLOCK, E)
    vb = vd.reshape(B, dil, G, nb, DIL_BLOCK, E)
    prev = ((0, 0), (0, 0), (0, 0), (1, 0), (0, 0), (0, 0))
    kk = jnp.concatenate([jnp.pad(kb, prev)[:, :, :, :-1], kb], axis=-2)
    vv = jnp.concatenate([jnp.pad(vb, prev)[:, :, :, :-1], vb], axis=-2)
    qi = jnp.arange(DIL_BLOCK)
    kj = jnp.arange(2 * DIL_BLOCK)
    dist = DIL_BLOCK + qi[:, None] - kj[None, :]
    key_sub = (jnp.arange(nb)[:, None, None] - 1) * DIL_BLOCK + kj[None, None, :]
    valid = (dist >= 0) & (dist <= steps) & (key_sub >= 0)
    s = jnp.einsum('bdgrnqe,bdgnke->bdgrnqk', qb, kk).astype(jnp.float32) * ATTN_SCALE
    s = jnp.where(valid, s, -jnp.inf)
    m = jnp.max(s, axis=-1)
    e = jnp.where(valid, jnp.exp(s - m[..., None]), 0.0)
    l = e.sum(-1)
    o = jnp.einsum('bdgrnqk,bdgnke->bdgrnqe', e, vv.astype(jnp.float32)) / l[..., None]
    o = o.reshape(B, dil, G, R, nb * DIL_BLOCK, E)[:, :, :, :, :L]
    o = o.transpose(0, 4, 1, 2, 3, 5).reshape(B, S, G, R, E)
    m = m.reshape(B, dil, G, R, nb * DIL_BLOCK)[..., :L].transpose(0, 4, 1, 2, 3).reshape(B, S, G, R)
    l = l.reshape(B, dil, G, R, nb * DIL_BLOCK)[..., :L].transpose(0, 4, 1, 2, 3).reshape(B, S, G, R)
    return o, m, l


def dilated_mixer(h, positions, w_in, w_o):
    B, S, _ = h.shape
    G, R, E = N_KV_HEADS, GQA_REP, HEAD_DIM
    proj = h @ w_in
    q = partial_rope(proj[..., :D_MODEL].reshape(B, S, N_Q_HEADS, E), positions).reshape(B, S, G, R, E)
    kv = proj[..., D_MODEL:].reshape(B, S, len(DIL_PATTERNS), 2, G, E)
    outs, maxes, dens = [], [], []
    for p, (window, dil) in enumerate(DIL_PATTERNS):
        o, m, l = dilated_band_attention(q, partial_rope(kv[:, :, p, 0], positions), kv[:, :, p, 1], dil, window // dil)
        outs.append(o)
        maxes.append(m)
        dens.append(l)
    m_all = jnp.stack(maxes, 0)
    w = jnp.stack(dens, 0) * jnp.exp(m_all - m_all.max(0))
    w = w / w.sum(0)
    o = jnp.einsum('pbsgr,pbsgre->bsgre', w, jnp.stack(outs, 0))
    return o.reshape(B, S, D_MODEL).astype(h.dtype) @ w_o


def moe_ffn(h, router_w, router_b, w_gate, w_up, w_down):
    B, S, D = h.shape
    N = B * S
    xt = h.reshape(N, D)
    scores = jax.nn.sigmoid((xt @ router_w).astype(jnp.float32))
    grp = (scores + router_b.astype(jnp.float32)).reshape(N, N_GROUPS, EXPERTS_PER_GROUP)
    best = jnp.argmax(lax.top_k(grp, TOP_K)[0].sum(-1), axis=-1)
    in_grp = jnp.arange(N_GROUPS)[None, :] == best[:, None]
    masked = jnp.where(in_grp[:, :, None], grp, -jnp.inf).reshape(N, N_EXPERTS)
    _, eidx = lax.top_k(masked, TOP_K)
    wt = jnp.take_along_axis(scores, eidx, -1)
    wt = wt / wt.sum(-1, keepdims=True)
    A = N * TOP_K
    e_flat = eidx.reshape(A)
    tok_flat = jnp.repeat(jnp.arange(N, dtype=jnp.int32), TOP_K)
    w_flat = wt.reshape(A)
    order = jnp.argsort(e_flat)
    e_sorted = e_flat[order]
    counts = jnp.bincount(e_flat, length=N_EXPERTS)
    starts = jnp.cumsum(counts) - counts
    padded = (counts + MOE_BLOCK - 1) // MOE_BLOCK * MOE_BLOCK
    pad_ends = jnp.cumsum(padded)
    pad_starts = pad_ends - padded
    dest = pad_starts[e_sorted] + jnp.arange(A) - starts[e_sorted]
    n_rows = A + N_EXPERTS * MOE_BLOCK
    n_blk = n_rows // MOE_BLOCK
    row_tok = jnp.zeros((n_rows,), jnp.int32).at[dest].set(tok_flat[order])
    row_w = jnp.zeros((n_rows,), jnp.float32).at[dest].set(w_flat[order])
    blk_exp = jnp.minimum(jnp.searchsorted(pad_ends, jnp.arange(n_blk) * MOE_BLOCK, side='right'), N_EXPERTS - 1)
    xs = xt[row_tok].reshape(n_blk, MOE_BLOCK, D)

    def expert_block(args):
        xb, e = args
        return (jax.nn.silu(xb @ w_gate[e]) * (xb @ w_up[e])) @ w_down[e]

    ys = lax.map(expert_block, (xs, blk_exp)).reshape(n_rows, D)
    out = jnp.zeros((N, D), h.dtype).at[row_tok].add(ys * row_w[:, None].astype(ys.dtype))
    return out.reshape(B, S, D)


def setup_inputs(seed: int = 0) -> dict:
    key = jax.random.key(seed)
    ks = jax.random.split(key, 24)
    nrm = jax.random.normal
    D, F = D_MODEL, D_EXPERT
    cmp_in = CMP_LEN * HEAD_DIM
    return {
        'x': nrm(ks[0], (BATCH, SEQ, D), jnp.float32),
        'c': nrm(ks[1], (BATCH, D), jnp.float32),
        'positions': (jnp.arange(SEQ, dtype=jnp.int32)[None, :]
                      + jax.random.randint(ks[2], (BATCH, 1), 0, 4096, dtype=jnp.int32)),
        'ada_w': nrm(ks[3], (DEPTH, 2, D, 3 * D), jnp.float32) * (0.5 * D ** -0.5),
        'ada_b': nrm(ks[4], (DEPTH, 2, 3 * D), jnp.float32) * 0.02,
        'ln_g': 1.0 + 0.02 * nrm(ks[5], (DEPTH, 2, D), jnp.float32),
        'ln_b': 0.02 * nrm(ks[6], (DEPTH, 2, D), jnp.float32),
        'nsa_w_in': nrm(ks[7], (N_A, D, NSA_COLS), jnp.float32) * D ** -0.5,
        'nsa_cmp_pos_k': 0.02 * nrm(ks[8], (N_A, CMP_LEN, HEAD_DIM), jnp.float32),
        'nsa_cmp_w1_k': nrm(ks[9], (N_A, cmp_in, CMP_HIDDEN), jnp.float32) * cmp_in ** -0.5,
        'nsa_cmp_w2_k': nrm(ks[10], (N_A, CMP_HIDDEN, HEAD_DIM), jnp.float32) * CMP_HIDDEN ** -0.5,
        'nsa_cmp_pos_v': 0.02 * nrm(ks[11], (N_A, CMP_LEN, HEAD_DIM), jnp.float32),
        'nsa_cmp_w1_v': nrm(ks[12], (N_A, cmp_in, CMP_HIDDEN), jnp.float32) * cmp_in ** -0.5,
        'nsa_cmp_w2_v': nrm(ks[13], (N_A, CMP_HIDDEN, HEAD_DIM), jnp.float32) * CMP_HIDDEN ** -0.5,
        'nsa_w_o': nrm(ks[14], (N_A, D, D), jnp.float32) * (D ** -0.5 * DN_BETA),
        'dil_w_in': nrm(ks[15], (N_B, D, DIL_COLS), jnp.float32) * D ** -0.5,
        'dil_w_o': nrm(ks[16], (N_B, D, D), jnp.float32) * (D ** -0.5 * DN_BETA),
        'router_w': nrm(ks[17], (D, N_EXPERTS), jnp.float32) * D ** -0.5,
        'router_b': 0.01 * nrm(ks[18], (N_EXPERTS,), jnp.float32),
        'moe_w_gate': nrm(ks[19], (DEPTH, N_EXPERTS, D, F), jnp.float32) * D ** -0.5,
        'moe_w_up': nrm(ks[20], (DEPTH, N_EXPERTS, D, F), jnp.float32) * D ** -0.5,
        'moe_w_down': nrm(ks[21], (DEPTH, N_EXPERTS, F, D), jnp.float32) * (F ** -0.5 * DN_BETA),
    }


def reference(x, c, positions, ada_w, ada_b, ln_g, ln_b,
              nsa_w_in, nsa_cmp_pos_k, nsa_cmp_w1_k, nsa_cmp_w2_k,
              nsa_cmp_pos_v, nsa_cmp_w1_v, nsa_cmp_w2_v, nsa_w_o,
              dil_w_in, dil_w_o,
              router_w, router_b, moe_w_gate, moe_w_up, moe_w_down):
    cond = jax.nn.silu(c)
    for i in range(DEPTH):
        mod = (cond @ ada_w[i, 0] + ada_b[i, 0])[:, None, :]
        shift, scale, gate = jnp.split(mod, 3, axis=-1)
        hmod = x * (1.0 + scale) + shift
        if i % 2 == 0:
            j = i // 2
            y = nsa_mixer(hmod, positions, nsa_w_in[j], nsa_cmp_pos_k[j], nsa_cmp_w1_k[j], nsa_cmp_w2_k[j],
                          nsa_cmp_pos_v[j], nsa_cmp_w1_v[j], nsa_cmp_w2_v[j], nsa_w_o[j])
        else:
            j = i // 2
            y = dilated_mixer(hmod, positions, dil_w_in[j], dil_w_o[j])
        x = layer_norm(DN_ALPHA * x + gate * y, ln_g[i, 0], ln_b[i, 0])
        mod = (cond @ ada_w[i, 1] + ada_b[i, 1])[:, None, :]
        shift, scale, gate = jnp.split(mod, 3, axis=-1)
        hmod = x * (1.0 + scale) + shift
        y = moe_ffn(hmod, router_w, router_b, moe_w_gate[i], moe_w_up[i], moe_w_down[i])
        x = layer_norm(DN_ALPHA * x + gate * y, ln_g[i, 1], ln_b[i, 1])
    return x
```

```cpp
#include <hip/hip_runtime.h>
#include <math.h>
#include <stdint.h>

#define D_MODEL 1024
#define BATCH 2
#define SEQ 16384
#define NTOK (BATCH * SEQ)
#define HEAD_DIM 64
#define NQH 16
#define NKV 4
#define KV_COLS 256
#define NSA_COLS 2608
#define DIL_COLS 2560
#define N_CMP 1023
#define N_EXPERTS 32
#define D_EXPERT 512
#define DN_ALPHA 1.41421356237309515f
#define LN_EPS 1e-5f
#define ATTN_SCALE 0.125f

__global__ void adaln_kernel(const float* __restrict__ c, const float* __restrict__ ada_w,
                             const float* __restrict__ ada_b, float* __restrict__ mod) {
  int idx = blockIdx.x * blockDim.x + threadIdx.x;
  if (idx >= 4 * BATCH * 3072) return;
  int col = idx % 3072;
  int b = (idx / 3072) % BATCH;
  int is = idx / (3072 * BATCH);
  const float* w = ada_w + (size_t)is * D_MODEL * 3072;
  float acc = 0.f;
  for (int k = 0; k < D_MODEL; ++k) {
    float cv = c[b * D_MODEL + k];
    float sv = cv / (1.f + expf(-cv));
    acc += sv * w[(size_t)k * 3072 + col];
  }
  mod[idx] = acc + ada_b[is * 3072 + col];
}

template <int MOD, int EPI>
__global__ void __launch_bounds__(256) sgemm_kernel(const float* __restrict__ A, int lda,
                                                    const float* __restrict__ W, int ldw, float* C,
                                                    int ldc, int M, int N, int K,
                                                    const float* __restrict__ modp,
                                                    const float* xin) {
  __shared__ float As[16][68];
  __shared__ float Bs[16][68];
  int tid = threadIdx.x;
  int tx = tid & 15, ty = tid >> 4;
  int m0 = blockIdx.y * 64, n0 = blockIdx.x * 64;
  float acc[4][4];
#pragma unroll
  for (int i = 0; i < 4; ++i)
#pragma unroll
    for (int j = 0; j < 4; ++j) acc[i][j] = 0.f;
  int arow = tid >> 2, ak = (tid & 3) * 4;
  int brow = tid >> 4, bcol = (tid & 15) * 4;
  int bb = (m0 / SEQ);
  for (int k0 = 0; k0 < K; k0 += 16) {
    float4 av = *(const float4*)(A + (size_t)(m0 + arow) * lda + k0 + ak);
    if (MOD) {
      const float* sh = modp + bb * 3072 + k0 + ak;
      const float* sc = sh + D_MODEL;
      av.x = av.x * (1.f + sc[0]) + sh[0];
      av.y = av.y * (1.f + sc[1]) + sh[1];
      av.z = av.z * (1.f + sc[2]) + sh[2];
      av.w = av.w * (1.f + sc[3]) + sh[3];
    }
    float4 bv = make_float4(0.f, 0.f, 0.f, 0.f);
    if (n0 + bcol < N) bv = *(const float4*)(W + (size_t)(k0 + brow) * ldw + n0 + bcol);
    __syncthreads();
    As[ak + 0][arow] = av.x;
    As[ak + 1][arow] = av.y;
    As[ak + 2][arow] = av.z;
    As[ak + 3][arow] = av.w;
    *(float4*)&Bs[brow][bcol] = bv;
    __syncthreads();
#pragma unroll
    for (int kk = 0; kk < 16; ++kk) {
      float4 a4 = *(const float4*)&As[kk][ty * 4];
      float4 b4 = *(const float4*)&Bs[kk][tx * 4];
      float a[4] = {a4.x, a4.y, a4.z, a4.w};
      float b[4] = {b4.x, b4.y, b4.z, b4.w};
#pragma unroll
      for (int i = 0; i < 4; ++i)
#pragma unroll
        for (int j = 0; j < 4; ++j) acc[i][j] += a[i] * b[j];
    }
  }
#pragma unroll
  for (int i = 0; i < 4; ++i) {
    int row = m0 + ty * 4 + i;
#pragma unroll
    for (int j = 0; j < 4; ++j) {
      int col = n0 + tx * 4 + j;
      if (col < N) {
        float v = acc[i][j];
        if (EPI == 1) {
          float g = modp[bb * 3072 + 2 * D_MODEL + col];
          v = DN_ALPHA * xin[(size_t)row * ldc + col] + g * v;
        }
        C[(size_t)row * ldc + col] = v;
      }
    }
  }
}

__device__ __forceinline__ void rope_pair(float& a, float& b, float ang) {
  float s, c;
  sincosf(ang, &s, &c);
  float na = a * c - b * s;
  float nb = a * s + b * c;
  a = na;
  b = nb;
}
__device__ __forceinline__ float rope_inv(int i) {
  return powf(500000.0f, -(float)i * 0.125f);
}

__global__ void postproj_kernel(float* P, int ld, const int* __restrict__ positions, int layer) {
  int tok = blockIdx.x;
  int tid = threadIdx.x;
  float pos = (float)positions[tok];
  float* row = P + (size_t)tok * ld;
  for (int idx = tid; idx < 40 * 8; idx += blockDim.x) {
    int chunk = idx >> 3, i = idx & 7;
    bool doit = chunk < 16;
    if (layer == 0)
      doit = doit || (chunk >= 24 && chunk < 28) || (chunk >= 32 && chunk < 36);
    else
      doit = doit || (chunk >= 16 && chunk < 20) || (chunk >= 24 && chunk < 28) || (chunk >= 32 && chunk < 36);
    if (!doit) continue;
    float ang = pos * rope_inv(i);
    rope_pair(row[chunk * 64 + i], row[chunk * 64 + 8 + i], ang);
  }
  if (layer == 0 && tid < 48) {
    float v = row[2560 + tid];
    row[2560 + tid] = 1.f / (1.f + expf(-v));
  }
}

__global__ void __launch_bounds__(256) compress_kernel(const float* __restrict__ P, const int* __restrict__ positions,
                                                       const float* __restrict__ pos_k, const float* __restrict__ w1_k,
                                                       const float* __restrict__ w2_k, const float* __restrict__ pos_v,
                                                       const float* __restrict__ w1_v, const float* __restrict__ w2_v,
                                                       float* __restrict__ kc, float* __restrict__ vc) {
  __shared__ float a[2048];
  __shared__ float h[256];
  __shared__ float o[64];
  int kv = blockIdx.y;
  int g = blockIdx.x % NKV;
  int n = (blockIdx.x / NKV) % N_CMP;
  int b = blockIdx.x / (NKV * N_CMP);
  const float* pe = kv ? pos_v : pos_k;
  const float* w1 = kv ? w1_v : w1_k;
  const float* w2 = kv ? w2_v : w2_k;
  int tid = threadIdx.x;
  for (int i = tid; i < 2048; i += 256) {
    int l = i >> 6, e = i & 63;
    a[i] = P[(size_t)(b * SEQ + 16 * n + l) * NSA_COLS + 1024 + kv * 256 + g * 64 + e] + pe[l * 64 + e];
  }
  __syncthreads();
  float acc = 0.f;
  for (int k = 0; k < 2048; ++k) acc += a[k] * w1[(size_t)k * 256 + tid];
  {
    float x = acc;
    float t = tanhf(0.7978845608028654f * (x + 0.044715f * x * x * x));
    h[tid] = 0.5f * x * (1.f + t);
  }
  __syncthreads();
  if (tid < 64) {
    float s = 0.f;
    for (int j = 0; j < 256; ++j) s += h[j] * w2[j * 64 + tid];
    o[tid] = s;
  }
  __syncthreads();
  if (kv == 0 && tid < 8) {
    float pos = (float)positions[b * SEQ + 16 * n + 31];
    rope_pair(o[tid], o[tid + 8], pos * rope_inv(tid));
  }
  __syncthreads();
  if (tid < 64) {
    float* dst = (kv ? vc : kc) + ((size_t)(b * N_CMP + n) * NKV + g) * 64;
    dst[tid] = o[tid];
  }
}

__device__ __forceinline__ float wave_max(float v) {
#pragma unroll
  for (int o = 32; o > 0; o >>= 1) v = fmaxf(v, __shfl_xor(v, o));
  return v;
}
__device__ __forceinline__ float wave_sum(float v) {
#pragma unroll
  for (int o = 32; o > 0; o >>= 1) v += __shfl_xor(v, o);
  return v;
}

__device__ __forceinline__ void dot4(const float (*q)[64], const float* __restrict__ kr, float s[4]) {
  s[0] = s[1] = s[2] = s[3] = 0.f;
#pragma unroll
  for (int e = 0; e < 64; e += 4) {
    float4 kvv = *(const float4*)(kr + e);
#pragma unroll
    for (int r = 0; r < 4; ++r)
      s[r] += q[r][e] * kvv.x + q[r][e + 1] * kvv.y + q[r][e + 2] * kvv.z + q[r][e + 3] * kvv.w;
  }
}

__device__ __forceinline__ void softmax_rows(float (*p)[1024], int n, int lane) {
  for (int r = 0; r < 4; ++r) {
    float m = -INFINITY;
    for (int i = lane; i < n; i += 64) m = fmaxf(m, p[r][i]);
    m = wave_max(m);
    if (m == -INFINITY) m = 0.f;
    float sum = 0.f;
    for (int i = lane; i < n; i += 64) {
      float v = p[r][i];
      float e = (v == -INFINITY) ? 0.f : expf(v - m);
      p[r][i] = e;
      sum += e;
    }
    sum = wave_sum(sum);
    float inv = 1.f / fmaxf(sum, 1e-30f);
    for (int i = lane; i < n; i += 64) p[r][i] *= inv;
  }
}

__global__ void __launch_bounds__(64) nsa_naive_kernel(const float* __restrict__ P, const float* __restrict__ kc,
                                                       const float* __restrict__ vc, float* __restrict__ out) {
  __shared__ float q[4][64];
  __shared__ float p[4][1024];
  __shared__ float imp[256];
  __shared__ int sel[16];
  int lane = threadIdx.x;
  int t = blockIdx.x % SEQ;
  int g = (blockIdx.x / SEQ) % NKV;
  int b = blockIdx.x / (SEQ * NKV);
  const float* prow = P + (size_t)(b * SEQ + t) * NSA_COLS;
  for (int r = 0; r < 4; ++r) q[r][lane] = prow[(g * 4 + r) * 64 + lane];
  __syncthreads();
  float oc[4], os[4], ow[4];
  int nvalid = t >= 31 ? (t - 31) / 16 + 1 : 0;
  for (int n = lane; n < 1024; n += 64) {
    if (n < nvalid) {
      float s[4];
      dot4(q, kc + ((size_t)(b * N_CMP + n) * NKV + g) * 64, s);
      for (int r = 0; r < 4; ++r) p[r][n] = s[r] * ATTN_SCALE;
    } else {
      for (int r = 0; r < 4; ++r) p[r][n] = -INFINITY;
    }
  }
  __syncthreads();
  softmax_rows(p, 1024, lane);
  __syncthreads();
  for (int r = 0; r < 4; ++r) oc[r] = 0.f;
  for (int n = 0; n < nvalid; ++n) {
    float v = vc[((size_t)(b * N_CMP + n) * NKV + g) * 64 + lane];
    for (int r = 0; r < 4; ++r) oc[r] += p[r][n] * v;
  }
  int cur = t >> 6;
  for (int i = 0; i < 4; ++i) {
    int s = lane + 64 * i;
    float v = 0.f;
    for (int r = 0; r < 4; ++r)
      for (int c = 4 * s - 1; c <= 4 * s + 3; ++c)
        if (c >= 0 && c < N_CMP) v += p[r][c];
    if (s == 0 || s == cur || s == cur - 1) v = 1.0e4f;
    if (s > cur) v = -INFINITY;
    imp[s] = v;
  }
  __syncthreads();
  int nsel = min(16, cur + 1);
  {
    float cv[4];
    for (int i = 0; i < 4; ++i) cv[i] = imp[lane + 64 * i];
    unsigned taken = 0;
    for (int round = 0; round < nsel; ++round) {
      float bv = -INFINITY;
      int bs = 1 << 30;
      for (int i = 0; i < 4; ++i) {
        int s = lane + 64 * i;
        if (!(taken & (1u << i)) && s <= cur) {
          if (cv[i] > bv || (cv[i] == bv && s < bs)) {
            bv = cv[i];
            bs = s;
          }
        }
      }
      for (int o = 32; o > 0; o >>= 1) {
        float ov = __shfl_xor(bv, o);
        int osx = __shfl_xor(bs, o);
        if (ov > bv || (ov == bv && osx < bs)) {
          bv = ov;
          bs = osx;
        }
      }
      if ((bs & 63) == lane) taken |= 1u << (bs >> 6);
      if (lane == 0) sel[round] = bs;
    }
  }
  __syncthreads();
  for (int jj = 0; jj < 16; ++jj) {
    bool ok = jj < nsel;
    int tok = ok ? sel[jj] * 64 + lane : 0;
    if (ok && tok <= t) {
      float s[4];
      dot4(q, P + (size_t)(b * SEQ + tok) * NSA_COLS + 1024 + 512 + g * 64, s);
      for (int r = 0; r < 4; ++r) p[r][jj * 64 + lane] = s[r] * ATTN_SCALE;
    } else {
      for (int r = 0; r < 4; ++r) p[r][jj * 64 + lane] = -INFINITY;
    }
  }
  __syncthreads();
  softmax_rows(p, 1024, lane);
  __syncthreads();
  for (int r = 0; r < 4; ++r) os[r] = 0.f;
  for (int jj = 0; jj < nsel; ++jj) {
    int base = sel[jj] * 64;
    for (int l = 0; l < 64; ++l) {
      int tok = base + l;
      if (tok > t) break;
      float v = P[(size_t)(b * SEQ + tok) * NSA_COLS + 1024 + 512 + 256 + g * 64 + lane];
      for (int r = 0; r < 4; ++r) os[r] += p[r][jj * 64 + l] * v;
    }
  }
  __syncthreads();
  for (int i = 0; i < 8; ++i) {
    int slot = lane + 64 * i;
    int tok = t - 511 + slot;
    if (tok >= 0) {
      float s[4];
      dot4(q, P + (size_t)(b * SEQ + tok) * NSA_COLS + 1024 + 1024 + g * 64, s);
      for (int r = 0; r < 4; ++r) p[r][slot] = s[r] * ATTN_SCALE;
    } else {
      for (int r = 0; r < 4; ++r) p[r][slot] = -INFINITY;
    }
  }
  __syncthreads();
  softmax_rows(p, 512, lane);
  __syncthreads();
  for (int r = 0; r < 4; ++r) ow[r] = 0.f;
  for (int slot = 0; slot < 512; ++slot) {
    int tok = t - 511 + slot;
    if (tok < 0) continue;
    float v = P[(size_t)(b * SEQ + tok) * NSA_COLS + 1024 + 1024 + 256 + g * 64 + lane];
    for (int r = 0; r < 4; ++r) ow[r] += p[r][slot] * v;
  }
  for (int r = 0; r < 4; ++r) {
    int h = g * 4 + r;
    float gc = prow[2560 + h * 3 + 0], gs = prow[2560 + h * 3 + 1], gw = prow[2560 + h * 3 + 2];
    out[(size_t)(b * SEQ + t) * D_MODEL + h * 64 + lane] = oc[r] * gc + os[r] * gs + ow[r] * gw;
  }
}

__global__ void __launch_bounds__(64) dil_naive_kernel(const float* __restrict__ P, float* __restrict__ out) {
  __shared__ float q[4][64];
  __shared__ float p[4][1024];
  int lane = threadIdx.x;
  int t = blockIdx.x % SEQ;
  int g = (blockIdx.x / SEQ) % NKV;
  int b = blockIdx.x / (SEQ * NKV);
  const float* prow = P + (size_t)(b * SEQ + t) * DIL_COLS;
  for (int r = 0; r < 4; ++r) q[r][lane] = prow[(g * 4 + r) * 64 + lane];
  __syncthreads();

  for (int slot = lane; slot < 387; slot += 64) {
    int pp = slot / 129, j = slot % 129;
    int dil = 1 << (2 * pp);
    int lq = t / dil;
    bool ok = (lq - j) >= 0;
    if (ok) {
      int tok = t - j * dil;
      float s[4];
      dot4(q, P + (size_t)(b * SEQ + tok) * DIL_COLS + 1024 + pp * 512 + g * 64, s);
      for (int r = 0; r < 4; ++r) p[r][slot] = s[r] * ATTN_SCALE;
    } else {
      for (int r = 0; r < 4; ++r) p[r][slot] = -INFINITY;
    }
  }
  __syncthreads();
  softmax_rows(p, 387, lane);
  __syncthreads();
  float o[4] = {0.f, 0.f, 0.f, 0.f};
  for (int slot = 0; slot < 387; ++slot) {
    int pp = slot / 129, j = slot % 129;
    int dil = 1 << (2 * pp);
    if (t / dil - j < 0) continue;
    int tok = t - j * dil;
    float v = P[(size_t)(b * SEQ + tok) * DIL_COLS + 1024 + pp * 512 + 256 + g * 64 + lane];
    for (int r = 0; r < 4; ++r) o[r] += p[r][slot] * v;
  }
  for (int r = 0; r < 4; ++r) out[(size_t)(b * SEQ + t) * D_MODEL + (g * 4 + r) * 64 + lane] = o[r];
}

template <int COMBINE, int ROUTE>
__global__ void __launch_bounds__(256) ln_kernel(float* X, const float* __restrict__ y0, const float* __restrict__ y1,
                                                 const float* __restrict__ modc,
                                                 const float* __restrict__ lng, const float* __restrict__ lnb,
                                                 const float* __restrict__ modr,
                                                 const float* __restrict__ router_w, const float* __restrict__ router_b,
                                                 int* __restrict__ eidx, float* __restrict__ ewt) {
  __shared__ float red[8];
  __shared__ float hm[D_MODEL];
  __shared__ float sc[32];
  int tok = blockIdx.x, tid = threadIdx.x;
  int b = tok / SEQ;
  float v[4];
  float* xr = X + (size_t)tok * D_MODEL;
  for (int i = 0; i < 4; ++i) {
    int col = tid + 256 * i;
    float u = xr[col];
    if (COMBINE) {
      float g = modc[b * 3072 + 2 * D_MODEL + col];
      u = DN_ALPHA * u + g * (y0[(size_t)tok * D_MODEL + col] + y1[(size_t)tok * D_MODEL + col]);
    }
    v[i] = u;
  }
  float s = v[0] + v[1] + v[2] + v[3];
  s = wave_sum(s);
  if ((tid & 63) == 0) red[tid >> 6] = s;
  __syncthreads();
  float mean = (red[0] + red[1] + red[2] + red[3]) * (1.f / D_MODEL);
  float d2 = 0.f;
  for (int i = 0; i < 4; ++i) {
    float d = v[i] - mean;
    d2 += d * d;
  }
  d2 = wave_sum(d2);
  if ((tid & 63) == 0) red[4 + (tid >> 6)] = d2;
  __syncthreads();
  float var = (red[4] + red[5] + red[6] + red[7]) * (1.f / D_MODEL);
  float rstd = rsqrtf(var + LN_EPS);
  for (int i = 0; i < 4; ++i) {
    int col = tid + 256 * i;
    float xn = (v[i] - mean) * rstd * lng[col] + lnb[col];
    xr[col] = xn;
    if (ROUTE) hm[col] = xn * (1.f + modr[b * 3072 + D_MODEL + col]) + modr[b * 3072 + col];
  }
  if (ROUTE) {
    __syncthreads();
    int e = tid & 31, part = tid >> 5;
    float acc = 0.f;
    for (int k = part * 128; k < part * 128 + 128; ++k) acc += hm[k] * router_w[k * 32 + e];
    __shared__ float parts[8][32];
    parts[part][e] = acc;
    __syncthreads();
    if (tid < 32) {
      float l = 0.f;
      for (int pq = 0; pq < 8; ++pq) l += parts[pq][tid];
      sc[tid] = 1.f / (1.f + expf(-l));
    }
    __syncthreads();
    if (tid == 0) {
      int best = 0;
      float bestv = -INFINITY;
      for (int gq = 0; gq < 4; ++gq) {
        float m1 = -INFINITY, m2 = -INFINITY;
        for (int j = 0; j < 8; ++j) {
          float x = sc[gq * 8 + j] + router_b[gq * 8 + j];
          if (x > m1) {
            m2 = m1;
            m1 = x;
          } else if (x > m2)
            m2 = x;
        }
        float gs = m1 + m2;
        if (gs > bestv) {
          bestv = gs;
          best = gq;
        }
      }
      int i1 = -1, i2 = -1;
      float v1 = -INFINITY, v2 = -INFINITY;
      for (int j = 0; j < 8; ++j) {
        float x = sc[best * 8 + j] + router_b[best * 8 + j];
        if (x > v1) {
          v2 = v1;
          i2 = i1;
          v1 = x;
          i1 = j;
        } else if (x > v2) {
          v2 = x;
          i2 = j;
        }
      }
      int e1 = best * 8 + i1, e2 = best * 8 + i2;
      float w1 = sc[e1], w2 = sc[e2];
      float inv = 1.f / (w1 + w2);
      eidx[tok * 2] = e1;
      eidx[tok * 2 + 1] = e2;
      ewt[tok * 2] = w1 * inv;
      ewt[tok * 2 + 1] = w2 * inv;
    }
  }
}

__global__ void __launch_bounds__(512) moe_naive_kernel(const float* __restrict__ X, const float* __restrict__ modr,
                                                        const int* __restrict__ eidx, const float* __restrict__ ewt,
                                                        const float* __restrict__ wg, const float* __restrict__ wu,
                                                        const float* __restrict__ wd, float* __restrict__ ypart) {
  __shared__ float hm[D_MODEL];
  __shared__ float hh[D_EXPERT];
  int tok = blockIdx.x >> 1, k = blockIdx.x & 1;
  int tid = threadIdx.x;
  int b = tok / SEQ;
  int e = eidx[tok * 2 + k];
  float w = ewt[tok * 2 + k];
  for (int col = tid; col < D_MODEL; col += 512)
    hm[col] = X[(size_t)tok * D_MODEL + col] * (1.f + modr[b * 3072 + D_MODEL + col]) + modr[b * 3072 + col];
  __syncthreads();
  const float* g = wg + (size_t)e * D_MODEL * D_EXPERT;
  const float* u = wu + (size_t)e * D_MODEL * D_EXPERT;
  float ag = 0.f, au = 0.f;
  for (int kk = 0; kk < D_MODEL; ++kk) {
    float x = hm[kk];
    ag += x * g[(size_t)kk * D_EXPERT + tid];
    au += x * u[(size_t)kk * D_EXPERT + tid];
  }
  hh[tid] = ag / (1.f + expf(-ag)) * au;
  __syncthreads();
  const float* d = wd + (size_t)e * D_EXPERT * D_MODEL;
  float a0 = 0.f, a1 = 0.f;
  for (int j = 0; j < D_EXPERT; ++j) {
    float h = hh[j];
    a0 += h * d[(size_t)j * D_MODEL + tid];
    a1 += h * d[(size_t)j * D_MODEL + 512 + tid];
  }
  float* yp = ypart + ((size_t)k * NTOK + tok) * D_MODEL;
  yp[tid] = a0 * w;
  yp[tid + 512] = a1 * w;
}

extern "C" void kernel_launch(void* const* d_in, const int* in_sizes, int n_in, void* d_out, int out_size,
                              void* d_ws, size_t ws_size, hipStream_t stream) {
  const float* x = (const float*)d_in[0];
  const float* c = (const float*)d_in[1];
  const int* positions = (const int*)d_in[2];
  const float* ada_w = (const float*)d_in[3];
  const float* ada_b = (const float*)d_in[4];
  const float* ln_g = (const float*)d_in[5];
  const float* ln_b = (const float*)d_in[6];
  const float* nsa_w_in = (const float*)d_in[7];
  const float* cmp_pos_k = (const float*)d_in[8];
  const float* cmp_w1_k = (const float*)d_in[9];
  const float* cmp_w2_k = (const float*)d_in[10];
  const float* cmp_pos_v = (const float*)d_in[11];
  const float* cmp_w1_v = (const float*)d_in[12];
  const float* cmp_w2_v = (const float*)d_in[13];
  const float* nsa_w_o = (const float*)d_in[14];
  const float* dil_w_in = (const float*)d_in[15];
  const float* dil_w_o = (const float*)d_in[16];
  const float* router_w = (const float*)d_in[17];
  const float* router_b = (const float*)d_in[18];
  const float* moe_wg = (const float*)d_in[19];
  const float* moe_wu = (const float*)d_in[20];
  const float* moe_wd = (const float*)d_in[21];
  float* X = (float*)d_out;

  char* ws = (char*)d_ws;
  size_t off = 0;
  auto carve = [&](size_t bytes) {
    void* p = ws + off;
    off += (bytes + 255) & ~(size_t)255;
    return p;
  };
  float* mod = (float*)carve((size_t)4 * BATCH * 3072 * 4);
  float* kc = (float*)carve((size_t)BATCH * N_CMP * NKV * 64 * 4);
  float* vc = (float*)carve((size_t)BATCH * N_CMP * NKV * 64 * 4);
  int* eidx = (int*)carve((size_t)NTOK * 2 * 4);
  float* ewt = (float*)carve((size_t)NTOK * 2 * 4);
  float* P = (float*)carve((size_t)NTOK * NSA_COLS * 4);
  float* A = (float*)carve((size_t)NTOK * D_MODEL * 4);
  float* ypart = P;

  adaln_kernel<<<(4 * BATCH * 3072 + 255) / 256, 256, 0, stream>>>(c, ada_w, ada_b, mod);
  for (int layer = 0; layer < 2; ++layer) {
    const float* mod_mix = mod + (size_t)(layer * 2 + 0) * BATCH * 3072;
    const float* mod_moe = mod + (size_t)(layer * 2 + 1) * BATCH * 3072;
    const float* xin = layer == 0 ? x : X;
    if (layer == 0) {
      sgemm_kernel<1, 0><<<dim3((NSA_COLS + 63) / 64, NTOK / 64), 256, 0, stream>>>(
          xin, D_MODEL, nsa_w_in, NSA_COLS, P, NSA_COLS, NTOK, NSA_COLS, D_MODEL, mod_mix, nullptr);
      postproj_kernel<<<NTOK, 256, 0, stream>>>(P, NSA_COLS, positions, 0);
      compress_kernel<<<dim3(BATCH * N_CMP * NKV, 2), 256, 0, stream>>>(P, positions, cmp_pos_k, cmp_w1_k, cmp_w2_k,
                                                                       cmp_pos_v, cmp_w1_v, cmp_w2_v, kc, vc);
      nsa_naive_kernel<<<BATCH * NKV * SEQ, 64, 0, stream>>>(P, kc, vc, A);
      sgemm_kernel<0, 1><<<dim3(D_MODEL / 64, NTOK / 64), 256, 0, stream>>>(A, D_MODEL, nsa_w_o, D_MODEL, X, D_MODEL,
                                                                          NTOK, D_MODEL, D_MODEL, mod_mix, xin);
    } else {
      sgemm_kernel<1, 0><<<dim3(DIL_COLS / 64, NTOK / 64), 256, 0, stream>>>(
          xin, D_MODEL, dil_w_in, DIL_COLS, P, DIL_COLS, NTOK, DIL_COLS, D_MODEL, mod_mix, nullptr);
      postproj_kernel<<<NTOK, 256, 0, stream>>>(P, DIL_COLS, positions, 1);
      dil_naive_kernel<<<BATCH * NKV * SEQ, 64, 0, stream>>>(P, A);
      sgemm_kernel<0, 1><<<dim3(D_MODEL / 64, NTOK / 64), 256, 0, stream>>>(A, D_MODEL, dil_w_o, D_MODEL, X, D_MODEL,
                                                                          NTOK, D_MODEL, D_MODEL, mod_mix, xin);
    }
    ln_kernel<0, 1><<<NTOK, 256, 0, stream>>>(X, nullptr, nullptr, nullptr, ln_g + (layer * 2 + 0) * D_MODEL,
                                               ln_b + (layer * 2 + 0) * D_MODEL, mod_moe, router_w, router_b, eidx, ewt);
    moe_naive_kernel<<<NTOK * 2, 512, 0, stream>>>(X, mod_moe, eidx, ewt,
                                                    moe_wg + (size_t)layer * N_EXPERTS * D_MODEL * D_EXPERT,
                                                    moe_wu + (size_t)layer * N_EXPERTS * D_MODEL * D_EXPERT,
                                                    moe_wd + (size_t)layer * N_EXPERTS * D_EXPERT * D_MODEL, ypart);
    ln_kernel<1, 0><<<NTOK, 256, 0, stream>>>(X, ypart, ypart + (size_t)NTOK * D_MODEL, mod_moe,
                                               ln_g + (layer * 2 + 1) * D_MODEL, ln_b + (layer * 2 + 1) * D_MODEL, nullptr,
                                               nullptr, nullptr, nullptr, nullptr);
  }
}
```

```cpp
#include <hip/hip_runtime.h>
#include <hip/hip_cooperative_groups.h>
#include <cstdio>
#include <cstdint>
namespace cg = cooperative_groups;
#ifndef PH_PRO
#define PH_PRO 1
#endif
#ifndef PH_PROJ
#define PH_PROJ 1
#endif
#ifndef PH_CMP
#define PH_CMP 1
#endif
#ifndef PH_NSA
#define PH_NSA 1
#endif
#ifndef PH_DIL
#define PH_DIL 1
#endif
#ifndef PH_WO
#define PH_WO 1
#endif
#ifndef PH_LNR
#define PH_LNR 1
#endif
#ifndef PH_SCAT
#define PH_SCAT 1
#endif
#ifndef PH_GU
#define PH_GU 1
#endif
#ifndef PH_DN
#define PH_DN 1
#endif
#ifndef PH_LNM
#define PH_LNM 1
#endif

namespace pg8 {
#define PG8_LAS __attribute__((address_space(3)))
typedef unsigned short bf16_t;
typedef short bf16x8 __attribute__((ext_vector_type(8)));
typedef float f32x4 __attribute__((ext_vector_type(4)));
typedef unsigned u32x4 __attribute__((ext_vector_type(4)));
constexpr int BM = 256, BK = 64, HALF = 128, HTB = HALF * BK * 2  , STAGE_BYTES = 8 * HTB, NXCD = 8, WGM = 8;

__host__ __device__ __forceinline__ int lds_byte(int r, int c) { const int st = (r >> 4) * 2 + (c >> 5), rr = r & 15, cc = c & 31, ob = rr * 64 + cc * 2; return st * 1024 + (ob ^ (((ob >> 9) & 1) << 5)); }
__host__ __device__ __forceinline__ void stage_rc(int b, int& R, int& C) { const int st = b / 1024, sb = b % 1024, swz = sb ^ (((sb >> 9) & 1) << 5); R = (st >> 1) * 16 + swz / 64; C = (st & 1) * 32 + (swz % 64) / 2; }
__host__ __device__ __forceinline__ int perm32(int rho) { const int n = rho >> 4, i = rho & 15; return 8 * (i >> 2) + 4 * n + (i & 3); }

struct Unit { int pm, pn; };
struct Gemm { const bf16_t* A; const bf16_t* Bt; };

struct StaticOrder {
    int nM, nN, nwg, G, c;
    __host__ __device__ void init(int M, int N, int G_, int c_) { nM = M / BM; nN = N / BM; nwg = nM * nN; G = G_; c = c_; }
    __host__ __device__ bool next(int i, Unit& u) const {
        const long L = (long)i * G + c; if (L >= nwg) return false;
        int wgid = (int)L; { const int q = nwg / NXCD, r = nwg % NXCD, xcd = wgid % NXCD, off = wgid / NXCD; wgid = (xcd < r ? xcd * (q + 1) : r * (q + 1) + (xcd - r) * q) + off; }
        const int nig = WGM * nN, gid = wgid / nig, fm = gid * WGM, gsz = (nM - fm) < WGM ? (nM - fm) : WGM;
        u.pm = fm + ((wgid % nig) % gsz); u.pn = (wgid % nig) / gsz; return true;
    }
    __device__ __forceinline__ void a_ready(const Unit&) const {}
    __device__ __forceinline__ void done(const Unit&) const {}
};

template <int LDA, int KK, class Epi, class Sched, bool ALIGN_EPI = false, bool SP2 = false>
__device__ __forceinline__ void gemm_phase(PG8_LAS unsigned char* lds, const Gemm g, const Sched& S, const Epi& E) {
    int tid_ = threadIdx.x; asm volatile("" : "+v"(tid_));
    const int tid = tid_, wid = __builtin_amdgcn_readfirstlane(tid >> 6), lane = tid & 63, wr = wid >> 2, wc = wid & 3, fr = lane & 15, fq = lane >> 4;
    constexpr int K = KK, nt = K / BK;
    unsigned voffA[2], voffB[2];
#pragma unroll
    for (int i = 0; i < 2; ++i) { int R, C; stage_rc(tid * 16 + i * 8192, R, C); const int Rb = Epi::PERM ? ((R & ~31) + perm32(R & 31)) : R;
        voffA[i] = (unsigned)(R * LDA + C) * 2u; voffB[i] = (unsigned)(Rb * K + C) * 2u; }
    constexpr size_t kstep = (size_t)(BK * 2);
    constexpr size_t hstepA = (size_t)HALF * LDA * 2, hstepB = (size_t)HALF * K * 2;
    constexpr size_t tstepA = 2 * hstepA, tstepB = 2 * hstepB;
    const unsigned ldsw = (unsigned)wid * 1024u;
    const int aoff = lds_byte(wr * 64 + fr, fq * 8), boff = lds_byte(wc * 32 + fr, fq * 8);
#define PG8_SA(b, h) (((b) * 2 + (h)) * HTB)
#define PG8_SB(b, h) ((4 + (b) * 2 + (h)) * HTB)
#define PG8_STAGE(bufoff, gbase, voff) do { _Pragma("unroll") for (int _i = 0; _i < 2; ++_i) \
        __builtin_amdgcn_global_load_lds((const unsigned*)((const char*)(gbase) + (voff)[_i]), (PG8_LAS unsigned*)(lds + (bufoff) + ldsw + _i * 8192), 16, 0, 0); } while (0)
#define PG8_LDA(dst, b, h) do { _Pragma("unroll") for (int m = 0; m < 4; ++m) _Pragma("unroll") for (int k = 0; k < 2; ++k) dst[m][k] = *(const PG8_LAS bf16x8*)(lds + PG8_SA(b, h) + aoff + m * 2048 + k * 1024); } while (0)
#define PG8_LDB(dst, b, h) do { _Pragma("unroll") for (int n = 0; n < 2; ++n) _Pragma("unroll") for (int k = 0; k < 2; ++k) dst[n][k] = *(const PG8_LAS bf16x8*)(lds + PG8_SB(b, h) + boff + n * 2048 + k * 1024); } while (0)
#define PG8_MMA(ai, bj, At, Bt) do { __builtin_amdgcn_s_setprio(1); _Pragma("unroll") for (int m = 0; m < 4; ++m) _Pragma("unroll") for (int n = 0; n < 2; ++n) _Pragma("unroll") for (int k = 0; k < 2; ++k) \
        acc[ai][bj][m][n] = __builtin_amdgcn_mfma_f32_16x16x32_bf16(Bt[n][k], At[m][k], acc[ai][bj][m][n], 0, 0, 0); __builtin_amdgcn_s_setprio(0); } while (0)
#define PG8_WAIT_V(n) asm volatile("s_waitcnt vmcnt(" #n ")" ::: "memory")
#define PG8_WAIT_L(n) asm volatile("s_waitcnt lgkmcnt(" #n ")" ::: "memory")
#define PG8_BAR __builtin_amdgcn_s_barrier()
#define PG8_SCHED __builtin_amdgcn_sched_barrier(0)
    Unit cur, nxt; int ui = 0;
    if (!S.next(0, cur)) return;
    f32x4 acc[2][2][4][2];
#pragma unroll
    for (int a = 0; a < 2; ++a)
#pragma unroll
        for (int b = 0; b < 2; ++b)
#pragma unroll
            for (int m = 0; m < 4; ++m)
#pragma unroll
                for (int n = 0; n < 2; ++n) acc[a][b][m][n] = (f32x4){0.f, 0.f, 0.f, 0.f};
    bf16x8 At[4][2], B0[2][2], B1[2][2];
    const char* cA = (const char*)g.A + (size_t)cur.pm * tstepA; const char* cB = (const char*)g.Bt + (size_t)cur.pn * tstepB;
    S.a_ready(cur);
    if constexpr (SP2) {
        PG8_STAGE(PG8_SB(0, 0), cB, voffB); PG8_STAGE(PG8_SB(0, 1), cB + hstepB, voffB); PG8_STAGE(PG8_SA(0, 0), cA, voffA); PG8_STAGE(PG8_SA(0, 1), cA + hstepA, voffA);
        if (wr == 1) PG8_BAR;
        PG8_WAIT_V(2); PG8_BAR;
        PG8_STAGE(PG8_SB(1, 0), cB + kstep, voffB); PG8_STAGE(PG8_SA(1, 0), cA + kstep, voffA); PG8_STAGE(PG8_SB(1, 1), cB + hstepB + kstep, voffB);
        PG8_WAIT_V(6); PG8_BAR;
    } else {
        PG8_STAGE(PG8_SB(0, 0), cB, voffB); PG8_STAGE(PG8_SA(0, 0), cA, voffA); PG8_STAGE(PG8_SB(0, 1), cB + hstepB, voffB); PG8_STAGE(PG8_SA(0, 1), cA + hstepA, voffA);
        if (wr == 1) PG8_BAR;
        PG8_WAIT_V(4); PG8_BAR;
        PG8_STAGE(PG8_SB(1, 0), cB + kstep, voffB); PG8_STAGE(PG8_SA(1, 0), cA + kstep, voffA); PG8_STAGE(PG8_SB(1, 1), cB + hstepB + kstep, voffB);
        PG8_WAIT_V(6); PG8_BAR;
    }
    for (;;) {
        const bool has_next = S.next(ui + 1, nxt);
        const char* nA = has_next ? (const char*)g.A + (size_t)nxt.pm * tstepA : cA; const char* nB = has_next ? (const char*)g.Bt + (size_t)nxt.pn * tstepB : cB;
        for (int t = 0; t < nt; t += 2) {
            const bool last = (t == nt - 2);
            const char* a1 = cA + (size_t)(t + 1) * kstep;
            const char* a2 = last ? nA : cA + (size_t)(t + 2) * kstep; const char* b2 = last ? nB : cB + (size_t)(t + 2) * kstep;
            const char* a3 = a2 + kstep; const char* b3 = b2 + kstep;
            if (last && has_next) S.a_ready(nxt);
            if constexpr (SP2) {
            PG8_LDB(B0, 0, 0); PG8_LDB(B1, 0, 1); PG8_SCHED; PG8_LDA(At, 0, 0); PG8_STAGE(PG8_SA(1, 1), a1 + hstepA, voffA);
            PG8_WAIT_V(8); PG8_WAIT_L(0); PG8_BAR; PG8_MMA(0, 0, At, B0); PG8_MMA(0, 1, At, B1); PG8_BAR; PG8_SCHED;
            PG8_LDA(At, 0, 1); PG8_STAGE(PG8_SB(0, 0), b2, voffB); PG8_STAGE(PG8_SB(0, 1), b2 + hstepB, voffB); PG8_STAGE(PG8_SA(0, 0), a2, voffA);
            PG8_WAIT_V(8); PG8_WAIT_L(0); PG8_BAR; PG8_MMA(1, 0, At, B0); PG8_MMA(1, 1, At, B1); PG8_BAR; PG8_SCHED;
            PG8_LDB(B0, 1, 0); PG8_LDB(B1, 1, 1); PG8_SCHED; PG8_LDA(At, 1, 0); PG8_STAGE(PG8_SA(0, 1), a2 + hstepA, voffA);
            PG8_WAIT_V(8); PG8_WAIT_L(0); PG8_BAR; PG8_MMA(0, 0, At, B0); PG8_MMA(0, 1, At, B1); PG8_BAR; PG8_SCHED;
            PG8_LDA(At, 1, 1); PG8_STAGE(PG8_SB(1, 0), b3, voffB); PG8_STAGE(PG8_SB(1, 1), b3 + hstepB, voffB); PG8_STAGE(PG8_SA(1, 0), a3, voffA);
            PG8_WAIT_V(8); PG8_WAIT_L(0); PG8_BAR; PG8_MMA(1, 0, At, B0); PG8_MMA(1, 1, At, B1); PG8_BAR; PG8_SCHED;
            } else {
            PG8_LDB(B0, 0, 0); PG8_SCHED; PG8_LDA(At, 0, 0); PG8_STAGE(PG8_SA(1, 1), a1 + hstepA, voffA);
            PG8_WAIT_L(8); PG8_BAR; PG8_WAIT_L(0); PG8_MMA(0, 0, At, B0); PG8_BAR; PG8_SCHED;
            PG8_LDB(B1, 0, 1); PG8_STAGE(PG8_SB(0, 0), b2, voffB);
            PG8_BAR; PG8_WAIT_L(0); PG8_MMA(0, 1, At, B1); PG8_BAR;
            PG8_LDA(At, 0, 1); PG8_STAGE(PG8_SA(0, 0), a2, voffA);
            PG8_BAR; PG8_WAIT_L(0); PG8_MMA(1, 0, At, B0); PG8_BAR; PG8_SCHED;
            PG8_STAGE(PG8_SB(0, 1), b2 + hstepB, voffB);
            PG8_WAIT_V(6); PG8_BAR; PG8_MMA(1, 1, At, B1); PG8_BAR;
            PG8_LDB(B0, 1, 0); PG8_SCHED; PG8_LDA(At, 1, 0); PG8_STAGE(PG8_SA(0, 1), a2 + hstepA, voffA);
            PG8_WAIT_L(8); PG8_BAR; PG8_WAIT_L(0); PG8_MMA(0, 0, At, B0); PG8_BAR; PG8_SCHED;
            PG8_LDB(B1, 1, 1); PG8_STAGE(PG8_SB(1, 0), b3, voffB);
            PG8_BAR; PG8_WAIT_L(0); PG8_MMA(0, 1, At, B1); PG8_BAR;
            PG8_LDA(At, 1, 1); PG8_STAGE(PG8_SA(1, 0), a3, voffA);
            PG8_BAR; PG8_WAIT_L(0); PG8_MMA(1, 0, At, B0); PG8_BAR; PG8_SCHED;
            PG8_STAGE(PG8_SB(1, 1), b3 + hstepB, voffB);
            PG8_WAIT_V(6); PG8_BAR; PG8_MMA(1, 1, At, B1); PG8_BAR;
            }
        }
        if constexpr (ALIGN_EPI) { if (wr == 0) PG8_BAR; }
        if constexpr (!Epi::AFTER_DRAIN) { E(acc, cur, wr, wc, fr, fq); S.done(cur); }
        if (!has_next) break;
#pragma unroll
        for (int a = 0; a < 2; ++a)
#pragma unroll
            for (int b = 0; b < 2; ++b)
#pragma unroll
                for (int m = 0; m < 4; ++m)
#pragma unroll
                    for (int n = 0; n < 2; ++n) acc[a][b][m][n] = (f32x4){0.f, 0.f, 0.f, 0.f};
        cur = nxt; cA = nA; cB = nB; ++ui;
        if constexpr (ALIGN_EPI) { if (wr == 1) PG8_BAR; }
    }
    PG8_WAIT_V(0);
    if constexpr (!ALIGN_EPI) { if (wr == 0) PG8_BAR; }
    PG8_BAR;
    if constexpr (Epi::AFTER_DRAIN) { E.fused(acc, cur, wr, wc, fr, fq, lds, wid, lane); S.done(cur); }
#undef PG8_SA
#undef PG8_SB
#undef PG8_STAGE
#undef PG8_LDA
#undef PG8_LDB
#undef PG8_MMA
#undef PG8_WAIT_V
#undef PG8_WAIT_L
#undef PG8_BAR
#undef PG8_SCHED
}
}


#define LAS __attribute__((address_space(3)))
#define DI __device__ __forceinline__
__device__ __forceinline__ int opaque_tid() { int t = threadIdx.x; asm volatile("" : "+v"(t)); return t; }
typedef unsigned short bf16_t;
typedef short bf16x8 __attribute__((ext_vector_type(8)));
typedef float f32x4 __attribute__((ext_vector_type(4)));
typedef float f32x16 __attribute__((ext_vector_type(16)));
typedef float f32x2 __attribute__((ext_vector_type(2)));
typedef __bf16 bf16x2n __attribute__((ext_vector_type(2)));
typedef unsigned u32x4 __attribute__((ext_vector_type(4)));
typedef unsigned u32x2 __attribute__((ext_vector_type(2)));

constexpr int D = 1024, NB = 2, S = 16384, NTOK = NB * S, NG = 4;
constexpr int NSA_N = 2608, NSA_NP = 2816, DIL_N = 2560;
constexpr int NE = 32, FE = 512;
constexpr int ROWS_PAD = 73728;
constexpr float ALPHA = 1.41421356237309515f, LN_EPS = 1e-5f, LOG2E = 1.4426950408889634f;
constexpr int NWAVES = 8, NTHREADS = 512;
constexpr int LDS_BYTES = 147456;
constexpr int RING_BYTES = 131072;

constexpr size_t MiB = 1u << 20;
constexpr size_t WS_CTL = 0;
constexpr size_t CTL_ZERO_BYTES = 4096;
constexpr size_t WS_MOD = 1 * MiB;
constexpr size_t WS_CBIAS = 1 * MiB + 128 * 1024;
constexpr size_t WS_ROPE = 2 * MiB;
constexpr size_t WS_EIDX = 4 * MiB;
constexpr size_t WS_EWT = 4 * MiB + 256 * 1024;
constexpr size_t WS_ROWTOK = 4 * MiB + 512 * 1024;
constexpr size_t WS_ROWW = 5 * MiB + 128 * 1024;
constexpr size_t WS_WIN0T = 6 * MiB;
constexpr size_t WS_WO0T = 12 * MiB;
constexpr size_t WS_WIN1T = 14 * MiB;
constexpr size_t WS_WO1T = 19 * MiB;
constexpr size_t WS_CW1T = 21 * MiB;
constexpr size_t WS_KC = 23 * MiB;
constexpr size_t WS_VCT = 24 * MiB;
constexpr size_t WS_G = 25 * MiB;
constexpr size_t WS_HID = 31 * MiB;
constexpr size_t WS_GUT = 40 * MiB;
constexpr size_t WS_DNT = 104 * MiB;
constexpr size_t WS_HM = 136 * MiB;
constexpr size_t WS_Q = 200 * MiB;
constexpr size_t WS_KV = 264 * MiB;
constexpr size_t KVB = 16 * MiB;
constexpr size_t WS_AO = 360 * MiB;
constexpr size_t WS_HS = 200 * MiB;
constexpr size_t WS_HH = 344 * MiB;
constexpr size_t WS_Y = 200 * MiB;
constexpr size_t WS_END = 424 * MiB;
constexpr int CW_CNT = 0;
constexpr int CW_CUR = 64;

struct Args {
    const float* x; const float* c; const int* pos; const float* ada_w; const float* ada_b; const float* ln_g; const float* ln_b;
    const float* nsa_w_in; const float* cpos_k; const float* cw1_k; const float* cw2_k; const float* cpos_v; const float* cw1_v; const float* cw2_v;
    const float* nsa_w_o; const float* dil_w_in; const float* dil_w_o; const float* router_w; const float* router_b;
    const float* moe_wg; const float* moe_wu; const float* moe_wd;
    float* out; unsigned char* ws;
};

DI unsigned pk2(float lo, float hi) { f32x2 v = {lo, hi}; return __builtin_bit_cast(unsigned, __builtin_convertvector(v, bf16x2n)); }
DI float bf2f(unsigned short b) { return __builtin_bit_cast(float, (unsigned)b << 16); }
DI float wave_sum(float v) {
#pragma unroll
    for (int o = 1; o < 64; o <<= 1) v += __shfl_xor(v, o);
    return v;
}
DI float sigmoidf_(float v) { return 1.f / (1.f + __expf(-v)); }
#define MFMA32(a, b, c) __builtin_amdgcn_mfma_f32_32x32x16_bf16((a), (b), (c), 0, 0, 0)

DI void transpose_item(const float* src, int ldn, int nvalid, bf16_t* dst, int ldk, LAS float* scr, int lane) {
    const int nn = lane & 31;
#pragma unroll 8
    for (int i = 0; i < 32; ++i) { const int kk = 2 * i + (lane >> 5); scr[kk * 33 + nn] = (nn < nvalid) ? src[(size_t)kk * ldn + nn] : 0.f; }
    asm volatile("s_waitcnt lgkmcnt(0)" ::: "memory");
    const int c = lane & 7;
#pragma unroll
    for (int j = 0; j < 4; ++j) { const int n = (lane >> 3) + 8 * j; const LAS float* s = scr + (8 * c) * 33 + n;
        u32x4 o; o.x = pk2(s[0 * 33], s[1 * 33]); o.y = pk2(s[2 * 33], s[3 * 33]); o.z = pk2(s[4 * 33], s[5 * 33]); o.w = pk2(s[6 * 33], s[7 * 33]);
        *(u32x4*)(dst + (size_t)n * ldk + 8 * c) = o; }
    asm volatile("s_waitcnt lgkmcnt(0)" ::: "memory");
}
DI void transpose_plain(const float* W, int K, int N, int Npad, bf16_t* WT, LAS float* scr, int item, int lane) {
    const int nblk = Npad / 32, kb = item / nblk, nb = item % nblk, k0 = 64 * kb, n0 = 32 * nb;
    int nvalid = N - n0; nvalid = nvalid < 0 ? 0 : (nvalid > 32 ? 32 : nvalid);
    transpose_item(W + (size_t)k0 * N + (nvalid > 0 ? n0 : 0), N, nvalid, WT + (size_t)n0 * K + k0, K, scr, lane);
}
constexpr int MOE_ITEMS_GU = NE * 16 * 16;
constexpr int MOE_ITEMS_DN = NE * 8 * 32;
constexpr int MOE_ITEMS = 2 * MOE_ITEMS_GU + MOE_ITEMS_DN;
DI void moe_convert_item(const float* wg, const float* wu, const float* wd, bf16_t* GUT, bf16_t* DNT, LAS float* scr, int item, int lane) {
    if (item < 2 * MOE_ITEMS_GU) {
        const int up = item >= MOE_ITEMS_GU; int r = up ? item - MOE_ITEMS_GU : item;
        const int e = r >> 8, kb = (r >> 4) & 15, nb = r & 15, k0 = 64 * kb, n0 = 32 * nb;
        const float* W = (up ? wu : wg) + (size_t)e * D * FE;
        const int row0 = e * 1024 + (n0 >> 7) * 256 + up * 128 + (n0 & 127);
        transpose_item(W + (size_t)k0 * FE + n0, FE, 32, GUT + (size_t)row0 * D + k0, D, scr, lane);
    } else {
        const int r = item - 2 * MOE_ITEMS_GU; const int e = r >> 8, kb = (r >> 5) & 7, nb = r & 31, k0 = 64 * kb, n0 = 32 * nb;
        const float* W = wd + (size_t)e * FE * D;
        transpose_item(W + (size_t)k0 * D + n0, D, 32, DNT + ((size_t)e * 1024 + n0) * FE + k0, FE, scr, lane);
    }
}

DI void hmod_row(const float* xrow, const float* modb  , bf16_t* orow, int lane) {
#pragma unroll
    for (int j = 0; j < 4; ++j) {
        const int col = 4 * lane + 256 * j;
        const f32x4 v = *(const f32x4*)(xrow + col), sh = *(const f32x4*)(modb + col), sc = *(const f32x4*)(modb + D + col);
        u32x2 o; o.x = pk2(v.x * (1.f + sc.x) + sh.x, v.y * (1.f + sc.y) + sh.y); o.y = pk2(v.z * (1.f + sc.z) + sh.z, v.w * (1.f + sc.w) + sh.w);
        *(u32x2*)(orow + col) = o;
    }
}

using pg8::Unit;
constexpr int HALF = 128;
#define EPI_ROWS(u, wr, fr, ai, m) ((u).pm * 256 + (ai) * 128 + (wr) * 64 + (m) * 16 + (fr))

DI void rope8(f32x4& v0, f32x4& v1, const float* cs  , int fq, bool active) {
    f32x4 p0, p1;
#pragma unroll
    for (int j = 0; j < 4; ++j) { p0[j] = __shfl_xor(v0[j], 16); p1[j] = __shfl_xor(v1[j], 16); }
    if (active) {
        const f32x4 c0 = *(const f32x4*)(cs), c1 = *(const f32x4*)(cs + 4), s0 = *(const f32x4*)(cs + 8), s1 = *(const f32x4*)(cs + 12);
        if (fq == 0) { v0 = v0 * c0 - p0 * s0; v1 = v1 * c1 - p1 * s1; }
        else         { v0 = p0 * s0 + v0 * c0; v1 = p1 * s1 + v1 * c1; }
    }
}

template <int LAYER> struct EpiProj {
    static constexpr bool PERM = true, AFTER_DRAIN = false;
    unsigned char* ws; const float* rope;
    DI void operator()(const f32x4 (&acc)[2][2][4][2], const Unit& u, int wr, int wc, int fr, int fq) const {
        const int pn = u.pn;
        int kind, p = 0;
        if (pn < 4) kind = 0;
        else if (LAYER == 0) { if (pn == 10) kind = 5; else { p = (pn - 4) >> 1; const int isv = (pn - 4) & 1; kind = isv ? (p == 0 ? 3 : 4) : (p == 0 ? 2 : 1); } }
        else { p = (pn - 4) >> 1; kind = ((pn - 4) & 1) ? 4 : 1; }
        const int dil_sh = LAYER == 1 ? 2 * p : 0;
        const int Lp = S >> dil_sh;
        if (kind <= 3) {
            const bool do_rope = (kind <= 1) && ((wc & 1) == 0);
            const bool rope_lane = do_rope && fq < 2;
            const float qs = kind == 0 ? 0.125f : 1.f;
            bf16_t* base = kind == 0 ? (bf16_t*)(ws + WS_Q) : (bf16_t*)(ws + WS_KV + (size_t)(2 * p + (kind == 3 ? 1 : 0)) * KVB);
#pragma unroll
            for (int ai = 0; ai < 2; ++ai)
#pragma unroll
                for (int m = 0; m < 4; ++m) {
                    asm volatile("" ::: "memory");
                    const int row = EPI_ROWS(u, wr, fr, ai, m);
                    const int b = row >> 14, t = row & (S - 1);
                    const float* cs = rope + (size_t)row * 16;
                    const int res = t & ((1 << dil_sh) - 1), l = t >> dil_sh;
#pragma unroll
                    for (int bj = 0; bj < 2; ++bj) {
                        f32x4 v0 = acc[ai][bj][m][0], v1 = acc[ai][bj][m][1];
                        const int cl = bj * 128 + wc * 32 + fq * 8;
                        if (do_rope) rope8(v0, v1, cs, fq, rope_lane);
                        v0 = v0 * qs; v1 = v1 * qs;
                        u32x4 w; w.x = pk2(v0[0], v0[1]); w.y = pk2(v0[2], v0[3]); w.z = pk2(v1[0], v1[1]); w.w = pk2(v1[2], v1[3]);
                        bf16_t* dst = kind == 0 ? base + (size_t)row * D + pn * 256 + cl
                                                : base + ((size_t)(b * NG + (cl >> 6)) * S + res * Lp + l) * 64 + (cl & 63);
                        *(u32x4*)dst = w;
                    }
                }
        } else if (kind == 4) {
            bf16_t* base = (bf16_t*)(ws + WS_KV + (size_t)(2 * p + 1) * KVB);
#pragma unroll
            for (int ai = 0; ai < 2; ++ai)
#pragma unroll
                for (int m = 0; m < 4; ++m) {
                    asm volatile("" ::: "memory");
                    const int row = EPI_ROWS(u, wr, fr, ai, m);
                    const int b = row >> 14, t = row & (S - 1);
                    const int res = t & ((1 << dil_sh) - 1), l = t >> dil_sh;
#pragma unroll
                    for (int bj = 0; bj < 2; ++bj) {
                        const f32x4 v0 = acc[ai][bj][m][0], v1 = acc[ai][bj][m][1];
                        const int cl = bj * 128 + wc * 32 + fq * 8, g = cl >> 6, dim = cl & 63;
                        bf16_t* vp = base + ((size_t)((b * NG + g) << dil_sh) + res) * 64 * Lp + (size_t)dim * Lp + l;
#pragma unroll
                        for (int j = 0; j < 4; ++j) { vp[(size_t)j * Lp] = (bf16_t)(pk2(v0[j], 0.f) & 0xffffu); vp[(size_t)(4 + j) * Lp] = (bf16_t)(pk2(v1[j], 0.f) & 0xffffu); }
                    }
                }
        } else {
            const int cl = wc * 32 + fq * 8;
            if (cl < 48) {
#pragma unroll
                for (int ai = 0; ai < 2; ++ai)
#pragma unroll
                    for (int m = 0; m < 4; ++m) {
                        const int row = EPI_ROWS(u, wr, fr, ai, m);
                        float* gp = (float*)(ws + WS_G) + (size_t)row * 48 + cl;
                        f32x4 g0, g1;
#pragma unroll
                        for (int j = 0; j < 4; ++j) { g0[j] = sigmoidf_(acc[ai][0][m][0][j]); g1[j] = sigmoidf_(acc[ai][0][m][1][j]); }
                        *(f32x4*)gp = g0; *(f32x4*)(gp + 4) = g1;
                    }
            }
        }
    }
};

struct EpiCmp1 {
    static constexpr bool PERM = true, AFTER_DRAIN = false;
    bf16_t* hid; const float* bias;
    DI void operator()(const f32x4 (&acc)[2][2][4][2], const Unit& u, int wr, int wc, int fr, int fq) const {
        const int kv = u.pn;
#pragma unroll
        for (int bj = 0; bj < 2; ++bj) {
            const int cl = bj * 128 + wc * 32 + fq * 8;
            const f32x4 b0 = *(const f32x4*)(bias + kv * 256 + cl), b1 = *(const f32x4*)(bias + kv * 256 + cl + 4);
#pragma unroll
            for (int ai = 0; ai < 2; ++ai)
#pragma unroll
                for (int m = 0; m < 4; ++m) {
                    const int row = EPI_ROWS(u, wr, fr, ai, m);
                    f32x4 v0 = acc[ai][bj][m][0] + b0, v1 = acc[ai][bj][m][1] + b1;
#pragma unroll
                    for (int j = 0; j < 4; ++j) {
                        float x = v0[j]; v0[j] = 0.5f * x * (1.f + tanhf(0.7978845608028654f * (x + 0.044715f * x * x * x)));
                        x = v1[j];       v1[j] = 0.5f * x * (1.f + tanhf(0.7978845608028654f * (x + 0.044715f * x * x * x)));
                    }
                    u32x4 w; w.x = pk2(v0[0], v0[1]); w.y = pk2(v0[2], v0[3]); w.z = pk2(v1[0], v1[1]); w.w = pk2(v1[2], v1[3]);
                    *(u32x4*)(hid + (size_t)row * 256 + cl) = w;
                }
        }
    }
};

struct EpiWo {
    static constexpr bool PERM = true, AFTER_DRAIN = false;
    const float* xin; float* X; const float* modp;
    DI void operator()(const f32x4 (&acc)[2][2][4][2], const Unit& u, int wr, int wc, int fr, int fq) const {
        const int b = (u.pm * 256) >> 14;
#pragma unroll
        for (int bj = 0; bj < 2; ++bj) {
            const int col = u.pn * 256 + bj * 128 + wc * 32 + fq * 8;
            const f32x4 g0 = *(const f32x4*)(modp + b * 3072 + 2 * D + col), g1 = *(const f32x4*)(modp + b * 3072 + 2 * D + col + 4);
#pragma unroll
            for (int ai = 0; ai < 2; ++ai)
#pragma unroll
                for (int m = 0; m < 4; ++m) {
                    asm volatile("" ::: "memory");
                    const size_t off = (size_t)EPI_ROWS(u, wr, fr, ai, m) * D + col;
                    const f32x4 x0 = *(const f32x4*)(xin + off), x1 = *(const f32x4*)(xin + off + 4);
                    *(f32x4*)(X + off) = x0 * ALPHA + g0 * acc[ai][bj][m][0];
                    *(f32x4*)(X + off + 4) = x1 * ALPHA + g1 * acc[ai][bj][m][1];
                }
        }
    }
};

struct EpiGU {
    static constexpr bool PERM = true, AFTER_DRAIN = false;
    bf16_t* hh;
    DI void operator()(const f32x4 (&acc)[2][2][4][2], const Unit& u, int wr, int wc, int fr, int fq) const {
        const int col = (u.pn & 3) * 128 + wc * 32 + fq * 8;
#pragma unroll
        for (int ai = 0; ai < 2; ++ai)
#pragma unroll
            for (int m = 0; m < 4; ++m) {
                const int row = EPI_ROWS(u, wr, fr, ai, m);
                f32x4 h0, h1;
#pragma unroll
                for (int j = 0; j < 4; ++j) {
                    const float g0 = acc[ai][0][m][0][j], g1 = acc[ai][0][m][1][j];
                    h0[j] = g0 / (1.f + __expf(-g0)) * acc[ai][1][m][0][j];
                    h1[j] = g1 / (1.f + __expf(-g1)) * acc[ai][1][m][1][j];
                }
                u32x4 w; w.x = pk2(h0[0], h0[1]); w.y = pk2(h0[2], h0[3]); w.z = pk2(h1[0], h1[1]); w.w = pk2(h1[2], h1[3]);
                *(u32x4*)(hh + (size_t)row * FE + col) = w;
            }
    }
};

struct EpiDown {
    static constexpr bool PERM = true, AFTER_DRAIN = false;
    bf16_t* Y; const int* row_tok; const float* row_w;
    DI void operator()(const f32x4 (&acc)[2][2][4][2], const Unit& u, int wr, int wc, int fr, int fq) const {
#pragma unroll
        for (int ai = 0; ai < 2; ++ai)
#pragma unroll
            for (int m = 0; m < 4; ++m) {
                const int row = EPI_ROWS(u, wr, fr, ai, m);
                const int tk = row_tok[row];
                if (tk < 0) continue;
                const float w = row_w[row];
                bf16_t* yr = Y + ((size_t)(tk & 1) * NTOK + (tk >> 1)) * D + (u.pn & 3) * 256 + wc * 32 + fq * 8;
#pragma unroll
                for (int bj = 0; bj < 2; ++bj) {
                    const f32x4 v0 = acc[ai][bj][m][0] * w, v1 = acc[ai][bj][m][1] * w;
                    u32x4 o; o.x = pk2(v0[0], v0[1]); o.y = pk2(v0[2], v0[3]); o.z = pk2(v1[0], v1[1]); o.w = pk2(v1[2], v1[3]);
                    *(u32x4*)(yr + bj * 128) = o;
                }
            }
    }
};

struct CmpOrder {
    int G, c;
    DI bool next(int i, Unit& u) const { const int L = i * G + c; if (L >= 64) return false; u.pm = L; u.pn = L >> 5; return true; }
    DI void a_ready(const Unit&) const {}
    DI void done(const Unit&) const {}
};
struct MoeOrder {
    const LAS int* tstart; int G, c;
    DI bool next(int i, Unit& u) const {
        const int L = i * G + c; const int nt = tstart[32];
        if (L >= nt * 4) return false;
        const int tile = L >> 2; int e = 0;
#pragma unroll 1
        for (int j = 1; j < 32; ++j) e += (tstart[j] <= tile) ? 1 : 0;
        u.pm = tile; u.pn = e * 4 + (L & 3); return true;
    }
    DI void a_ready(const Unit&) const {}
    DI void done(const Unit&) const {}
};

constexpr int AT_KV_BYTES = 16384;
constexpr int AT_IMP_OFF = 2 * AT_KV_BYTES;
constexpr int AT_IMP_STRIDE = 260;
constexpr int AT_SEL_OFF = AT_IMP_OFF + 64 * AT_IMP_STRIDE * 4;
static_assert(AT_SEL_OFF + 64 * 8 * 4 <= RING_BYTES, "attention LDS map");

struct AttnSt { f32x16 o[2]; float m, l; };

DI void at_stage_issue(const bf16_t* Kb, const bf16_t* VTb, int pitch, int key0, int tid, u32x4& kr, u32x4& vr) {
    const int row = tid >> 3, ch = tid & 7;
    kr = *(const u32x4*)(Kb + (size_t)(key0 + row) * 64 + ch * 8);
    vr = *(const u32x4*)(VTb + (size_t)row * pitch + key0 + ch * 8);
}
DI void at_stage_write(LAS unsigned char* buf, int tid, const u32x4& kr, const u32x4& vr) {
    const int row = tid >> 3, ch = tid & 7, sw = (row >> 1) & 7;
    *(LAS u32x4*)(buf + row * 128 + ((ch ^ sw) << 4)) = kr;
    const int c0 = (ch >> 1) * 2, sub = 8 * (ch & 1);
    u32x2 lo = {vr.x, vr.y}, hi = {vr.z, vr.w};
    *(LAS u32x2*)(buf + 8192 + row * 128 + (((c0) ^ sw) << 4) + sub) = lo;
    *(LAS u32x2*)(buf + 8192 + row * 128 + (((c0 + 1) ^ sw) << 4) + sub) = hi;
}

template <int MODE, bool SEL>
DI void attn_loop(LAS unsigned char* lds, const bf16_t* Kb, const bf16_t* VTb, int pitch, int tile_lo, int tile_hi,
                  const bf16x8 (&qf)[4], int lo_c, int hi_c, AttnSt& st, float inv_l, int tok_local, int t_col, LAS float* imp_row) {
    const int tid = opaque_tid(), lane = tid & 63, r = lane & 31, h = lane >> 5, sw = (r >> 1) & 7;
    if (tile_lo > tile_hi) return;
    u32x4 kr, vr;
    at_stage_issue(Kb, VTb, pitch, tile_lo * 64, tid, kr, vr);
    __syncthreads();
    at_stage_write(lds, tid, kr, vr);
    __syncthreads();
    int cur = 0;
    for (int t = tile_lo; t <= tile_hi; ++t) {
        const bool more = t < tile_hi;
        if (more) at_stage_issue(Kb, VTb, pitch, (t + 1) * 64, tid, kr, vr);
        LAS unsigned char* kb = lds + cur * AT_KV_BYTES;
        LAS unsigned char* vb = kb + 8192;
        const int key0 = t * 64;
        int lo = lo_c, hi = hi_c;
        if (SEL) { const unsigned wsel = ((LAS unsigned*)(lds + AT_SEL_OFF))[tok_local * 8 + (t >> 5)]; hi = ((wsel >> (t & 31)) & 1u) ? t_col : -1; }
        const bool act = (key0 + 63 >= lo) && (key0 <= hi);
        if (__any(act)) {
            f32x16 s0, s1;
#pragma unroll
            for (int i = 0; i < 16; ++i) { s0[i] = 0.f; s1[i] = 0.f; }
#pragma unroll
            for (int kk = 0; kk < 4; ++kk) {
                const bf16x8 a0 = *(const LAS bf16x8*)(kb + r * 128 + (((2 * kk + h) ^ sw) << 4));
                const bf16x8 a1 = *(const LAS bf16x8*)(kb + 4096 + r * 128 + (((2 * kk + h) ^ sw) << 4));
                s0 = MFMA32(a0, qf[kk], s0);
                s1 = MFMA32(a1, qf[kk], s1);
            }
            float mx = -INFINITY;
#pragma unroll
            for (int i = 0; i < 16; ++i) {
                const int key = key0 + (i & 3) + 8 * (i >> 2) + 4 * h;
                float v = s0[i] * LOG2E; v = (key >= lo && key <= hi) ? v : -INFINITY; s0[i] = v; mx = fmaxf(mx, v);
                float w = s1[i] * LOG2E; w = (key + 32 >= lo && key + 32 <= hi) ? w : -INFINITY; s1[i] = w; mx = fmaxf(mx, w);
            }
            float mref;
            if (MODE == 2) mref = st.m;
            else {
                mx = fmaxf(mx, __shfl_xor(mx, 32));
                const float mnew = fmaxf(st.m, mx);
                const float alpha = __builtin_amdgcn_exp2f(st.m - mnew);
                st.l *= alpha;
                if (MODE == 0) { if (!__all(mnew == st.m)) {
#pragma unroll
                    for (int i = 0; i < 16; ++i) { st.o[0][i] *= alpha; st.o[1][i] *= alpha; } } }
                st.m = mnew; mref = mnew;
            }
            float rs = 0.f;
#pragma unroll
            for (int i = 0; i < 16; ++i) {
                float p0 = __builtin_amdgcn_exp2f(s0[i] - mref), p1 = __builtin_amdgcn_exp2f(s1[i] - mref);
                if (MODE == 2) { p0 *= inv_l; p1 *= inv_l; }
                s0[i] = p0; s1[i] = p1; rs += p0 + p1;
            }
            if (MODE != 2) st.l += rs;
            if (MODE == 2) {
#pragma unroll
                for (int kt = 0; kt < 2; ++kt)
#pragma unroll
                    for (int jj = 0; jj < 4; ++jj) {
                        float gs = kt ? (s1[4 * jj] + s1[4 * jj + 1]) + (s1[4 * jj + 2] + s1[4 * jj + 3]) : (s0[4 * jj] + s0[4 * jj + 1]) + (s0[4 * jj + 2] + s0[4 * jj + 3]);
                        float ls = kt ? s1[4 * jj + 3] : s0[4 * jj + 3];
                        gs += __shfl_xor(gs, 1); gs += __shfl_xor(gs, 2);
                        ls += __shfl_xor(ls, 1); ls += __shfl_xor(ls, 2);
                        if ((lane & 3) == 0) {
                            const int gidx = t * 16 + 8 * kt + 2 * jj + h;
                            (void)__hip_atomic_fetch_add(imp_row + gidx, gs, __ATOMIC_RELAXED, __HIP_MEMORY_SCOPE_WORKGROUP);
                            (void)__hip_atomic_fetch_add(imp_row + gidx + 1, ls, __ATOMIC_RELAXED, __HIP_MEMORY_SCOPE_WORKGROUP);
                        }
                    }
            }
            if (MODE != 1) {
                bf16x8 pf[4];
#pragma unroll
                for (int sg = 0; sg < 4; ++sg) {
                    u32x4 w;
                    if (sg < 2) { w.x = pk2(s0[8 * sg + 0], s0[8 * sg + 1]); w.y = pk2(s0[8 * sg + 2], s0[8 * sg + 3]); w.z = pk2(s0[8 * sg + 4], s0[8 * sg + 5]); w.w = pk2(s0[8 * sg + 6], s0[8 * sg + 7]); }
                    else { const int q = sg - 2; w.x = pk2(s1[8 * q + 0], s1[8 * q + 1]); w.y = pk2(s1[8 * q + 2], s1[8 * q + 3]); w.z = pk2(s1[8 * q + 4], s1[8 * q + 5]); w.w = pk2(s1[8 * q + 6], s1[8 * q + 7]); }
                    pf[sg] = __builtin_bit_cast(bf16x8, w);
                }
#pragma unroll
                for (int sg = 0; sg < 4; ++sg) {
                    const bf16x8 v0 = *(const LAS bf16x8*)(vb + r * 128 + (((2 * sg + h) ^ sw) << 4));
                    const bf16x8 v1 = *(const LAS bf16x8*)(vb + 4096 + r * 128 + (((2 * sg + h) ^ sw) << 4));
                    st.o[0] = MFMA32(v0, pf[sg], st.o[0]);
                    st.o[1] = MFMA32(v1, pf[sg], st.o[1]);
                }
            }
        }
        if (more) at_stage_write(lds + (cur ^ 1) * AT_KV_BYTES, tid, kr, vr);
        __syncthreads();
        cur ^= 1;
    }
}

DI void st_reset(AttnSt& st) {
#pragma unroll
    for (int i = 0; i < 16; ++i) { st.o[0][i] = 0.f; st.o[1][i] = 0.f; }
    st.m = -1e30f; st.l = 0.f;
}
DI void load_q(const bf16_t* Q, int tokrow, int head, int h, bf16x8 (&qf)[4]) {
#pragma unroll
    for (int kk = 0; kk < 4; ++kk) qf[kk] = *(const bf16x8*)(Q + (size_t)tokrow * D + head * 64 + 16 * kk + 8 * h);
}
DI void acc_out(f32x16 (&out)[2], const AttnSt& st, float scale) {
#pragma unroll
    for (int i = 0; i < 16; ++i) { out[0][i] += scale * st.o[0][i]; out[1][i] += scale * st.o[1][i]; }
}
DI void store_out(bf16_t* AO, int tokrow, int head, int h, const f32x16 (&out)[2]) {
    bf16_t* base = AO + (size_t)tokrow * D + head * 64 + 4 * h;
#pragma unroll
    for (int dt = 0; dt < 2; ++dt)
#pragma unroll
        for (int jj = 0; jj < 4; ++jj) {
            u32x2 w; w.x = pk2(out[dt][4 * jj], out[dt][4 * jj + 1]); w.y = pk2(out[dt][4 * jj + 2], out[dt][4 * jj + 3]);
            *(u32x2*)(base + 32 * dt + 8 * jj) = w;
        }
}


DI void lds_out_set(LAS unsigned char* ob, int c, int h, const AttnSt& st, float scale) {
#pragma unroll
    for (int dt = 0; dt < 2; ++dt)
#pragma unroll
        for (int jj = 0; jj < 4; ++jj) {
            f32x4 v = {st.o[dt][4 * jj] * scale, st.o[dt][4 * jj + 1] * scale, st.o[dt][4 * jj + 2] * scale, st.o[dt][4 * jj + 3] * scale};
            *(LAS f32x4*)(ob + (((dt * 4 + jj) * 2 + h) * 32 + c) * 16) = v;
        }
}
DI void lds_out_add(LAS unsigned char* ob, int c, int h, const AttnSt& st, float scale) {
#pragma unroll
    for (int dt = 0; dt < 2; ++dt)
#pragma unroll
        for (int jj = 0; jj < 4; ++jj) {
            LAS f32x4* p = (LAS f32x4*)(ob + (((dt * 4 + jj) * 2 + h) * 32 + c) * 16);
            f32x4 v = *p;
            v[0] += st.o[dt][4 * jj] * scale; v[1] += st.o[dt][4 * jj + 1] * scale; v[2] += st.o[dt][4 * jj + 2] * scale; v[3] += st.o[dt][4 * jj + 3] * scale;
            *p = v;
        }
}
DI void lds_out_final_store(LAS unsigned char* ob, int c, int h, const AttnSt& st, float scale, bf16_t* AO, int tokrow, int head) {
    bf16_t* base = AO + (size_t)tokrow * D + head * 64 + 4 * h;
#pragma unroll
    for (int dt = 0; dt < 2; ++dt)
#pragma unroll
        for (int jj = 0; jj < 4; ++jj) {
            const f32x4 v = *(const LAS f32x4*)(ob + (((dt * 4 + jj) * 2 + h) * 32 + c) * 16);
            u32x2 w; w.x = pk2(v[0] + st.o[dt][4 * jj] * scale, v[1] + st.o[dt][4 * jj + 1] * scale); w.y = pk2(v[2] + st.o[dt][4 * jj + 2] * scale, v[3] + st.o[dt][4 * jj + 3] * scale);
            *(u32x2*)(base + 32 * dt + 8 * jj) = w;
        }
}

DI void nsa_tile(LAS unsigned char* lds, unsigned char* ws, int b, int g, int tq0) {
    const int tid = opaque_tid(), lane = tid & 63, wave = tid >> 6, c = lane & 31, h = lane >> 5, r = c & 3;
    const int tok_local = wave * 8 + (c >> 2), t_col = tq0 + tok_local, tokrow = b * S + t_col, head = g * 4 + r;
    const int cur = tq0 >> 6;
    const bf16_t* Q = (const bf16_t*)(ws + WS_Q);
    const size_t slab = (size_t)(b * NG + g) * S * 64;
    const bf16_t* KC = (const bf16_t*)(ws + WS_KC) + (size_t)(b * NG + g) * 1024 * 64;
    const bf16_t* VCT = (const bf16_t*)(ws + WS_VCT) + (size_t)(b * NG + g) * 64 * 1024;
    const bf16_t* K1 = (const bf16_t*)(ws + WS_KV + 2 * KVB) + slab;
    const bf16_t* V1T = (const bf16_t*)(ws + WS_KV + 3 * KVB) + slab;
    const bf16_t* K2 = (const bf16_t*)(ws + WS_KV + 4 * KVB) + slab;
    const bf16_t* V2T = (const bf16_t*)(ws + WS_KV + 5 * KVB) + slab;
    LAS float* imp = (LAS float*)(lds + AT_IMP_OFF);
    LAS unsigned* selm = (LAS unsigned*)(lds + AT_SEL_OFF);
    LAS float* imp_row = imp + tok_local * AT_IMP_STRIDE;
    bf16x8 qf[4];
    load_q(Q, tokrow, head, h, qf);
    const float* gp = (const float*)(ws + WS_G) + (size_t)tokrow * 48 + head * 3;
    const float g_c = gp[0], g_s = gp[1], g_w = gp[2];
    for (int i = lane; i < 8 * AT_IMP_STRIDE; i += 64) imp[wave * 8 * AT_IMP_STRIDE + i] = 0.f;
    LAS unsigned char* ob = lds + AT_IMP_OFF + wave * (8 * AT_IMP_STRIDE * 4);
    AttnSt st;
    const int hi_cmp = (t_col - 31) >> 4;
    const int ct_hi = ((tq0 + 32) >> 4) >> 6;
    st_reset(st);
    attn_loop<1, false>(lds, KC, VCT, 1024, 0, ct_hi, qf, 0, hi_cmp, st, 0.f, tok_local, t_col, imp_row);
    {
        const float ltot = st.l + __shfl_xor(st.l, 32);
        const float inv_l = ltot > 0.f ? 1.f / ltot : 0.f;
        const float mfin = st.m;
        st_reset(st); st.m = mfin;
        attn_loop<2, false>(lds, KC, VCT, 1024, 0, ct_hi, qf, 0, hi_cmp, st, inv_l, tok_local, t_col, imp_row);
    }
    if (cur <= 15) {
        if (lane < 64) { const int tk = lane >> 3, wd = lane & 7; unsigned bits = 0u;
            if (wd == 0) bits = (cur >= 31) ? 0xffffffffu : ((2u << cur) - 1u);
            selm[(wave * 8 + tk) * 8 + wd] = bits; }
    } else {
        float cv[8][4]; unsigned words[8];
#pragma unroll
        for (int tk = 0; tk < 8; ++tk) {
            words[tk] = 0u;
#pragma unroll
            for (int i = 0; i < 4; ++i) { const int s = lane + 64 * i; const float v = imp[(wave * 8 + tk) * AT_IMP_STRIDE + s]; cv[tk][i] = (s >= 1 && s <= cur - 2) ? v : -1.f; }
        }
#pragma unroll 1
        for (int round = 0; round < 13; ++round) {
#pragma unroll
            for (int tk = 0; tk < 8; ++tk) {
                float bv = cv[tk][0]; int bs = lane;
#pragma unroll
                for (int i = 1; i < 4; ++i) { if (cv[tk][i] > bv) { bv = cv[tk][i]; bs = lane + 64 * i; } }
#pragma unroll
                for (int o = 1; o < 64; o <<= 1) { const float ov = __shfl_xor(bv, o); const int os = __shfl_xor(bs, o); if (ov > bv || (ov == bv && os < bs)) { bv = ov; bs = os; } }
#pragma unroll
                for (int i = 0; i < 4; ++i) if (bs == lane + 64 * i) cv[tk][i] = -1.f;
                if ((bs >> 5) == (lane & 7)) words[tk] |= 1u << (bs & 31);
            }
        }
#pragma unroll
        for (int tk = 0; tk < 8; ++tk) {
            unsigned wv = words[tk]; const int wd = lane & 7;
            if (wd == 0) wv |= 1u;
            if (((cur - 1) >> 5) == wd) wv |= 1u << ((cur - 1) & 31);
            if ((cur >> 5) == wd) wv |= 1u << (cur & 31);
            if (lane < 8) selm[(wave * 8 + tk) * 8 + wd] = wv;
        }
    }
    asm volatile("s_waitcnt lgkmcnt(0)" ::: "memory");
    lds_out_set(ob, c, h, st, g_c);
    st_reset(st);
    attn_loop<0, true>(lds, K1, V1T, S, 0, cur, qf, 0, t_col, st, 0.f, tok_local, t_col, imp_row);
    { const float ltot = st.l + __shfl_xor(st.l, 32); lds_out_add(ob, c, h, st, ltot > 0.f ? g_s / ltot : 0.f); }
    st_reset(st);
    attn_loop<0, false>(lds, K2, V2T, S, cur >= 8 ? cur - 8 : 0, cur, qf, t_col - 511, t_col, st, 0.f, tok_local, t_col, imp_row);
    { const float ltot = st.l + __shfl_xor(st.l, 32); lds_out_final_store(ob, c, h, st, ltot > 0.f ? g_w / ltot : 0.f, (bf16_t*)(ws + WS_AO), tokrow, head); }
}

DI void dil_tile(LAS unsigned char* lds, unsigned char* ws, int b, int g, int res16, int i0) {
    const int tid = opaque_tid(), lane = tid & 63, wave = tid >> 6, c = lane & 31, h = lane >> 5, r = c & 3;
    const int iq = i0 + wave * 8 + (c >> 2), t_col = 16 * iq + res16, tokrow = b * S + t_col, head = g * 4 + r;
    const bf16_t* Q = (const bf16_t*)(ws + WS_Q);
    const size_t slab = (size_t)(b * NG + g) * S * 64;
    bf16x8 qf[4];
    load_q(Q, tokrow, head, h, qf);
    AttnSt st; st_reset(st);
    {
        const bf16_t* Kb = (const bf16_t*)(ws + WS_KV + 4 * KVB) + slab + (size_t)res16 * 1024 * 64;
        const bf16_t* Vb = (const bf16_t*)(ws + WS_KV + 5 * KVB) + slab + (size_t)res16 * 64 * 1024;
        const int lq = iq, lmin = i0 - 128;
        attn_loop<0, false>(lds, Kb, Vb, 1024, lmin > 0 ? lmin >> 6 : 0, (i0 + 63) >> 6, qf, lq - 128, lq, st, 0.f, 0, 0, nullptr);
    }
    {
        const int res4 = res16 & 3, c4 = res16 >> 2;
        const bf16_t* Kb = (const bf16_t*)(ws + WS_KV + 2 * KVB) + slab + (size_t)res4 * 4096 * 64;
        const bf16_t* Vb = (const bf16_t*)(ws + WS_KV + 3 * KVB) + slab + (size_t)res4 * 64 * 4096;
        const int lq = 4 * iq + c4, lmin = 4 * i0 + c4 - 128;
        attn_loop<0, false>(lds, Kb, Vb, 4096, lmin > 0 ? lmin >> 6 : 0, (4 * (i0 + 63) + c4) >> 6, qf, lq - 128, lq, st, 0.f, 0, 0, nullptr);
    }
    {
        const bf16_t* Kb = (const bf16_t*)(ws + WS_KV + 0 * KVB) + slab;
        const bf16_t* Vb = (const bf16_t*)(ws + WS_KV + 1 * KVB) + slab;
        const int lq = t_col, lmin = 16 * i0 + res16 - 128;
        attn_loop<0, false>(lds, Kb, Vb, S, lmin > 0 ? lmin >> 6 : 0, (16 * (i0 + 63) + res16) >> 6, qf, lq - 128, lq, st, 0.f, 0, 0, nullptr);
    }
    f32x16 out[2];
    const float ltot = st.l + __shfl_xor(st.l, 32), sc = 1.f / ltot;
#pragma unroll
    for (int i = 0; i < 16; ++i) { out[0][i] = st.o[0][i] * sc; out[1][i] = st.o[1][i] * sc; }
    store_out((bf16_t*)(ws + WS_AO), tokrow, head, h, out);
}

constexpr int RT_RW_STRIDE = 128;
constexpr int RT_SC_OFF = 131072;
constexpr int RT_HIST_OFF = RT_SC_OFF + 8 * 8 * 32 * 4;
constexpr int MISC_OFF = 131072 + 12288;

DI void ln_router_phase(LAS unsigned char* lds, const Args& a, int layer, int G) {
    const int tid = opaque_tid(), lane = tid & 63, wave = tid >> 6;
    unsigned char* ws = a.ws;
    float* X = a.out;
    bf16_t* HM = (bf16_t*)(ws + WS_HM);
    const float* modr = (const float*)(ws + WS_MOD) + (size_t)(layer * 2 + 1) * NB * 3072;
    const float* lng = a.ln_g + (layer * 2 + 0) * D; const float* lnb = a.ln_b + (layer * 2 + 0) * D;
    int* eidx = (int*)(ws + WS_EIDX); float* ewt = (float*)(ws + WS_EWT);
    unsigned* ctl = (unsigned*)(ws + WS_CTL);
    LAS unsigned* hist = (LAS unsigned*)(lds + RT_HIST_OFF);
    LAS float* sc = (LAS float*)(lds + RT_SC_OFF) + wave * 256;
    for (int idx = tid; idx < 1024 * 8; idx += NTHREADS) {
        const int k = idx >> 3, ch = idx & 7;
        const int rho = ((k >> 2) & 63) + 64 * (((k >> 8) & 3) * 4 + (k & 3));
        const f32x4 v = *(const f32x4*)(a.router_w + (size_t)k * 32 + ch * 4);
        *(LAS f32x4*)(lds + rho * RT_RW_STRIDE + ((ch ^ ((rho >> 1) & 7)) << 4)) = v;
    }
    if (tid < 32) hist[tid] = 0u;
    __syncthreads();
    for (int tg = blockIdx.x * NWAVES + wave; tg < NTOK / 8; tg += G * NWAVES) {
#pragma unroll 1
        for (int ti = 0; ti < 8; ++ti) {
            const int tok = tg * 8 + ti, b = tok >> 14;
            float* xr = X + (size_t)tok * D;
            f32x4 v[4]; float s = 0.f;
#pragma unroll
            for (int j = 0; j < 4; ++j) { v[j] = *(const f32x4*)(xr + 4 * lane + 256 * j); s += (v[j].x + v[j].y) + (v[j].z + v[j].w); }
            const float mean = wave_sum(s) * (1.f / D); float s2 = 0.f;
#pragma unroll
            for (int j = 0; j < 4; ++j) { v[j] = v[j] - mean; s2 += (v[j].x * v[j].x + v[j].y * v[j].y) + (v[j].z * v[j].z + v[j].w * v[j].w); }
            const float rstd = 1.f / sqrtf(wave_sum(s2) * (1.f / D) + LN_EPS);
            float acc[32];
#pragma unroll
            for (int e = 0; e < 32; ++e) acc[e] = 0.f;
#pragma unroll
            for (int j = 0; j < 4; ++j) {
                const int col = 4 * lane + 256 * j;
                const f32x4 gg = *(const f32x4*)(lng + col), bb = *(const f32x4*)(lnb + col);
                const f32x4 sh = *(const f32x4*)(modr + b * 3072 + col), scl = *(const f32x4*)(modr + b * 3072 + D + col);
                const f32x4 xn = v[j] * rstd * gg + bb;
                *(f32x4*)(xr + col) = xn;
                const f32x4 hm = xn * (scl + 1.f) + sh;
                u32x2 o; o.x = pk2(hm.x, hm.y); o.y = pk2(hm.z, hm.w);
                *(u32x2*)(HM + (size_t)tok * D + col) = o;
#pragma unroll
                for (int q = 0; q < 4; ++q) {
                    const int rho = lane + 64 * (4 * j + q);
                    const float xv = hm[q];
                    const LAS unsigned char* rp = lds + rho * RT_RW_STRIDE; const int sw = (rho >> 1) & 7;
#pragma unroll
                    for (int ch = 0; ch < 8; ++ch) { const f32x4 w = *(const LAS f32x4*)(rp + ((ch ^ sw) << 4));
                        acc[4 * ch + 0] += xv * w.x; acc[4 * ch + 1] += xv * w.y; acc[4 * ch + 2] += xv * w.z; acc[4 * ch + 3] += xv * w.w; }
                }
            }
#pragma unroll
            for (int i = 0; i < 16; ++i) { const float send = (lane & 32) ? acc[i] : acc[i + 16]; const float keep = (lane & 32) ? acc[i + 16] : acc[i]; acc[i] = keep + __shfl_xor(send, 32); }
#pragma unroll
            for (int i = 0; i < 8; ++i) { const float send = (lane & 16) ? acc[i] : acc[i + 8]; const float keep = (lane & 16) ? acc[i + 8] : acc[i]; acc[i] = keep + __shfl_xor(send, 16); }
#pragma unroll
            for (int i = 0; i < 4; ++i) { const float send = (lane & 8) ? acc[i] : acc[i + 4]; const float keep = (lane & 8) ? acc[i + 4] : acc[i]; acc[i] = keep + __shfl_xor(send, 8); }
#pragma unroll
            for (int i = 0; i < 2; ++i) { const float send = (lane & 4) ? acc[i] : acc[i + 2]; const float keep = (lane & 4) ? acc[i + 2] : acc[i]; acc[i] = keep + __shfl_xor(send, 4); }
            { const float send = (lane & 2) ? acc[0] : acc[1]; const float keep = (lane & 2) ? acc[1] : acc[0]; acc[0] = keep + __shfl_xor(send, 2); }
            acc[0] += __shfl_xor(acc[0], 1);
            if ((lane & 1) == 0) sc[ti * 32 + (lane >> 1)] = 1.f / (1.f + expf(-acc[0]));
        }
        asm volatile("s_waitcnt lgkmcnt(0)" ::: "memory");
        if (lane < 8) {
            const LAS float* srow = sc + lane * 32; const int tok = tg * 8 + lane;
            int best = 0; float bestv = -INFINITY;
#pragma unroll 1
            for (int gq = 0; gq < 4; ++gq) {
                float m1 = -INFINITY, m2 = -INFINITY;
                for (int j = 0; j < 8; ++j) { const float x = srow[gq * 8 + j] + a.router_b[gq * 8 + j]; if (x > m1) { m2 = m1; m1 = x; } else if (x > m2) m2 = x; }
                const float gs = m1 + m2; if (gs > bestv) { bestv = gs; best = gq; }
            }
            int i1 = 0, i2 = 0; float v1 = -INFINITY, v2 = -INFINITY;
            for (int j = 0; j < 8; ++j) { const float x = srow[best * 8 + j] + a.router_b[best * 8 + j];
                if (x > v1) { v2 = v1; i2 = i1; v1 = x; i1 = j; } else if (x > v2) { v2 = x; i2 = j; } }
            const int e1 = best * 8 + i1, e2 = best * 8 + i2; const float w1 = srow[e1], w2 = srow[e2], inv = 1.f / (w1 + w2);
            eidx[tok * 2] = e1; eidx[tok * 2 + 1] = e2; ewt[tok * 2] = w1 * inv; ewt[tok * 2 + 1] = w2 * inv;
            (void)__hip_atomic_fetch_add(hist + e1, 1u, __ATOMIC_RELAXED, __HIP_MEMORY_SCOPE_WORKGROUP); (void)__hip_atomic_fetch_add(hist + e2, 1u, __ATOMIC_RELAXED, __HIP_MEMORY_SCOPE_WORKGROUP);
        }
        asm volatile("s_waitcnt lgkmcnt(0)" ::: "memory");
    }
    __syncthreads();
    if (tid < 32) { const unsigned hv = hist[tid]; if (hv) atomicAdd(ctl + CW_CNT + layer * 32 + tid, hv); }
}

DI void build_tile_table(LAS int* tstart, const unsigned* cnt) {
    if (threadIdx.x == 0) { int acc = 0; for (int e = 0; e < 32; ++e) { tstart[e] = acc; acc += (int)((__hip_atomic_load(cnt + e, __ATOMIC_RELAXED, __HIP_MEMORY_SCOPE_AGENT) + 255u) >> 8); } tstart[32] = acc; }
    __syncthreads();
}

DI void scatter_phase(LAS unsigned char* lds, const Args& a, int layer, int G) {
    const int tid = opaque_tid(), lane = tid & 63, wave = tid >> 6;
    unsigned char* ws = a.ws;
    unsigned* ctl = (unsigned*)(ws + WS_CTL);
    LAS int* tstart = (LAS int*)(lds + MISC_OFF);
    LAS unsigned* lh = (LAS unsigned*)(lds + MISC_OFF + 256);
    LAS unsigned* lbase = (LAS unsigned*)(lds + MISC_OFF + 512);
    LAS int* slots = (LAS int*)(lds + MISC_OFF + 1024);
    const int* eidx = (const int*)(ws + WS_EIDX); const float* ewt = (const float*)(ws + WS_EWT);
    int* row_tok = (int*)(ws + WS_ROWTOK) + layer * ROWS_PAD; float* row_w = (float*)(ws + WS_ROWW) + layer * ROWS_PAD;
    const bf16_t* HM = (const bf16_t*)(ws + WS_HM); bf16_t* HS = (bf16_t*)(ws + WS_HS);
    build_tile_table(tstart, ctl + CW_CNT + layer * 32);
    for (int chunk = blockIdx.x; chunk < NTOK / 128; chunk += G) {
        if (tid < 32) lh[tid] = 0u;
        __syncthreads();
        int e = 0; unsigned rank = 0;
        if (tid < 256) { e = eidx[chunk * 256 + tid]; rank = __hip_atomic_fetch_add(lh + e, 1u, __ATOMIC_RELAXED, __HIP_MEMORY_SCOPE_WORKGROUP); }
        __syncthreads();
        if (tid < 32) { const unsigned n = lh[tid]; lbase[tid] = n ? atomicAdd(ctl + CW_CUR + layer * 32 + tid, n) : 0u; }
        __syncthreads();
        if (tid < 256) {
            const int slot = tstart[e] * 256 + (int)(lbase[e] + rank);
            slots[tid] = slot;
            row_tok[slot] = chunk * 256 + tid;
            row_w[slot] = ewt[chunk * 256 + tid];
        }
        __syncthreads();
        for (int i = wave; i < 256; i += NWAVES) {
            const int tok = chunk * 128 + (i >> 1), slot = slots[i];
            const u32x4* src = (const u32x4*)(HM + (size_t)tok * D) + lane; u32x4* dst = (u32x4*)(HS + (size_t)slot * D) + lane;
            const u32x4 v0 = src[0], v1 = src[64];
            dst[0] = v0; dst[64] = v1;
        }
        __syncthreads();
    }
}

DI void ln_moe_phase(const Args& a, int layer, int G, bool write_hm) {
    const int tid = opaque_tid(), lane = tid & 63, wave = tid >> 6;
    unsigned char* ws = a.ws;
    float* X = a.out;
    const bf16_t* Y = (const bf16_t*)(ws + WS_Y);
    const float* modc = (const float*)(ws + WS_MOD) + (size_t)(layer * 2 + 1) * NB * 3072;
    const float* modn = (const float*)(ws + WS_MOD) + (size_t)((layer + 1) * 2 + 0) * NB * 3072;
    const float* lng = a.ln_g + (layer * 2 + 1) * D; const float* lnb = a.ln_b + (layer * 2 + 1) * D;
    bf16_t* HM = (bf16_t*)(ws + WS_HM);
    for (int tok = blockIdx.x * NWAVES + wave; tok < NTOK; tok += G * NWAVES) {
        const int b = tok >> 14;
        float* xr = X + (size_t)tok * D;
        f32x4 v[4]; float s = 0.f;
#pragma unroll
        for (int j = 0; j < 4; ++j) {
            const int col = 4 * lane + 256 * j;
            const f32x4 x = *(const f32x4*)(xr + col), gt = *(const f32x4*)(modc + b * 3072 + 2 * D + col);
            const u32x2 y0 = *(const u32x2*)(Y + (size_t)tok * D + col), y1 = *(const u32x2*)(Y + ((size_t)NTOK + tok) * D + col);
            f32x4 ys;
            ys.x = bf2f((unsigned short)(y0.x & 0xffffu)) + bf2f((unsigned short)(y1.x & 0xffffu));
            ys.y = bf2f((unsigned short)(y0.x >> 16)) + bf2f((unsigned short)(y1.x >> 16));
            ys.z = bf2f((unsigned short)(y0.y & 0xffffu)) + bf2f((unsigned short)(y1.y & 0xffffu));
            ys.w = bf2f((unsigned short)(y0.y >> 16)) + bf2f((unsigned short)(y1.y >> 16));
            v[j] = x * ALPHA + gt * ys;
            s += (v[j].x + v[j].y) + (v[j].z + v[j].w);
        }
        const float mean = wave_sum(s) * (1.f / D); float s2 = 0.f;
#pragma unroll
        for (int j = 0; j < 4; ++j) { v[j] = v[j] - mean; s2 += (v[j].x * v[j].x + v[j].y * v[j].y) + (v[j].z * v[j].z + v[j].w * v[j].w); }
        const float rstd = 1.f / sqrtf(wave_sum(s2) * (1.f / D) + LN_EPS);
#pragma unroll
        for (int j = 0; j < 4; ++j) {
            const int col = 4 * lane + 256 * j;
            const f32x4 gg = *(const f32x4*)(lng + col), bb = *(const f32x4*)(lnb + col);
            const f32x4 xn = v[j] * rstd * gg + bb;
            *(f32x4*)(xr + col) = xn;
            if (write_hm) {
                const f32x4 sh = *(const f32x4*)(modn + b * 3072 + col), scl = *(const f32x4*)(modn + b * 3072 + D + col);
                const f32x4 hm = xn * (scl + 1.f) + sh;
                u32x2 o; o.x = pk2(hm.x, hm.y); o.y = pk2(hm.z, hm.w);
                *(u32x2*)(HM + (size_t)tok * D + col) = o;
            }
        }
    }
}

DI void cmp2_phase(const Args& a, int G) {
    const int tid = opaque_tid(), lane = tid & 63, wave = tid >> 6;
    unsigned char* ws = a.ws;
    const bf16_t* hid = (const bf16_t*)(ws + WS_HID);
    const float* rope = (const float*)(ws + WS_ROPE);
    bf16_t* KC = (bf16_t*)(ws + WS_KC); bf16_t* VCT = (bf16_t*)(ws + WS_VCT);
    for (int R = blockIdx.x * NWAVES + wave; R < 16384; R += G * NWAVES) {
        const int kv = R >> 13, bg = (R >> 10) & 7, n = R & 1023;
        const float* w2 = kv ? a.cw2_v : a.cw2_k;
        float acc = 0.f;
        if (n < 1023) {
            const bf16_t* hr = hid + (size_t)R * 256;
#pragma unroll 4
            for (int k = 0; k < 256; k += 2) {
                const unsigned hp = *(const unsigned*)(hr + k);
                acc += bf2f((unsigned short)(hp & 0xffffu)) * w2[(size_t)k * 64 + lane];
                acc += bf2f((unsigned short)(hp >> 16)) * w2[(size_t)(k + 1) * 64 + lane];
            }
        }
        if (kv == 0) {
            const float partner = __shfl_xor(acc, 8);
            if (lane < 16 && n < 1023) {
                const int b = bg >> 2; const float* cs = rope + ((size_t)b * S + 16 * n + 31) * 16; const int i = lane & 7;
                acc = (lane < 8) ? acc * cs[i] - partner * cs[8 + i] : partner * cs[8 + i] + acc * cs[i];
            }
            KC[((size_t)bg * 1024 + n) * 64 + lane] = (bf16_t)(pk2(acc, 0.f) & 0xffffu);
        } else {
            VCT[((size_t)bg * 64 + lane) * 1024 + n] = (bf16_t)(pk2(acc, 0.f) & 0xffffu);
        }
    }
}

DI void prologue_phase(LAS unsigned char* lds, const Args& a, int G) {
    const int tid = opaque_tid(), lane = tid & 63, wave = tid >> 6;
    unsigned char* ws = a.ws;
    LAS float* red = (LAS float*)(lds + 131072);
    for (int bt = blockIdx.x; bt < 200; bt += G) {
        float a0 = 0.f, a1 = 0.f;
        if (bt < 192) {
            const int is = bt / 48, col = (bt % 48) * 64 + lane;
            const float* W = a.ada_w + (size_t)is * D * 3072;
            for (int k = wave * 128; k < wave * 128 + 128; ++k) {
                const float c0 = a.c[k], c1 = a.c[D + k];
                const float w = W[(size_t)k * 3072 + col];
                a0 += c0 / (1.f + expf(-c0)) * w; a1 += c1 / (1.f + expf(-c1)) * w;
            }
        } else {
            const int kv = (bt - 192) >> 2, col = ((bt - 192) & 3) * 64 + lane;
            const float* pe = kv ? a.cpos_v : a.cpos_k; const float* w1 = kv ? a.cw1_v : a.cw1_k;
            for (int k = wave * 256; k < wave * 256 + 256; ++k) a0 += pe[k] * w1[(size_t)k * 256 + col];
        }
        red[(wave * 2 + 0) * 64 + lane] = a0; red[(wave * 2 + 1) * 64 + lane] = a1;
        __syncthreads();
        if (wave < 2) {
            float s = 0.f;
#pragma unroll
            for (int w = 0; w < 8; ++w) s += red[(w * 2 + wave) * 64 + lane];
            if (bt < 192) { const int is = bt / 48, col = (bt % 48) * 64 + lane; ((float*)(ws + WS_MOD))[((size_t)is * NB + wave) * 3072 + col] = s + a.ada_b[is * 3072 + col]; }
            else if (wave == 0) { const int kv = (bt - 192) >> 2, col = ((bt - 192) & 3) * 64 + lane; ((float*)(ws + WS_CBIAS))[kv * 256 + col] = s; }
        }
        __syncthreads();
    }
    const int gtid = blockIdx.x * NTHREADS + tid, gn = G * NTHREADS;
    for (int idx = gtid; idx < NTOK * 8; idx += gn) {
        const int tok = idx >> 3, i = idx & 7;
        const float inv = powf(500000.0f, -(float)i * 0.125f);
        const float ang = (float)a.pos[tok] * inv;
        float sn, cs; sincosf(ang, &sn, &cs);
        float* rp = (float*)(ws + WS_ROPE) + (size_t)tok * 16;
        rp[i] = cs; rp[8 + i] = sn;
    }
    for (int idx = gtid; idx < 2 * ROWS_PAD; idx += gn) ((int*)(ws + WS_ROWTOK))[idx] = -1;
    LAS float* scr = (LAS float*)(lds + wave * 16384);
    const int gw = blockIdx.x * NWAVES + wave, NGW = G * NWAVES;
    constexpr int I_IN0 = 16 * (NSA_NP / 32), I_O = 16 * 32, I_IN1 = 16 * (DIL_N / 32), I_C1 = 32 * 8;
    constexpr int NITEMS = I_IN0 + 2 * I_O + I_IN1 + 2 * I_C1 + MOE_ITEMS;
    for (int it = gw; it < NITEMS; it += NGW) {
        int r = it;
        if (r < I_IN0) { transpose_plain(a.nsa_w_in, D, NSA_N, NSA_NP, (bf16_t*)(ws + WS_WIN0T), scr, r, lane); continue; } r -= I_IN0;
        if (r < I_O) { transpose_plain(a.nsa_w_o, D, D, D, (bf16_t*)(ws + WS_WO0T), scr, r, lane); continue; } r -= I_O;
        if (r < I_IN1) { transpose_plain(a.dil_w_in, D, DIL_N, DIL_N, (bf16_t*)(ws + WS_WIN1T), scr, r, lane); continue; } r -= I_IN1;
        if (r < I_O) { transpose_plain(a.dil_w_o, D, D, D, (bf16_t*)(ws + WS_WO1T), scr, r, lane); continue; } r -= I_O;
        if (r < I_C1) { transpose_plain(a.cw1_k, 2048, 256, 256, (bf16_t*)(ws + WS_CW1T), scr, r, lane); continue; } r -= I_C1;
        if (r < I_C1) { transpose_plain(a.cw1_v, 2048, 256, 256, (bf16_t*)(ws + WS_CW1T) + (size_t)256 * 2048, scr, r, lane); continue; } r -= I_C1;
        moe_convert_item(a.moe_wg, a.moe_wu, a.moe_wd, (bf16_t*)(ws + WS_GUT), (bf16_t*)(ws + WS_DNT), scr, r, lane);
    }
}

template <int layer>
DI void layer_body(LAS unsigned char* lds, const Args& a, cg::grid_group& grid, int G) {
    const int tid = opaque_tid(), lane = tid & 63, wave = tid >> 6;
    unsigned char* ws = a.ws;
    const float* rope = (const float*)(ws + WS_ROPE);
    const float* mod = (const float*)(ws + WS_MOD);
    unsigned* ctl = (unsigned*)(ws + WS_CTL);
    LAS int* tstart = (LAS int*)(lds + MISC_OFF);

#if PH_PROJ
        if (layer == 0) {
            pg8::Gemm g{(const bf16_t*)(ws + WS_HM), (const bf16_t*)(ws + WS_WIN0T)}; pg8::StaticOrder So; So.init(NTOK, NSA_NP, G, (int)blockIdx.x);
            EpiProj<0> E{ws, rope};
            pg8::gemm_phase<D, D, EpiProj<0>, pg8::StaticOrder, true, true>(lds, g, So, E);
        } else {
            pg8::Gemm g{(const bf16_t*)(ws + WS_HM), (const bf16_t*)(ws + WS_WIN1T)}; pg8::StaticOrder So; So.init(NTOK, DIL_N, G, (int)blockIdx.x);
            EpiProj<1> E{ws, rope};
            pg8::gemm_phase<D, D, EpiProj<1>, pg8::StaticOrder, true, true>(lds, g, So, E);
        }
#endif
        grid.sync();
        if (layer == 0) {
#if PH_CMP
            { pg8::Gemm g{(const bf16_t*)(ws + WS_KV), (const bf16_t*)(ws + WS_CW1T)}; CmpOrder So{G, (int)blockIdx.x};
              EpiCmp1 E{(bf16_t*)(ws + WS_HID), (const float*)(ws + WS_CBIAS)};
              pg8::gemm_phase<1024, 2048, EpiCmp1, CmpOrder, true, true>(lds, g, So, E); }
            grid.sync();
            cmp2_phase(a, G);
#endif
            grid.sync();
#if PH_NSA
            for (int T = blockIdx.x; T < 2048; T += G) { const int bg = T & 7; nsa_tile(lds, ws, bg >> 2, bg & 3, (T >> 3) * 64); }
#endif
        } else {
#if PH_DIL
            for (int T = blockIdx.x; T < 2048; T += G) { const int bg = T & 7, rest = T >> 3; dil_tile(lds, ws, bg >> 2, bg & 3, rest >> 4, (rest & 15) * 64); }
#endif
        }
        grid.sync();
#if PH_WO
        {
            pg8::Gemm g{(const bf16_t*)(ws + WS_AO), (const bf16_t*)(ws + (layer == 0 ? WS_WO0T : WS_WO1T))}; pg8::StaticOrder So; So.init(NTOK, D, G, (int)blockIdx.x);
            EpiWo E{layer == 0 ? a.x : a.out, a.out, mod + (size_t)(layer * 2 + 0) * NB * 3072};
            pg8::gemm_phase<D, D, EpiWo, pg8::StaticOrder, true, true>(lds, g, So, E);
        }
#endif
        grid.sync();
#if PH_LNR
        ln_router_phase(lds, a, layer, G);
#endif
        grid.sync();
#if PH_SCAT
        scatter_phase(lds, a, layer, G);
#endif
        grid.sync();
        build_tile_table(tstart, ctl + CW_CNT + layer * 32);
#if PH_GU
        { pg8::Gemm g{(const bf16_t*)(ws + WS_HS), (const bf16_t*)(ws + WS_GUT)}; MoeOrder So{tstart, G, (int)blockIdx.x};
          EpiGU E{(bf16_t*)(ws + WS_HH)};
          pg8::gemm_phase<D, D, EpiGU, MoeOrder, true, true>(lds, g, So, E); }
#endif
        grid.sync();
#if PH_DN
        { pg8::Gemm g{(const bf16_t*)(ws + WS_HH), (const bf16_t*)(ws + WS_DNT)}; MoeOrder So{tstart, G, (int)blockIdx.x};
          EpiDown E{(bf16_t*)(ws + WS_Y), (const int*)(ws + WS_ROWTOK) + layer * ROWS_PAD, (const float*)(ws + WS_ROWW) + layer * ROWS_PAD};
          pg8::gemm_phase<FE, FE, EpiDown, MoeOrder, true, true>(lds, g, So, E); }
#endif
        grid.sync();
#if PH_LNM
        ln_moe_phase(a, layer, G, layer == 0);
#endif
        if (layer == 0) {
            LAS float* scr = (LAS float*)(lds + wave * 16384);
            const size_t wo = (size_t)NE * D * FE;
            for (int it = blockIdx.x * NWAVES + wave; it < MOE_ITEMS; it += G * NWAVES)
                moe_convert_item(a.moe_wg + wo, a.moe_wu + wo, a.moe_wd + wo, (bf16_t*)(ws + WS_GUT), (bf16_t*)(ws + WS_DNT), scr, it, lane);
            grid.sync();
        }
}

__global__ void __launch_bounds__(NTHREADS, 2) mega_fwd(Args a) {
    extern __shared__ __attribute__((aligned(16))) unsigned char lds_raw[];
    LAS unsigned char* lds = (LAS unsigned char*)lds_raw;
    cg::grid_group grid = cg::this_grid();
    const int G = gridDim.x, tid = opaque_tid(), lane = tid & 63, wave = tid >> 6;
    unsigned char* ws = a.ws;
    const float* rope = (const float*)(ws + WS_ROPE);
    const float* mod = (const float*)(ws + WS_MOD);
    unsigned* ctl = (unsigned*)(ws + WS_CTL);
    LAS int* tstart = (LAS int*)(lds + MISC_OFF);

#if PH_PRO
    prologue_phase(lds, a, G);
#endif
    grid.sync();
    for (int tok = blockIdx.x * NWAVES + wave; tok < NTOK; tok += G * NWAVES)
        hmod_row(a.x + (size_t)tok * D, mod + (size_t)(tok >> 14) * 3072, (bf16_t*)(ws + WS_HM) + (size_t)tok * D, lane);
    grid.sync();

    layer_body<0>(lds, a, grid, G);
    layer_body<1>(lds, a, grid, G);
}

extern "C" void kernel_launch(void* const* d_in, const int* in_sizes, int n_in, void* d_out, int out_size, void* d_ws, size_t ws_size, hipStream_t stream) {
    static int grid = 0;
    if (grid == 0) {
        if (n_in != 22 || out_size != NTOK * D || ws_size < WS_END) { fprintf(stderr, "kernel_launch: unexpected shapes (n_in %d, out %d, ws %zu)\n", n_in, out_size, ws_size); grid = -1; return; }
        int dev = 0, cus = 0, per_cu = 0;
        if (hipGetDevice(&dev) != hipSuccess || hipDeviceGetAttribute(&cus, hipDeviceAttributeMultiprocessorCount, dev) != hipSuccess) { grid = -1; return; }
        if (hipFuncSetAttribute((const void*)mega_fwd, hipFuncAttributeMaxDynamicSharedMemorySize, LDS_BYTES) != hipSuccess) { fprintf(stderr, "kernel_launch: hipFuncSetAttribute failed\n"); grid = -1; return; }
        if (hipOccupancyMaxActiveBlocksPerMultiprocessor(&per_cu, (const void*)mega_fwd, NTHREADS, LDS_BYTES) != hipSuccess || per_cu < 1) { fprintf(stderr, "kernel_launch: occupancy query failed (%d)\n", per_cu); grid = -1; return; }
        grid = cus * per_cu;
    }
    if (grid < 0) return;
    (void)hipMemsetAsync((char*)d_ws + WS_CTL, 0, CTL_ZERO_BYTES, stream);
    Args a{};
    a.x = (const float*)d_in[0]; a.c = (const float*)d_in[1]; a.pos = (const int*)d_in[2]; a.ada_w = (const float*)d_in[3]; a.ada_b = (const float*)d_in[4];
    a.ln_g = (const float*)d_in[5]; a.ln_b = (const float*)d_in[6]; a.nsa_w_in = (const float*)d_in[7]; a.cpos_k = (const float*)d_in[8]; a.cw1_k = (const float*)d_in[9];
    a.cw2_k = (const float*)d_in[10]; a.cpos_v = (const float*)d_in[11]; a.cw1_v = (const float*)d_in[12]; a.cw2_v = (const float*)d_in[13]; a.nsa_w_o = (const float*)d_in[14];
    a.dil_w_in = (const float*)d_in[15]; a.dil_w_o = (const float*)d_in[16]; a.router_w = (const float*)d_in[17]; a.router_b = (const float*)d_in[18];
    a.moe_wg = (const float*)d_in[19]; a.moe_wu = (const float*)d_in[20]; a.moe_wd = (const float*)d_in[21];
    a.out = (float*)d_out; a.ws = (unsigned char*)d_ws;
    void* args[] = {&a};
    const hipError_t e = hipLaunchCooperativeKernel((const void*)mega_fwd, dim3(grid), dim3(NTHREADS), args, LDS_BYTES, stream);
    if (e != hipSuccess) fprintf(stderr, "kernel_launch: cooperative launch failed: %s (grid %d)\n", hipGetErrorString(e), grid);
}
```

```cpp
#include <hip/hip_runtime.h>
#include <hip/hip_cooperative_groups.h>
#include <cstdio>
#include <cstdint>
namespace cg = cooperative_groups;
#ifndef PH_PRO
#define PH_PRO 1
#endif
#ifndef PH_PROJ
#define PH_PROJ 1
#endif
#ifndef PH_CMP
#define PH_CMP 1
#endif
#ifndef PH_NSA
#define PH_NSA 1
#endif
#ifndef PH_DIL
#define PH_DIL 1
#endif
#ifndef PH_WO
#define PH_WO 1
#endif
#ifndef PH_LNR
#define PH_LNR 1
#endif
#ifndef PH_SCAT
#define PH_SCAT 1
#endif
#ifndef PH_GU
#define PH_GU 1
#endif
#ifndef PH_DN
#define PH_DN 1
#endif
#ifndef PH_LNM
#define PH_LNM 1
#endif

namespace pg8 {
#define PG8_LAS __attribute__((address_space(3)))
typedef unsigned short bf16_t;
typedef short bf16x8 __attribute__((ext_vector_type(8)));
typedef float f32x4 __attribute__((ext_vector_type(4)));
typedef unsigned u32x4 __attribute__((ext_vector_type(4)));
constexpr int AG_RT_OFF = 131072;
constexpr int BM = 256, BK = 64, HALF = 128, HTB = HALF * BK * 2  , STAGE_BYTES = 8 * HTB, NXCD = 8, WGM = 8;

__host__ __device__ __forceinline__ int lds_byte(int r, int c) { const int st = (r >> 4) * 2 + (c >> 5), rr = r & 15, cc = c & 31, ob = rr * 64 + cc * 2; return st * 1024 + (ob ^ (((ob >> 9) & 1) << 5)); }
__host__ __device__ __forceinline__ void stage_rc(int b, int& R, int& C) { const int st = b / 1024, sb = b % 1024, swz = sb ^ (((sb >> 9) & 1) << 5); R = (st >> 1) * 16 + swz / 64; C = (st & 1) * 32 + (swz % 64) / 2; }
__host__ __device__ __forceinline__ int perm32(int rho) { const int n = rho >> 4, i = rho & 15; return 8 * (i >> 2) + 4 * n + (i & 3); }

struct Unit { int pm, pn; int ao = 0; };
struct Gemm { const bf16_t* A; const bf16_t* Bt; };

struct StaticOrder {
    int nM, nN, nwg, G, c;
    __host__ __device__ void init(int M, int N, int G_, int c_) { nM = M / BM; nN = N / BM; nwg = nM * nN; G = G_; c = c_; }
    __host__ __device__ bool next(int i, Unit& u) const {
        const long L = (long)i * G + c; if (L >= nwg) return false;
        int wgid = (int)L; { const int q = nwg / NXCD, r = nwg % NXCD, xcd = wgid % NXCD, off = wgid / NXCD; wgid = (xcd < r ? xcd * (q + 1) : r * (q + 1) + (xcd - r) * q) + off; }
        const int nig = WGM * nN, gid = wgid / nig, fm = gid * WGM, gsz = (nM - fm) < WGM ? (nM - fm) : WGM;
        u.pm = fm + ((wgid % nig) % gsz); u.pn = (wgid % nig) / gsz; return true;
    }
    __device__ __forceinline__ void a_ready(const Unit&) const {}
    __device__ __forceinline__ void done(const Unit&) const {}
};

template <int LDA, int KK, class Epi, class Sched, bool ALIGN_EPI = false, bool SP2 = false, bool AG = false>
__device__ __forceinline__ void gemm_phase(PG8_LAS unsigned char* lds, const Gemm g, const Sched& S, const Epi& E) {
    int tid_ = threadIdx.x; asm volatile("" : "+v"(tid_));
    const int tid = tid_, wid = __builtin_amdgcn_readfirstlane(tid >> 6), lane = tid & 63, wr = wid >> 2, wc = wid & 3, fr = lane & 15, fq = lane >> 4;
    constexpr int K = KK, nt = K / BK;
    unsigned voffA[2], voffB[2];
    int Rrow[2]; unsigned Ccol2[2];
#pragma unroll
    for (int i = 0; i < 2; ++i) { int R, C; stage_rc(tid * 16 + i * 8192, R, C); const int Rb = Epi::PERM ? ((R & ~31) + perm32(R & 31)) : R;
        voffA[i] = (unsigned)(R * LDA + C) * 2u; voffB[i] = (unsigned)(Rb * K + C) * 2u; Rrow[i] = R; Ccol2[i] = (unsigned)C * 2u; }
    const PG8_LAS unsigned* rtl = (const PG8_LAS unsigned*)(lds + AG_RT_OFF);
    unsigned gc[2][2], gn[2][2];
#define PG8_GLOAD(dst, uidx) do { _Pragma("unroll") for (int h_ = 0; h_ < 2; ++h_) _Pragma("unroll") for (int i_ = 0; i_ < 2; ++i_) dst[h_][i_] = rtl[(uidx) * 256 + 128 * h_ + Rrow[i_]] + Ccol2[i_]; } while (0)
#define PG8_STAGE_G(bufoff, kbyte, gv) do { _Pragma("unroll") for (int _i = 0; _i < 2; ++_i) \
        __builtin_amdgcn_global_load_lds((const unsigned*)((const char*)g.A + (size_t)(kbyte) + (size_t)(gv)[_i]), (PG8_LAS unsigned*)(lds + (bufoff) + ldsw + _i * 8192), 16, 0, 0); } while (0)
    constexpr size_t kstep = (size_t)(BK * 2);
    constexpr size_t hstepA = (size_t)HALF * LDA * 2, hstepB = (size_t)HALF * K * 2;
    constexpr size_t tstepA = 2 * hstepA, tstepB = 2 * hstepB;
    const unsigned ldsw = (unsigned)wid * 1024u;
    const int aoff = lds_byte(wr * 64 + fr, fq * 8), boff = lds_byte(wc * 32 + fr, fq * 8);
#define PG8_SA(b, h) (((b) * 2 + (h)) * HTB)
#define PG8_SB(b, h) ((4 + (b) * 2 + (h)) * HTB)
#define PG8_STAGE(bufoff, gbase, voff) do { _Pragma("unroll") for (int _i = 0; _i < 2; ++_i) \
        __builtin_amdgcn_global_load_lds((const unsigned*)((const char*)(gbase) + (voff)[_i]), (PG8_LAS unsigned*)(lds + (bufoff) + ldsw + _i * 8192), 16, 0, 0); } while (0)
#define PG8_LDA(dst, b, h) do { _Pragma("unroll") for (int m = 0; m < 4; ++m) _Pragma("unroll") for (int k = 0; k < 2; ++k) dst[m][k] = *(const PG8_LAS bf16x8*)(lds + PG8_SA(b, h) + aoff + m * 2048 + k * 1024); } while (0)
#define PG8_LDB(dst, b, h) do { _Pragma("unroll") for (int n = 0; n < 2; ++n) _Pragma("unroll") for (int k = 0; k < 2; ++k) dst[n][k] = *(const PG8_LAS bf16x8*)(lds + PG8_SB(b, h) + boff + n * 2048 + k * 1024); } while (0)
#define PG8_MMA(ai, bj, At, Bt) do { __builtin_amdgcn_s_setprio(1); _Pragma("unroll") for (int m = 0; m < 4; ++m) _Pragma("unroll") for (int n = 0; n < 2; ++n) _Pragma("unroll") for (int k = 0; k < 2; ++k) \
        acc[ai][bj][m][n] = __builtin_amdgcn_mfma_f32_16x16x32_bf16(Bt[n][k], At[m][k], acc[ai][bj][m][n], 0, 0, 0); __builtin_amdgcn_s_setprio(0); } while (0)
#define PG8_WAIT_V(n) asm volatile("s_waitcnt vmcnt(" #n ")" ::: "memory")
#define PG8_WAIT_L(n) asm volatile("s_waitcnt lgkmcnt(" #n ")" ::: "memory")
#define PG8_BAR __builtin_amdgcn_s_barrier()
#define PG8_SCHED __builtin_amdgcn_sched_barrier(0)
    Unit cur, nxt; int ui = 0;
    if (!S.next(0, cur)) return;
    f32x4 acc[2][2][4][2];
#pragma unroll
    for (int a = 0; a < 2; ++a)
#pragma unroll
        for (int b = 0; b < 2; ++b)
#pragma unroll
            for (int m = 0; m < 4; ++m)
#pragma unroll
                for (int n = 0; n < 2; ++n) acc[a][b][m][n] = (f32x4){0.f, 0.f, 0.f, 0.f};
    bf16x8 At[4][2], B0[2][2], B1[2][2];
    const char* cA = (const char*)g.A + (size_t)cur.pm * tstepA + cur.ao; const char* cB = (const char*)g.Bt + (size_t)cur.pn * tstepB;
    S.a_ready(cur);
    if constexpr (SP2) {
        if constexpr (AG) { PG8_GLOAD(gc, 0); }
        PG8_STAGE(PG8_SB(0, 0), cB, voffB); PG8_STAGE(PG8_SB(0, 1), cB + hstepB, voffB);
        if constexpr (AG) { PG8_STAGE_G(PG8_SA(0, 0), 0, gc[0]); PG8_STAGE_G(PG8_SA(0, 1), 0, gc[1]); } else { PG8_STAGE(PG8_SA(0, 0), cA, voffA); PG8_STAGE(PG8_SA(0, 1), cA + hstepA, voffA); }
        if (wr == 1) PG8_BAR;
        PG8_WAIT_V(2); PG8_BAR;
        PG8_STAGE(PG8_SB(1, 0), cB + kstep, voffB);
        if constexpr (AG) PG8_STAGE_G(PG8_SA(1, 0), kstep, gc[0]); else PG8_STAGE(PG8_SA(1, 0), cA + kstep, voffA);
        PG8_STAGE(PG8_SB(1, 1), cB + hstepB + kstep, voffB);
        PG8_WAIT_V(6); PG8_BAR;
    } else {
        PG8_STAGE(PG8_SB(0, 0), cB, voffB); PG8_STAGE(PG8_SA(0, 0), cA, voffA); PG8_STAGE(PG8_SB(0, 1), cB + hstepB, voffB); PG8_STAGE(PG8_SA(0, 1), cA + hstepA, voffA);
        if (wr == 1) PG8_BAR;
        PG8_WAIT_V(4); PG8_BAR;
        PG8_STAGE(PG8_SB(1, 0), cB + kstep, voffB); PG8_STAGE(PG8_SA(1, 0), cA + kstep, voffA); PG8_STAGE(PG8_SB(1, 1), cB + hstepB + kstep, voffB);
        PG8_WAIT_V(6); PG8_BAR;
    }
    for (;;) {
        const bool has_next = S.next(ui + 1, nxt);
        const char* nA = has_next ? (const char*)g.A + (size_t)nxt.pm * tstepA + nxt.ao : cA; const char* nB = has_next ? (const char*)g.Bt + (size_t)nxt.pn * tstepB : cB;
        if constexpr (AG) { if (has_next) { PG8_GLOAD(gn, ui + 1); } else {
#pragma unroll
            for (int h_ = 0; h_ < 2; ++h_)
#pragma unroll
                for (int i_ = 0; i_ < 2; ++i_) gn[h_][i_] = gc[h_][i_]; } }
        for (int t = 0; t < nt; t += 2) {
            const bool last = (t == nt - 2);
            const char* a1 = cA + (size_t)(t + 1) * kstep;
            const char* a2 = last ? nA : cA + (size_t)(t + 2) * kstep; const char* b2 = last ? nB : cB + (size_t)(t + 2) * kstep;
            const char* a3 = a2 + kstep; const char* b3 = b2 + kstep;
            if (last && has_next) S.a_ready(nxt);
            unsigned g2[2][2]; size_t k2 = 0;
            if constexpr (AG) {
#pragma unroll
                for (int h_ = 0; h_ < 2; ++h_)
#pragma unroll
                    for (int i_ = 0; i_ < 2; ++i_) g2[h_][i_] = last ? gn[h_][i_] : gc[h_][i_];
                k2 = last ? (size_t)0 : (size_t)(t + 2) * kstep;
            }
            if constexpr (SP2) {
            PG8_LDB(B0, 0, 0); PG8_LDB(B1, 0, 1); PG8_SCHED; PG8_LDA(At, 0, 0); if constexpr (AG) PG8_STAGE_G(PG8_SA(1, 1), (size_t)(t + 1) * kstep, gc[1]); else PG8_STAGE(PG8_SA(1, 1), a1 + hstepA, voffA);
            PG8_WAIT_V(8); PG8_WAIT_L(0); PG8_BAR; PG8_MMA(0, 0, At, B0); PG8_MMA(0, 1, At, B1); PG8_BAR; PG8_SCHED;
            PG8_LDA(At, 0, 1); PG8_STAGE(PG8_SB(0, 0), b2, voffB); PG8_STAGE(PG8_SB(0, 1), b2 + hstepB, voffB); if constexpr (AG) PG8_STAGE_G(PG8_SA(0, 0), k2, g2[0]); else PG8_STAGE(PG8_SA(0, 0), a2, voffA);
            PG8_WAIT_V(8); PG8_WAIT_L(0); PG8_BAR; PG8_MMA(1, 0, At, B0); PG8_MMA(1, 1, At, B1); PG8_BAR; PG8_SCHED;
            PG8_LDB(B0, 1, 0); PG8_LDB(B1, 1, 1); PG8_SCHED; PG8_LDA(At, 1, 0); if constexpr (AG) PG8_STAGE_G(PG8_SA(0, 1), k2, g2[1]); else PG8_STAGE(PG8_SA(0, 1), a2 + hstepA, voffA);
            PG8_WAIT_V(8); PG8_WAIT_L(0); PG8_BAR; PG8_MMA(0, 0, At, B0); PG8_MMA(0, 1, At, B1); PG8_BAR; PG8_SCHED;
            PG8_LDA(At, 1, 1); PG8_STAGE(PG8_SB(1, 0), b3, voffB); PG8_STAGE(PG8_SB(1, 1), b3 + hstepB, voffB); if constexpr (AG) PG8_STAGE_G(PG8_SA(1, 0), k2 + kstep, g2[0]); else PG8_STAGE(PG8_SA(1, 0), a3, voffA);
            PG8_WAIT_V(8); PG8_WAIT_L(0); PG8_BAR; PG8_MMA(1, 0, At, B0); PG8_MMA(1, 1, At, B1); PG8_BAR; PG8_SCHED;
            } else {
            PG8_LDB(B0, 0, 0); PG8_SCHED; PG8_LDA(At, 0, 0); PG8_STAGE(PG8_SA(1, 1), a1 + hstepA, voffA);
            PG8_WAIT_L(8); PG8_BAR; PG8_WAIT_L(0); PG8_MMA(0, 0, At, B0); PG8_BAR; PG8_SCHED;
            PG8_LDB(B1, 0, 1); PG8_STAGE(PG8_SB(0, 0), b2, voffB);
            PG8_BAR; PG8_WAIT_L(0); PG8_MMA(0, 1, At, B1); PG8_BAR;
            PG8_LDA(At, 0, 1); PG8_STAGE(PG8_SA(0, 0), a2, voffA);
            PG8_BAR; PG8_WAIT_L(0); PG8_MMA(1, 0, At, B0); PG8_BAR; PG8_SCHED;
            PG8_STAGE(PG8_SB(0, 1), b2 + hstepB, voffB);
            PG8_WAIT_V(6); PG8_BAR; PG8_MMA(1, 1, At, B1); PG8_BAR;
            PG8_LDB(B0, 1, 0); PG8_SCHED; PG8_LDA(At, 1, 0); PG8_STAGE(PG8_SA(0, 1), a2 + hstepA, voffA);
            PG8_WAIT_L(8); PG8_BAR; PG8_WAIT_L(0); PG8_MMA(0, 0, At, B0); PG8_BAR; PG8_SCHED;
            PG8_LDB(B1, 1, 1); PG8_STAGE(PG8_SB(1, 0), b3, voffB);
            PG8_BAR; PG8_WAIT_L(0); PG8_MMA(0, 1, At, B1); PG8_BAR;
            PG8_LDA(At, 1, 1); PG8_STAGE(PG8_SA(1, 0), a3, voffA);
            PG8_BAR; PG8_WAIT_L(0); PG8_MMA(1, 0, At, B0); PG8_BAR; PG8_SCHED;
            PG8_STAGE(PG8_SB(1, 1), b3 + hstepB, voffB);
            PG8_WAIT_V(6); PG8_BAR; PG8_MMA(1, 1, At, B1); PG8_BAR;
            }
        }
        if constexpr (ALIGN_EPI) { if (wr == 0) PG8_BAR; }
        if constexpr (!Epi::AFTER_DRAIN) { E(acc, cur, wr, wc, fr, fq); S.done(cur); }
        if (!has_next) break;
#pragma unroll
        for (int a = 0; a < 2; ++a)
#pragma unroll
            for (int b = 0; b < 2; ++b)
#pragma unroll
                for (int m = 0; m < 4; ++m)
#pragma unroll
                    for (int n = 0; n < 2; ++n) acc[a][b][m][n] = (f32x4){0.f, 0.f, 0.f, 0.f};
        cur = nxt; cA = nA; cB = nB; ++ui;
        if constexpr (AG) {
#pragma unroll
            for (int h_ = 0; h_ < 2; ++h_)
#pragma unroll
                for (int i_ = 0; i_ < 2; ++i_) gc[h_][i_] = gn[h_][i_]; }
        if constexpr (ALIGN_EPI) { if (wr == 1) PG8_BAR; }
    }
    PG8_WAIT_V(0);
    if constexpr (!ALIGN_EPI) { if (wr == 0) PG8_BAR; }
    PG8_BAR;
    if constexpr (Epi::AFTER_DRAIN) { E.fused(acc, cur, wr, wc, fr, fq, lds, wid, lane); S.done(cur); }
#undef PG8_SA
#undef PG8_SB
#undef PG8_STAGE
#undef PG8_STAGE_G
#undef PG8_GLOAD
#undef PG8_LDA
#undef PG8_LDB
#undef PG8_MMA
#undef PG8_WAIT_V
#undef PG8_WAIT_L
#undef PG8_BAR
#undef PG8_SCHED
}
}


#ifndef SEL16
#define SEL16 1
#endif
#ifndef SEL_GATHER
#define SEL_GATHER 0
#endif
#ifndef T5_STATIC
#define T5_STATIC 0
#endif
#ifndef T5_PRIO
#define T5_PRIO 0
#endif
#ifndef PREQK
#define PREQK 0
#endif
#ifndef AT_VAR
#define AT_VAR 0
#endif
#ifndef AT_STAG
#define AT_STAG 0
#endif
#ifndef AT_STAG_MODE
#define AT_STAG_MODE 0
#endif
#ifndef V_AFTER_QK
#define V_AFTER_QK 1
#endif
#ifndef AT_NO_BARRIER
#define AT_NO_BARRIER 0
#endif
#ifndef SEL_NS
#define SEL_NS 8
#endif
#ifndef SEL_PRIME
#define SEL_PRIME 0
#endif
#ifndef MOE_GATHER
#define MOE_GATHER 1
#endif
#ifndef DIL_NS
#define DIL_NS 4
#endif
#ifndef DIL_PRIV
#define DIL_PRIV 1
#endif
#ifndef DEFER_THR
#define DEFER_THR 8
#endif
#ifndef SEL_SPREAD
#define SEL_SPREAD 1
#endif
#ifndef CMP_SPLITK
#define CMP_SPLITK 1
#endif
#ifndef AT_NO_COMPUTE
#define AT_NO_COMPUTE 0
#endif
#ifndef NSA_SKIP_SEL
#define NSA_SKIP_SEL 0
#endif
#ifndef NSA_SKIP_TOPK
#define NSA_SKIP_TOPK 0
#endif
#ifndef NSA_SKIP_CMP
#define NSA_SKIP_CMP 0
#endif
#ifndef NSA_SKIP_WIN
#define NSA_SKIP_WIN 0
#endif
#ifndef PROBE_A
#define PROBE_A 0
#endif
#ifndef PROBE_OFF
#define PROBE_OFF 0
#endif
#ifndef PROBE_DIV
#define PROBE_DIV 100
#endif
#ifndef PROBE_B
#define PROBE_B 0
#endif
#define STAMP(k) do { if ((PROBE_A || PROBE_B) && blockIdx.x == 0 && threadIdx.x == 0) { ((unsigned long long*)(a.ws + 2048))[k] = __builtin_amdgcn_s_memrealtime(); ((unsigned long long*)(a.ws + 2048))[32 + (k)] = __builtin_amdgcn_s_memtime(); } } while (0)
#define LAS __attribute__((address_space(3)))
#define DI __device__ __forceinline__
__device__ __forceinline__ int opaque_tid() { int t = threadIdx.x; asm volatile("" : "+v"(t)); return t; }
typedef unsigned short bf16_t;
typedef short bf16x8 __attribute__((ext_vector_type(8)));
typedef float f32x4 __attribute__((ext_vector_type(4)));
typedef float f32x16 __attribute__((ext_vector_type(16)));
typedef float f32x2 __attribute__((ext_vector_type(2)));
typedef __bf16 bf16x2n __attribute__((ext_vector_type(2)));
typedef unsigned u32x4 __attribute__((ext_vector_type(4)));
typedef unsigned u32x2 __attribute__((ext_vector_type(2)));

constexpr int D = 1024, NB = 2, S = 16384, NTOK = NB * S, NG = 4;
constexpr int NSA_N = 2608, NSA_NP = 2816, DIL_N = 2560;
constexpr int NE = 32, FE = 512;
constexpr int ROWS_PAD = 73728;
constexpr float ALPHA = 1.41421356237309515f, LN_EPS = 1e-5f, LOG2E = 1.4426950408889634f;
constexpr int NWAVES = 8, NTHREADS = 512;
constexpr int LDS_BYTES = 147456;
constexpr int RING_BYTES = 131072;

constexpr size_t MiB = 1u << 20;
constexpr size_t WS_CTL = 0;
constexpr size_t CTL_ZERO_BYTES = 32768;
constexpr int CW_BAR = 4096;
constexpr size_t WS_MOD = 1 * MiB;
constexpr size_t WS_CBIAS = 1 * MiB + 128 * 1024;
constexpr size_t WS_ROPE = 2 * MiB;
constexpr size_t WS_EIDX = 4 * MiB;
constexpr size_t WS_EWT = 4 * MiB + 256 * 1024;
constexpr size_t WS_ROWTOK = 4 * MiB + 512 * 1024;
constexpr size_t WS_ROWW = 5 * MiB + 128 * 1024;
constexpr size_t WS_WIN0T = 6 * MiB;
constexpr size_t WS_WO0T = 12 * MiB;
constexpr size_t WS_WIN1T = 14 * MiB;
constexpr size_t WS_WO1T = 19 * MiB;
constexpr size_t WS_CW1T = 21 * MiB;
constexpr size_t WS_KC = 23 * MiB;
constexpr size_t WS_VCT = 24 * MiB;
constexpr size_t WS_G = 25 * MiB;
constexpr size_t WS_HID = 31 * MiB;
constexpr size_t WS_GUT = 40 * MiB;
constexpr size_t WS_DNT = 104 * MiB;
constexpr size_t WS_HM = 136 * MiB;
constexpr size_t WS_Q = 200 * MiB;
constexpr size_t WS_KV = 264 * MiB;
constexpr size_t KVB = 16 * MiB;
constexpr size_t WS_AO = 360 * MiB;
constexpr size_t WS_HS = 200 * MiB;
constexpr size_t WS_HH = 344 * MiB;
constexpr size_t WS_Y = 200 * MiB;
constexpr size_t WS_XB = 424 * MiB;
constexpr size_t WS_CMPP = 488 * MiB;
constexpr size_t WS_END = 520 * MiB;
constexpr int CW_CNT = 0;
constexpr int CW_CUR = 64;

struct Args {
    const float* x; const float* c; const int* pos; const float* ada_w; const float* ada_b; const float* ln_g; const float* ln_b;
    const float* nsa_w_in; const float* cpos_k; const float* cw1_k; const float* cw2_k; const float* cpos_v; const float* cw1_v; const float* cw2_v;
    const float* nsa_w_o; const float* dil_w_in; const float* dil_w_o; const float* router_w; const float* router_b;
    const float* moe_wg; const float* moe_wu; const float* moe_wd;
    float* out; unsigned char* ws;
};

DI unsigned pk2(float lo, float hi) { f32x2 v = {lo, hi}; return __builtin_bit_cast(unsigned, __builtin_convertvector(v, bf16x2n)); }
DI float bf2f(unsigned short b) { return __builtin_bit_cast(float, (unsigned)b << 16); }
#define DPPF(x, ctrl, rmask) __builtin_bit_cast(float, __builtin_amdgcn_update_dpp(0, __builtin_bit_cast(int, (x)), (ctrl), (rmask), 0xf, true))
DI float wave_sum(float v) {
    v += DPPF(v, 0x111, 0xf); v += DPPF(v, 0x112, 0xf); v += DPPF(v, 0x114, 0xf); v += DPPF(v, 0x118, 0xf);
    v += DPPF(v, 0x142, 0xa); v += DPPF(v, 0x143, 0xc);
    return __builtin_bit_cast(float, __builtin_amdgcn_readlane(__builtin_bit_cast(int, v), 63));
}
DI int vperm32(int l) { return (l & ~31) | (((l >> 2) & 3) << 3) | (((l >> 4) & 1) << 2) | (l & 3); }
DI int vperm(int l) { return (l & ~12) | ((l & 4) << 1) | ((l & 8) >> 1); }

DI unsigned wave_umax(unsigned v) {
    v = max(v, (unsigned)__builtin_amdgcn_update_dpp(0, (int)v, 0x111, 0xf, 0xf, true));
    v = max(v, (unsigned)__builtin_amdgcn_update_dpp(0, (int)v, 0x112, 0xf, 0xf, true));
    v = max(v, (unsigned)__builtin_amdgcn_update_dpp(0, (int)v, 0x114, 0xf, 0xf, true));
    v = max(v, (unsigned)__builtin_amdgcn_update_dpp(0, (int)v, 0x118, 0xf, 0xf, true));
    v = max(v, (unsigned)__builtin_amdgcn_update_dpp(0, (int)v, 0x142, 0xa, 0xf, true));
    v = max(v, (unsigned)__builtin_amdgcn_update_dpp(0, (int)v, 0x143, 0xc, 0xf, true));
    return (unsigned)__builtin_amdgcn_readlane((int)v, 63);
}
DI float fmx(float a, float b) { return __builtin_elementwise_maximum(a, b); }
DI float xh32_max(float v) { unsigned x_ = __builtin_bit_cast(unsigned, v), y_ = x_; asm volatile("s_nop 1\n\tv_permlane32_swap_b32 %0, %1" : "+v"(x_), "+v"(y_)); return fmx(__builtin_bit_cast(float, x_), __builtin_bit_cast(float, y_)); }
DI float xh16_max(float v) { unsigned x_ = __builtin_bit_cast(unsigned, v), y_ = x_; asm volatile("s_nop 1\n\tv_permlane16_swap_b32 %0, %1" : "+v"(x_), "+v"(y_)); return fmx(__builtin_bit_cast(float, x_), __builtin_bit_cast(float, y_)); }
DI float sigmoidf_(float v) { return 1.f / (1.f + __expf(-v)); }
#define MFMA32(a, b, c) __builtin_amdgcn_mfma_f32_32x32x16_bf16((a), (b), (c), 0, 0, 0)

DI void transpose_item(const float* src, int ldn, int nvalid, bf16_t* dst, int ldk, LAS float* scr, int lane) {
    const int nn = lane & 31;
#pragma unroll 8
    for (int i = 0; i < 32; ++i) { const int kk = 2 * i + (lane >> 5); scr[kk * 33 + nn] = (nn < nvalid) ? src[(size_t)kk * ldn + nn] : 0.f; }
    asm volatile("s_waitcnt lgkmcnt(0)" ::: "memory");
    const int c = lane & 7;
#pragma unroll
    for (int j = 0; j < 4; ++j) { const int n = (lane >> 3) + 8 * j; const LAS float* s = scr + (8 * c) * 33 + n;
        u32x4 o; o.x = pk2(s[0 * 33], s[1 * 33]); o.y = pk2(s[2 * 33], s[3 * 33]); o.z = pk2(s[4 * 33], s[5 * 33]); o.w = pk2(s[6 * 33], s[7 * 33]);
        *(u32x4*)(dst + (size_t)n * ldk + 8 * c) = o; }
    asm volatile("s_waitcnt lgkmcnt(0)" ::: "memory");
}
DI void transpose_plain(const float* W, int K, int N, int Npad, bf16_t* WT, LAS float* scr, int item, int lane) {
    const int nblk = Npad / 32, kb = item / nblk, nb = item % nblk, k0 = 64 * kb, n0 = 32 * nb;
    int nvalid = N - n0; nvalid = nvalid < 0 ? 0 : (nvalid > 32 ? 32 : nvalid);
    transpose_item(W + (size_t)k0 * N + (nvalid > 0 ? n0 : 0), N, nvalid, WT + (size_t)n0 * K + k0, K, scr, lane);
}
constexpr int MOE_ITEMS_GU = NE * 16 * 16;
constexpr int MOE_ITEMS_DN = NE * 8 * 32;
constexpr int MOE_ITEMS = 2 * MOE_ITEMS_GU + MOE_ITEMS_DN;
DI void moe_convert_item(const float* wg, const float* wu, const float* wd, bf16_t* GUT, bf16_t* DNT, LAS float* scr, int item, int lane) {
    if (item < 2 * MOE_ITEMS_GU) {
        const int up = item >= MOE_ITEMS_GU; int r = up ? item - MOE_ITEMS_GU : item;
        const int e = r >> 8, kb = (r >> 4) & 15, nb = r & 15, k0 = 64 * kb, n0 = 32 * nb;
        const float* W = (up ? wu : wg) + (size_t)e * D * FE;
        const int row0 = e * 1024 + (n0 >> 7) * 256 + up * 128 + (n0 & 127);
        transpose_item(W + (size_t)k0 * FE + n0, FE, 32, GUT + (size_t)row0 * D + k0, D, scr, lane);
    } else {
        const int r = item - 2 * MOE_ITEMS_GU; const int e = r >> 8, kb = (r >> 5) & 7, nb = r & 31, k0 = 64 * kb, n0 = 32 * nb;
        const float* W = wd + (size_t)e * FE * D;
        transpose_item(W + (size_t)k0 * D + n0, D, 32, DNT + ((size_t)e * 1024 + n0) * FE + k0, FE, scr, lane);
    }
}

DI f32x4 bf4_to_f4(u32x2 w) { f32x4 r; r.x = bf2f((unsigned short)(w.x & 0xffffu)); r.y = bf2f((unsigned short)(w.x >> 16)); r.z = bf2f((unsigned short)(w.y & 0xffffu)); r.w = bf2f((unsigned short)(w.y >> 16)); return r; }
DI void hmod_row(const float* xrow, const float* modb  , bf16_t* orow, int lane) {
#pragma unroll
    for (int j = 0; j < 4; ++j) {
        const int col = 4 * lane + 256 * j;
        const f32x4 v = *(const f32x4*)(xrow + col), sh = *(const f32x4*)(modb + col), sc = *(const f32x4*)(modb + D + col);
        u32x2 o; o.x = pk2(v.x * (1.f + sc.x) + sh.x, v.y * (1.f + sc.y) + sh.y); o.y = pk2(v.z * (1.f + sc.z) + sh.z, v.w * (1.f + sc.w) + sh.w);
        *(u32x2*)(orow + col) = o;
    }
}

using pg8::Unit;
constexpr int HALF = 128;
#define EPI_ROWS(u, wr, fr, ai, m) ((u).pm * 256 + (ai) * 128 + (wr) * 64 + (m) * 16 + (fr))

DI void rope8(f32x4& v0, f32x4& v1, const float* cs  , int fq, bool active) {
    f32x4 p0, p1;
#pragma unroll
    for (int j = 0; j < 4; ++j) { p0[j] = __shfl_xor(v0[j], 16); p1[j] = __shfl_xor(v1[j], 16); }
    if (active) {
        const f32x4 c0 = *(const f32x4*)(cs), c1 = *(const f32x4*)(cs + 4), s0 = *(const f32x4*)(cs + 8), s1 = *(const f32x4*)(cs + 12);
        if (fq == 0) { v0 = v0 * c0 - p0 * s0; v1 = v1 * c1 - p1 * s1; }
        else         { v0 = p0 * s0 + v0 * c0; v1 = p1 * s1 + v1 * c1; }
    }
}

#ifndef PROJ1_PERM
#define PROJ1_PERM 1
#endif
DI int proj1_tok(int R) { return PROJ1_PERM ? (R & ~16383) + ((R & 4095) << 2) + ((R >> 12) & 3) : R; }
template <int LAYER> struct EpiProj {
    static constexpr bool PERM = true, AFTER_DRAIN = false;
    unsigned char* ws; const float* rope;
    DI void operator()(const f32x4 (&acc)[2][2][4][2], const Unit& u, int wr, int wc, int fr, int fq) const {
#ifdef EPI_OFF
        _Pragma("unroll") for (int ai = 0; ai < 2; ++ai) _Pragma("unroll") for (int bj = 0; bj < 2; ++bj) _Pragma("unroll") for (int m = 0; m < 4; ++m) { asm volatile("" :: "v"(acc[ai][bj][m][0]), "v"(acc[ai][bj][m][1])); }
        return;
#endif
        const int pn = u.pn;
        int kind, p = 0;
        if (pn < 4) kind = 0;
        else if (LAYER == 0) { if (pn == 10) kind = 5; else { p = (pn - 4) >> 1; const int isv = (pn - 4) & 1; kind = isv ? (p == 0 ? 3 : 4) : (p == 0 ? 2 : 1); } }
        else { p = (pn - 4) >> 1; kind = ((pn - 4) & 1) ? 4 : 1; }
        const int dil_sh = LAYER == 1 ? 2 * p : 0;
        const int Lp = S >> dil_sh;
        if (kind <= 3) {
            const bool do_rope = (kind <= 1) && ((wc & 1) == 0);
            const bool rope_lane = do_rope && fq < 2;
            const float qs = kind == 0 ? 0.125f : 1.f;
            bf16_t* base = kind == 0 ? (bf16_t*)(ws + WS_Q) : (bf16_t*)(ws + WS_KV + (size_t)(2 * p + (kind == 3 ? 1 : 0)) * KVB);
#pragma unroll
            for (int ai = 0; ai < 2; ++ai)
#pragma unroll
                for (int m = 0; m < 4; ++m) {
                    asm volatile("" ::: "memory");
                    const int row = LAYER == 1 ? proj1_tok(EPI_ROWS(u, wr, fr, ai, m)) : EPI_ROWS(u, wr, fr, ai, m);
                    const int b = row >> 14, t = row & (S - 1);
                    const float* cs = rope + (size_t)row * 16;
                    const int res = t & ((1 << dil_sh) - 1), l = t >> dil_sh;
#pragma unroll
                    for (int bj = 0; bj < 2; ++bj) {
                        f32x4 v0 = acc[ai][bj][m][0], v1 = acc[ai][bj][m][1];
                        const int cl = bj * 128 + wc * 32 + fq * 8;
                        if (do_rope) rope8(v0, v1, cs, fq, rope_lane);
                        v0 = v0 * qs; v1 = v1 * qs;
                        u32x4 w; w.x = pk2(v0[0], v0[1]); w.y = pk2(v0[2], v0[3]); w.z = pk2(v1[0], v1[1]); w.w = pk2(v1[2], v1[3]);
                        bf16_t* dst = kind == 0 ? base + (size_t)row * D + pn * 256 + cl
                                                : base + ((size_t)(b * NG + (cl >> 6)) * S + res * Lp + l) * 64 + (cl & 63);
                        *(u32x4*)dst = w;
                    }
                }
        } else if (kind == 4) {
            bf16_t* base = (bf16_t*)(ws + WS_KV + (size_t)(2 * p + 1) * KVB);
#pragma unroll
            for (int ai = 0; ai < 2; ++ai)
#pragma unroll
                for (int m = 0; m < 4; ++m) {
                    asm volatile("" ::: "memory");
                    const int row = LAYER == 1 ? proj1_tok(EPI_ROWS(u, wr, fr, ai, m)) : EPI_ROWS(u, wr, fr, ai, m);
                    const int b = row >> 14, t = row & (S - 1);
                    const int res = t & ((1 << dil_sh) - 1), l = t >> dil_sh;
#pragma unroll
                    for (int bj = 0; bj < 2; ++bj) {
                        const f32x4 v0 = acc[ai][bj][m][0], v1 = acc[ai][bj][m][1];
                        const int cl = bj * 128 + wc * 32 + fq * 8, g = cl >> 6, dim = cl & 63;
                        const int rowi = res * Lp + l;
                        bf16_t* vp = base + (size_t)(b * NG + g) * S * 64 + (size_t)(rowi >> 6) * 4096 + dim * 64 + ((LAYER == 0 && p == 1 && SEL16) ? vperm32(rowi & 63) : vperm(rowi & 63));
#pragma unroll
                        for (int j = 0; j < 4; ++j) { vp[j * 64] = (bf16_t)(pk2(v0[j], 0.f) & 0xffffu); vp[(4 + j) * 64] = (bf16_t)(pk2(v1[j], 0.f) & 0xffffu); }
                    }
                }
        } else {
            const int cl = wc * 32 + fq * 8;
            if (cl < 48) {
#pragma unroll
                for (int ai = 0; ai < 2; ++ai)
#pragma unroll
                    for (int m = 0; m < 4; ++m) {
                        const int row = EPI_ROWS(u, wr, fr, ai, m);
                        float* gp = (float*)(ws + WS_G) + (size_t)row * 48 + cl;
                        f32x4 g0, g1;
#pragma unroll
                        for (int j = 0; j < 4; ++j) { g0[j] = sigmoidf_(acc[ai][0][m][0][j]); g1[j] = sigmoidf_(acc[ai][0][m][1][j]); }
                        *(f32x4*)gp = g0; *(f32x4*)(gp + 4) = g1;
                    }
            }
        }
    }
};

struct EpiCmp1 {
    static constexpr bool PERM = true, AFTER_DRAIN = false;
    bf16_t* hid; const float* bias;
    DI void operator()(const f32x4 (&acc)[2][2][4][2], const Unit& u, int wr, int wc, int fr, int fq) const {
        const int kv = u.pn;
#pragma unroll
        for (int bj = 0; bj < 2; ++bj) {
            const int cl = bj * 128 + wc * 32 + fq * 8;
            const f32x4 b0 = *(const f32x4*)(bias + kv * 256 + cl), b1 = *(const f32x4*)(bias + kv * 256 + cl + 4);
#pragma unroll
            for (int ai = 0; ai < 2; ++ai)
#pragma unroll
                for (int m = 0; m < 4; ++m) {
                    const int row = EPI_ROWS(u, wr, fr, ai, m);
                    f32x4 v0 = acc[ai][bj][m][0] + b0, v1 = acc[ai][bj][m][1] + b1;
#pragma unroll
                    for (int j = 0; j < 4; ++j) {
                        float x = v0[j]; v0[j] = 0.5f * x * (1.f + tanhf(0.7978845608028654f * (x + 0.044715f * x * x * x)));
                        x = v1[j];       v1[j] = 0.5f * x * (1.f + tanhf(0.7978845608028654f * (x + 0.044715f * x * x * x)));
                    }
                    u32x4 w; w.x = pk2(v0[0], v0[1]); w.y = pk2(v0[2], v0[3]); w.z = pk2(v1[0], v1[1]); w.w = pk2(v1[2], v1[3]);
                    *(u32x4*)(hid + (size_t)row * 256 + cl) = w;
                }
        }
    }
};

struct EpiCmpP {
    static constexpr bool PERM = true, AFTER_DRAIN = false;
    float* P;
    DI void operator()(const f32x4 (&acc)[2][2][4][2], const Unit& u, int wr, int wc, int fr, int fq) const {
        float* base = P + (size_t)(u.pn & 1) * 16384 * 256;
#pragma unroll
        for (int bj = 0; bj < 2; ++bj) {
            const int cl = bj * 128 + wc * 32 + fq * 8;
#pragma unroll
            for (int ai = 0; ai < 2; ++ai)
#pragma unroll
                for (int m = 0; m < 4; ++m) {
                    const int row = EPI_ROWS(u, wr, fr, ai, m);
                    *(f32x4*)(base + (size_t)row * 256 + cl) = acc[ai][bj][m][0]; *(f32x4*)(base + (size_t)row * 256 + cl + 4) = acc[ai][bj][m][1];
                }
        }
    }
};

struct EpiWo {
    static constexpr bool PERM = true, AFTER_DRAIN = false;
    bf16_t* Y;
    DI void operator()(const f32x4 (&acc)[2][2][4][2], const Unit& u, int wr, int wc, int fr, int fq) const {
#pragma unroll
        for (int ai = 0; ai < 2; ++ai)
#pragma unroll
            for (int m = 0; m < 4; ++m) {
                bf16_t* yr = Y + (size_t)EPI_ROWS(u, wr, fr, ai, m) * D + u.pn * 256 + wc * 32 + fq * 8;
#pragma unroll
                for (int bj = 0; bj < 2; ++bj) {
                    const f32x4 v0 = acc[ai][bj][m][0], v1 = acc[ai][bj][m][1];
                    u32x4 o; o.x = pk2(v0[0], v0[1]); o.y = pk2(v0[2], v0[3]); o.z = pk2(v1[0], v1[1]); o.w = pk2(v1[2], v1[3]);
                    *(u32x4*)(yr + bj * 128) = o;
                }
            }
    }
};

struct EpiGU {
    static constexpr bool PERM = true, AFTER_DRAIN = false;
    bf16_t* hh;
    DI void operator()(const f32x4 (&acc)[2][2][4][2], const Unit& u, int wr, int wc, int fr, int fq) const {
        const int col = (u.pn & 3) * 128 + wc * 32 + fq * 8;
#pragma unroll
        for (int ai = 0; ai < 2; ++ai)
#pragma unroll
            for (int m = 0; m < 4; ++m) {
                const int row = EPI_ROWS(u, wr, fr, ai, m);
                f32x4 h0, h1;
#pragma unroll
                for (int j = 0; j < 4; ++j) {
                    const float g0 = acc[ai][0][m][0][j], g1 = acc[ai][0][m][1][j];
                    h0[j] = g0 / (1.f + __expf(-g0)) * acc[ai][1][m][0][j];
                    h1[j] = g1 / (1.f + __expf(-g1)) * acc[ai][1][m][1][j];
                }
                u32x4 w; w.x = pk2(h0[0], h0[1]); w.y = pk2(h0[2], h0[3]); w.z = pk2(h1[0], h1[1]); w.w = pk2(h1[2], h1[3]);
                *(u32x4*)(hh + (size_t)row * FE + col) = w;
            }
    }
};

struct EpiDown {
    static constexpr bool PERM = true, AFTER_DRAIN = false;
    bf16_t* Y; const int* row_tok; const float* row_w;
    DI void operator()(const f32x4 (&acc)[2][2][4][2], const Unit& u, int wr, int wc, int fr, int fq) const {
#pragma unroll
        for (int ai = 0; ai < 2; ++ai)
#pragma unroll
            for (int m = 0; m < 4; ++m) {
                const int row = EPI_ROWS(u, wr, fr, ai, m);
                const int tk = row_tok[row];
                if (tk < 0) continue;
                const float w = row_w[row];
                bf16_t* yr = Y + ((size_t)(tk & 1) * NTOK + (tk >> 1)) * D + (u.pn & 3) * 256 + wc * 32 + fq * 8;
#pragma unroll
                for (int bj = 0; bj < 2; ++bj) {
                    const f32x4 v0 = acc[ai][bj][m][0] * w, v1 = acc[ai][bj][m][1] * w;
                    u32x4 o; o.x = pk2(v0[0], v0[1]); o.y = pk2(v0[2], v0[3]); o.z = pk2(v1[0], v1[1]); o.w = pk2(v1[2], v1[3]);
                    *(u32x4*)(yr + bj * 128) = o;
                }
            }
    }
};

struct CmpOrder {
    int G, c;
    DI bool next(int i, Unit& u) const { const int L = i * G + c; if (L >= 64) return false; u.pm = L; u.pn = L >> 5; return true; }
    DI void a_ready(const Unit&) const {}
    DI void done(const Unit&) const {}
};
struct CmpOrder2 {
    int G, c;
    DI bool next(int i, Unit& u) const { const int L = i * G + c; if (L >= 128) return false; const int half = L & 1; u.pm = L >> 1; u.pn = (u.pm >> 5) * 2 + half; u.ao = half * 2048; return true; }
    DI void a_ready(const Unit&) const {}
    DI void done(const Unit&) const {}
};
struct MoeOrder {
    const LAS int* tstart; int G, c;
    DI bool next(int i, Unit& u) const {
        const int L = i * G + c; const int nt = tstart[32];
        if (L >= nt * 4) return false;
        const int tile = L >> 2; const int e = ((const LAS unsigned char*)tstart)[2048 + tile];
        u.pm = tile; u.pn = e * 4 + (L & 3); return true;
    }
    DI void a_ready(const Unit&) const {}
    DI void done(const Unit&) const {}
};

constexpr int AT_KV_BYTES = 16384;
constexpr int AT_NSLOT = 4;
constexpr int AT_IMP_OFF = AT_NSLOT * AT_KV_BYTES;
constexpr int AT_IMP_STRIDE = 260;
constexpr int AT_CNT_OFF = 146496;
constexpr int AT_SEL_OFF = AT_IMP_OFF + 64 * AT_IMP_STRIDE * 4;
static_assert(AT_SEL_OFF + 64 * 8 * 4 <= 143360, "attention LDS map");

struct AttnSt { f32x16 o[2]; float m, l; };


#define AT_ISSUE_V true
#define AT_ISSUE(tile, slot) do { \
        __builtin_amdgcn_global_load_lds((const unsigned*)(ksrc + (size_t)(tile) * 64 * 64), (LAS unsigned*)(wbase + (slot) * AT_KV_BYTES), 16, 0, 0); \
        if (AT_ISSUE_V) __builtin_amdgcn_global_load_lds((const unsigned*)(vsrc + (size_t)(tile) * 64 * 64), (LAS unsigned*)(wbase + (slot) * AT_KV_BYTES + 8192), 16, 0, 0); } while (0)

#undef AT_ISSUE_V
#define AT_ISSUE_V (MODE != 1)
template <int MODE, bool SEL, int NS = 4>
DI void attn_loop(LAS unsigned char* lds, const bf16_t* Kb, const bf16_t* VTb, int tile_lo, int tile_hi,
                  const bf16x8 (&qf)[4], int lo_c, int hi_c, AttnSt& st, float inv_l, int tok_local, int t_col, LAS float* imp_row) {
    const int tid = opaque_tid(), lane = tid & 63, r = lane & 31, h = lane >> 5, sw = (r >> 1) & 7;
    const int wave_u = __builtin_amdgcn_readfirstlane(tid >> 6);
    if (tile_lo > tile_hi) return;
    const float l2inv = (MODE == 2) ? __builtin_amdgcn_logf(inv_l) : 0.f;
    const int srow = tid >> 3, lc = (tid & 7) ^ ((srow >> 1) & 7);
    const bf16_t* ksrc = Kb + (size_t)srow * 64 + lc * 8;
    const bf16_t* vsrc = VTb + (size_t)srow * 64 + lc * 8;
    LAS unsigned char* wbase = lds + wave_u * 1024;
    constexpr bool DEC = false;
    LAS unsigned* cnt = (LAS unsigned*)(lds + AT_CNT_OFF);
    const unsigned cnt_addr = (unsigned)(size_t)cnt;
    asm volatile("s_waitcnt lgkmcnt(0)" ::: "memory");
    __builtin_amdgcn_s_barrier();
    if (DEC) { if (tid < 8) cnt[tid] = 0u; asm volatile("s_waitcnt lgkmcnt(0)" ::: "memory"); __builtin_amdgcn_s_barrier(); }
    constexpr int GRP = NS / 2;
#pragma unroll
    for (int i = 0; i < GRP; ++i) if (tile_lo + i <= tile_hi) AT_ISSUE(tile_lo + i, i);
    if (DEC && tile_lo + 2 <= tile_hi) AT_ISSUE(tile_lo + 2, 2);
#define AT_SIGNAL(idx) do { if (lane == 0) asm volatile("ds_add_u32 %0, %1" :: "v"(cnt_addr + 4u * (unsigned)(idx)), "v"(1u) : "memory"); } while (0)
#define AT_WAIT(idx, target) do { unsigned sp_ = 0; while ((unsigned)__builtin_amdgcn_readfirstlane((int)*(volatile LAS unsigned*)(cnt + (idx))) < (unsigned)(target)) { __builtin_amdgcn_s_sleep(1); if (++sp_ > (1u << 20)) break; } } while (0)
    f32x16 sb0, sb1; bool pre_b = false;
#pragma unroll
    for (int i = 0; i < 16; ++i) { sb0[i] = 0.f; sb1[i] = 0.f; }
#pragma unroll 1
    for (int t = tile_lo; t <= tile_hi; ++t) {
      {
        if (MODE != 1) { const float dep_ = st.o[0][15] + st.o[1][15]; asm volatile("" :: "v"(dep_)); }
        const int rel = t - tile_lo, rem = tile_hi - t;
        if (!DEC) {
            if ((rel & (GRP - 1)) == 0) {
                asm volatile("s_waitcnt vmcnt(0)" ::: "memory");
                __builtin_amdgcn_s_barrier();
#pragma unroll
                for (int i = 0; i < GRP; ++i) if (rem >= GRP + i) AT_ISSUE(t + GRP + i, (rel + GRP + i) & (NS - 1));
                if (AT_STAG && (AT_STAG_MODE ? (wave_u & 1) : (wave_u >= 4))) __builtin_amdgcn_s_sleep(AT_STAG);
            }
        } else {
            if (rem >= 2) asm volatile("s_waitcnt vmcnt(4)" ::: "memory");
            else if (rem == 1) asm volatile("s_waitcnt vmcnt(2)" ::: "memory");
            else asm volatile("s_waitcnt vmcnt(0)" ::: "memory");
            AT_SIGNAL(rel & 3);
            if (rem >= 3) { AT_WAIT(4 + ((rel + 3) & 3), 8 * ((rel + 3) >> 2)); AT_ISSUE(t + 3, (rel + 3) & 3); }
            AT_WAIT(rel & 3, 8 * ((rel >> 2) + 1));
        }
        LAS unsigned char* kb = lds + ((t - tile_lo) & (NS - 1)) * AT_KV_BYTES;
        LAS unsigned char* vb = kb + 8192;
        const int key0 = t * 64;
        int lo = lo_c, hi = hi_c;
        if (SEL) { const unsigned wsel = ((LAS unsigned*)(lds + AT_SEL_OFF))[tok_local * 8 + (t >> 5)]; hi = ((wsel >> (t & 31)) & 1u) ? t_col : -1; }
        const bool act = (key0 + 63 >= lo) && (key0 <= hi);
        if (!AT_NO_COMPUTE && __any(act)) {
            bf16x8 va[4][2];
#define AT_LOAD_V() do { if (MODE != 1) { _Pragma("unroll") for (int sg = 0; sg < 4; ++sg) { \
                    if (AT_VAR == 3) { va[sg][0] = qf[sg]; va[sg][1] = qf[(sg + 1) & 3]; continue; } \
                    va[sg][0] = *(const LAS bf16x8*)(vb + r * 128 + (((2 * sg + h) ^ sw) << 4)); \
                    va[sg][1] = *(const LAS bf16x8*)(vb + 4096 + r * 128 + (((2 * sg + h) ^ sw) << 4)); } } } while (0)
            if (!V_AFTER_QK) AT_LOAD_V();
            f32x16 s0, s1;
            const bool odd = ((t - tile_lo) & 1) != 0;
            if (PREQK && !DEC && !SEL && odd && pre_b) { s0 = sb0; s1 = sb1; }
            else {
#pragma unroll
                for (int i = 0; i < 16; ++i) { s0[i] = 0.f; s1[i] = 0.f; }
                bf16x8 ka[4][2];
#pragma unroll
                for (int kk = 0; kk < 4; ++kk) {
                    if (AT_VAR == 3) { ka[kk][0] = qf[kk]; ka[kk][1] = qf[(kk + 1) & 3]; continue; }
                    ka[kk][0] = *(const LAS bf16x8*)(kb + r * 128 + (((2 * kk + h) ^ sw) << 4));
                    ka[kk][1] = *(const LAS bf16x8*)(kb + 4096 + r * 128 + (((2 * kk + h) ^ sw) << 4));
                }
                bool do_b = false;
                if (PREQK && !DEC && !SEL && !odd && t + 1 <= tile_hi) { const bool act_b = (key0 + 64 + 63 >= lo) && (key0 + 64 <= hi); do_b = __any(act_b); }
                __builtin_amdgcn_sched_barrier(0);
                if (T5_PRIO) __builtin_amdgcn_s_setprio(1);
#pragma unroll
                for (int kk = 0; kk < 4; ++kk) {
                    if (AT_VAR == 2) { asm volatile("" :: "v"(__builtin_bit_cast(u32x4, ka[kk][0])), "v"(__builtin_bit_cast(u32x4, ka[kk][1]))); s0[kk] = (float)lane * 1e-3f; s1[kk] = (float)kk; continue; }
                    s0 = MFMA32(ka[kk][0], qf[kk], s0);
                    s1 = MFMA32(ka[kk][1], qf[kk], s1);
                }
                if (T5_PRIO) __builtin_amdgcn_s_setprio(0);
                if (V_AFTER_QK && MODE != 1) {
                    const float dq_ = s0[15] + s1[15]; int z_; asm volatile("v_mov_b32 %0, 0" : "=v"(z_) : "v"(dq_));
                    vb += z_;
                    AT_LOAD_V();
                }
                if (do_b) {
                    LAS unsigned char* kb2 = lds + ((t + 1 - tile_lo) & 3) * AT_KV_BYTES;
#ifdef PREQK_NOP
                    asm volatile("s_nop 15\n\ts_nop 15\n\ts_nop 15\n\ts_nop 15\n\ts_nop 15\n\ts_nop 15\n\ts_nop 15\n\ts_nop 15" ::: "memory");
#endif
#pragma unroll
                    for (int kk = 0; kk < 4; ++kk) {
                        ka[kk][0] = *(const LAS bf16x8*)(kb2 + r * 128 + (((2 * kk + h) ^ sw) << 4));
                        ka[kk][1] = *(const LAS bf16x8*)(kb2 + 4096 + r * 128 + (((2 * kk + h) ^ sw) << 4));
                    }
#pragma unroll
                    for (int i = 0; i < 16; ++i) { sb0[i] = 0.f; sb1[i] = 0.f; }
#pragma unroll
                    for (int kk = 0; kk < 4; ++kk) {
                        sb0 = MFMA32(ka[kk][0], qf[kk], sb0);
                        sb1 = MFMA32(ka[kk][1], qf[kk], sb1);
                    }
                }
                if (!odd) pre_b = do_b;
            }
            const bool dead = (hi < key0) || (lo > key0 + 63), fullv = (lo <= key0) && (hi >= key0 + 63);
            float rs = 0.f;
            bf16x8 pf[4];
            if (!__all(dead || fullv)) {
                const int dhi = hi - key0 - 4 * h, dlo = lo - key0 - 4 * h;
                const bool need_lo = __any(!dead && lo > key0), need_hi = __any(!dead && hi < key0 + 63);
                if (need_lo && need_hi) {
#pragma unroll
                    for (int i = 0; i < 16; ++i) { const int off = (i & 3) + 8 * (i >> 2);
                        s0[i] = (off <= dhi && off >= dlo) ? s0[i] : -INFINITY; s1[i] = (off + 32 <= dhi && off + 32 >= dlo) ? s1[i] : -INFINITY; }
                } else if (need_hi) {
#pragma unroll
                    for (int i = 0; i < 16; ++i) { const int off = (i & 3) + 8 * (i >> 2);
                        s0[i] = (off <= dhi) ? s0[i] : -INFINITY; s1[i] = (off + 32 <= dhi) ? s1[i] : -INFINITY; }
                } else {
#pragma unroll
                    for (int i = 0; i < 16; ++i) { const int off = (i & 3) + 8 * (i >> 2);
                        s0[i] = (off >= dlo) ? s0[i] : -INFINITY; s1[i] = (off + 32 >= dlo) ? s1[i] : -INFINITY; }
                }
            }
            if (AT_VAR == 1) { rs = 1.f + 1e-30f * (s0[0] + s1[0]);
#pragma unroll
                for (int sg = 0; sg < 4; ++sg) pf[sg] = qf[sg]; } else
            {
                float mxr = fmx(s0[0], s1[0]);
#pragma unroll
                for (int i = 1; i < 16; ++i) mxr = fmx(mxr, fmx(s0[i], s1[i]));
                float nb;
                if (MODE == 2) nb = dead ? -INFINITY : (l2inv - st.m);
                else {
                    float mx = dead ? -INFINITY : mxr * LOG2E;
                    if (__any(mx > st.m + (float)DEFER_THR)) {
                        mx = xh32_max(mx);
                        const float mnew = fmx(st.m, mx);
                        const float alpha = __builtin_amdgcn_exp2f(st.m - mnew);
                        st.l *= alpha;
                        if (MODE == 0) { if (!__all(mnew == st.m)) {
#pragma unroll
                            for (int i = 0; i < 16; ++i) { st.o[0][i] *= alpha; st.o[1][i] *= alpha; } } }
                        st.m = mnew;
                    }
                    nb = dead ? -INFINITY : -st.m;
                }
                const f32x2 nb2 = {nb, nb}, l2e2 = {LOG2E, LOG2E};
                f32x2 rs2 = {0.f, 0.f};
                u32x4 pw[4];
#pragma unroll
                for (int i = 0; i < 8; ++i) {
                    f32x2 a0 = {s0[2 * i], s0[2 * i + 1]}, a1 = {s1[2 * i], s1[2 * i + 1]};
                    a0 = a0 * l2e2 + nb2; a1 = a1 * l2e2 + nb2;
                    a0.x = __builtin_amdgcn_exp2f(a0.x); a0.y = __builtin_amdgcn_exp2f(a0.y); a1.x = __builtin_amdgcn_exp2f(a1.x); a1.y = __builtin_amdgcn_exp2f(a1.y);
                    rs2 += a0 + a1;
                    if (MODE == 2) { s0[2 * i] = a0.x; s0[2 * i + 1] = a0.y; s1[2 * i] = a1.x; s1[2 * i + 1] = a1.y; }
                    pw[i >> 2][i & 3] = pk2(a0.x, a0.y); pw[2 + (i >> 2)][i & 3] = pk2(a1.x, a1.y);
                }
                rs = rs2.x + rs2.y;
#pragma unroll
                for (int sg = 0; sg < 4; ++sg) pf[sg] = __builtin_bit_cast(bf16x8, pw[sg]);
            }
            if (MODE != 2) st.l += rs;
            if (MODE == 2) {
#pragma unroll
                for (int kt = 0; kt < 2; ++kt)
#pragma unroll
                    for (int jj = 0; jj < 4; ++jj) {
                        float gs = kt ? (s1[4 * jj] + s1[4 * jj + 1]) + (s1[4 * jj + 2] + s1[4 * jj + 3]) : (s0[4 * jj] + s0[4 * jj + 1]) + (s0[4 * jj + 2] + s0[4 * jj + 3]);
                        float ls = kt ? s1[4 * jj + 3] : s0[4 * jj + 3];
                        gs += DPPF(gs, 0xB1, 0xf); gs += DPPF(gs, 0x4E, 0xf);
                        ls += DPPF(ls, 0xB1, 0xf); ls += DPPF(ls, 0x4E, 0xf);
                        if ((lane & 3) == 0) {
                            const int gidx = t * 16 + 8 * kt + 2 * jj + h;
                            const unsigned ia = (unsigned)(size_t)(imp_row + gidx);
                            asm volatile("ds_add_f32 %0, %1\n\tds_add_f32 %0, %2 offset:4" :: "v"(ia), "v"(gs), "v"(ls) : "memory");
                        }
                    }
            }
            if (MODE != 1) {
                if (T5_PRIO) __builtin_amdgcn_s_setprio(1);
#pragma unroll
                for (int sg = 0; sg < 4; ++sg) {
                    if (AT_VAR == 2) { asm volatile("" :: "v"(__builtin_bit_cast(u32x4, va[sg][0])), "v"(__builtin_bit_cast(u32x4, va[sg][1])), "v"(__builtin_bit_cast(u32x4, pf[sg]))); continue; }
                    st.o[0] = MFMA32(va[sg][0], pf[sg], st.o[0]);
                    st.o[1] = MFMA32(va[sg][1], pf[sg], st.o[1]);
                }
                if (T5_PRIO) __builtin_amdgcn_s_setprio(0);
            }
        } else if (((t - tile_lo) & 1) == 0) pre_b = false;
        if (DEC) { asm volatile("s_waitcnt lgkmcnt(0)" ::: "memory"); AT_SIGNAL(4 + ((t - tile_lo) & 3)); }
      }
    }
    if (MODE != 1) { const float dep_ = st.o[0][15] + st.o[1][15]; asm volatile("" :: "v"(dep_)); }
#undef AT_SIGNAL
#undef AT_WAIT
}

template <int MODE>
DI void pp_softmax(f32x16& s0, f32x16& s1, bf16x8 (&pf)[4], AttnSt& st, int t, int lo, int hi, float l2inv, int lane, int h, LAS float* imp_row) {
    const int key0 = t * 64;
    const bool dead = (hi < key0) || (lo > key0 + 63), fullv = (lo <= key0) && (hi >= key0 + 63);
    float rs = 0.f;
    if (!__all(dead || fullv)) {
        const int dhi = hi - key0 - 4 * h, dlo = lo - key0 - 4 * h;
        const bool need_lo = __any(!dead && lo > key0), need_hi = __any(!dead && hi < key0 + 63);
        if (need_lo && need_hi) {
#pragma unroll
            for (int i = 0; i < 16; ++i) { const int off = (i & 3) + 8 * (i >> 2);
                s0[i] = (off <= dhi && off >= dlo) ? s0[i] : -INFINITY; s1[i] = (off + 32 <= dhi && off + 32 >= dlo) ? s1[i] : -INFINITY; }
        } else if (need_hi) {
#pragma unroll
            for (int i = 0; i < 16; ++i) { const int off = (i & 3) + 8 * (i >> 2);
                s0[i] = (off <= dhi) ? s0[i] : -INFINITY; s1[i] = (off + 32 <= dhi) ? s1[i] : -INFINITY; }
        } else {
#pragma unroll
            for (int i = 0; i < 16; ++i) { const int off = (i & 3) + 8 * (i >> 2);
                s0[i] = (off >= dlo) ? s0[i] : -INFINITY; s1[i] = (off + 32 >= dlo) ? s1[i] : -INFINITY; }
        }
    }
    float mxr = fmx(s0[0], s1[0]);
#pragma unroll
    for (int i = 1; i < 16; ++i) mxr = fmx(mxr, fmx(s0[i], s1[i]));
    float nb;
    if (MODE == 2) nb = dead ? -INFINITY : (l2inv - st.m);
    else {
        float mx = dead ? -INFINITY : mxr * LOG2E;
        if (__any(mx > st.m + (float)DEFER_THR)) {
            mx = xh32_max(mx);
            const float mnew = fmx(st.m, mx);
            const float alpha = __builtin_amdgcn_exp2f(st.m - mnew);
            st.l *= alpha;
            if (MODE == 0) { if (!__all(mnew == st.m)) {
#pragma unroll
                for (int i = 0; i < 16; ++i) { st.o[0][i] *= alpha; st.o[1][i] *= alpha; } } }
            st.m = mnew;
        }
        nb = dead ? -INFINITY : -st.m;
    }
    const f32x2 nb2 = {nb, nb}, l2e2 = {LOG2E, LOG2E};
    f32x2 rs2 = {0.f, 0.f};
    u32x4 pw[4];
#pragma unroll
    for (int i = 0; i < 8; ++i) {
        f32x2 a0 = {s0[2 * i], s0[2 * i + 1]}, a1 = {s1[2 * i], s1[2 * i + 1]};
        a0 = a0 * l2e2 + nb2; a1 = a1 * l2e2 + nb2;
        a0.x = __builtin_amdgcn_exp2f(a0.x); a0.y = __builtin_amdgcn_exp2f(a0.y); a1.x = __builtin_amdgcn_exp2f(a1.x); a1.y = __builtin_amdgcn_exp2f(a1.y);
        rs2 += a0 + a1;
        if (MODE == 2) { s0[2 * i] = a0.x; s0[2 * i + 1] = a0.y; s1[2 * i] = a1.x; s1[2 * i + 1] = a1.y; }
        pw[i >> 2][i & 3] = pk2(a0.x, a0.y); pw[2 + (i >> 2)][i & 3] = pk2(a1.x, a1.y);
    }
    rs = rs2.x + rs2.y;
    if (MODE != 1) {
#pragma unroll
        for (int sg = 0; sg < 4; ++sg) pf[sg] = __builtin_bit_cast(bf16x8, pw[sg]);
    }
    if (MODE != 2) st.l += rs;
    if (MODE == 2) {
#pragma unroll
        for (int kt = 0; kt < 2; ++kt)
#pragma unroll
            for (int jj = 0; jj < 4; ++jj) {
                float gs = kt ? (s1[4 * jj] + s1[4 * jj + 1]) + (s1[4 * jj + 2] + s1[4 * jj + 3]) : (s0[4 * jj] + s0[4 * jj + 1]) + (s0[4 * jj + 2] + s0[4 * jj + 3]);
                float ls = kt ? s1[4 * jj + 3] : s0[4 * jj + 3];
                gs += DPPF(gs, 0xB1, 0xf); gs += DPPF(gs, 0x4E, 0xf);
                ls += DPPF(ls, 0xB1, 0xf); ls += DPPF(ls, 0x4E, 0xf);
                if ((lane & 3) == 0) {
                    const int gidx = t * 16 + 8 * kt + 2 * jj + h;
                    const unsigned ia = (unsigned)(size_t)(imp_row + gidx);
                    asm volatile("ds_add_f32 %0, %1\n\tds_add_f32 %0, %2 offset:4" :: "v"(ia), "v"(gs), "v"(ls) : "memory");
                }
            }
    }
}

DI void attn_private(LAS unsigned char* lds, const bf16_t* Kb, const bf16_t* VTb, int tile_lo, int tile_hi, const bf16x8 (&qf)[4], int lo_c, int hi_c, AttnSt& st) {
    const int tid = opaque_tid(), lane = tid & 63, r = lane & 31, h = lane >> 5, sw = (r >> 1) & 7;
    const int wave_u = __builtin_amdgcn_readfirstlane(tid >> 6);
    if (tile_lo > tile_hi) return;
    LAS unsigned char* slot = lds + wave_u * AT_KV_BYTES;
    const int prow = lane >> 3, pch = lane & 7;
#define PRIV_ISSUE(base, tile, off) do { _Pragma("unroll") for (int p_ = 0; p_ < 8; ++p_) { const int srow_ = 8 * p_ + prow; const int lc_ = pch ^ ((srow_ >> 1) & 7); \
        __builtin_amdgcn_global_load_lds((const unsigned*)((base) + (size_t)(tile) * 4096 + srow_ * 64 + lc_ * 8), (LAS unsigned*)(slot + (off) + p_ * 1024), 16, 0, 0); } } while (0)
    PRIV_ISSUE(Kb, tile_lo, 0); PRIV_ISSUE(VTb, tile_lo, 8192);
#pragma unroll 1
    for (int t = tile_lo; t <= tile_hi; ++t) {
        { const float dep_ = st.o[0][15] + st.o[1][15]; asm volatile("" :: "v"(dep_)); }
        const bool more = t < tile_hi;
        asm volatile("s_waitcnt vmcnt(8)" ::: "memory");
        LAS unsigned char* kb = slot;
        bf16x8 ka[4][2];
#pragma unroll
        for (int kk = 0; kk < 4; ++kk) {
            ka[kk][0] = *(const LAS bf16x8*)(kb + r * 128 + (((2 * kk + h) ^ sw) << 4));
            ka[kk][1] = *(const LAS bf16x8*)(kb + 4096 + r * 128 + (((2 * kk + h) ^ sw) << 4));
        }
        asm volatile("s_waitcnt lgkmcnt(0)" ::: "memory");
        if (more) PRIV_ISSUE(Kb, t + 1, 0);
        f32x16 s0, s1;
#pragma unroll
        for (int i = 0; i < 16; ++i) { s0[i] = 0.f; s1[i] = 0.f; }
#pragma unroll
        for (int kk = 0; kk < 4; ++kk) { s0 = MFMA32(ka[kk][0], qf[kk], s0); s1 = MFMA32(ka[kk][1], qf[kk], s1); }
        const float dq_ = s0[15] + s1[15]; int z_; asm volatile("v_mov_b32 %0, 0" : "=v"(z_) : "v"(dq_));
        if (more) asm volatile("s_waitcnt vmcnt(8)" ::: "memory"); else asm volatile("s_waitcnt vmcnt(0)" ::: "memory");
        LAS unsigned char* vb = slot + 8192 + z_;
        bf16x8 va[4][2];
#pragma unroll
        for (int sg = 0; sg < 4; ++sg) {
            va[sg][0] = *(const LAS bf16x8*)(vb + r * 128 + (((2 * sg + h) ^ sw) << 4));
            va[sg][1] = *(const LAS bf16x8*)(vb + 4096 + r * 128 + (((2 * sg + h) ^ sw) << 4));
        }
        asm volatile("s_waitcnt lgkmcnt(0)" ::: "memory");
        if (more) PRIV_ISSUE(VTb, t + 1, 8192);
        bf16x8 pf[4];
        pp_softmax<0>(s0, s1, pf, st, t, lo_c, hi_c, 0.f, lane, h, nullptr);
#pragma unroll
        for (int sg = 0; sg < 4; ++sg) { st.o[0] = MFMA32(va[sg][0], pf[sg], st.o[0]); st.o[1] = MFMA32(va[sg][1], pf[sg], st.o[1]); }
    }
    { const float dep_ = st.o[0][15] + st.o[1][15]; asm volatile("" :: "v"(dep_)); }
#undef PRIV_ISSUE
}

#undef AT_ISSUE_V
#define AT_ISSUE_V true
DI void st_reset(AttnSt& st) {
#pragma unroll
    for (int i = 0; i < 16; ++i) { st.o[0][i] = 0.f; st.o[1][i] = 0.f; }
    st.m = -1e30f; st.l = 0.f;
}
DI void load_q(const bf16_t* Q, int tokrow, int head, int h, bf16x8 (&qf)[4]) {
#pragma unroll
    for (int kk = 0; kk < 4; ++kk) qf[kk] = *(const bf16x8*)(Q + (size_t)tokrow * D + head * 64 + 16 * kk + 8 * h);
#pragma unroll
    for (int kk = 0; kk < 4; ++kk) asm volatile("" : "+v"(qf[kk]));
}
DI void acc_out(f32x16 (&out)[2], const AttnSt& st, float scale) {
#pragma unroll
    for (int i = 0; i < 16; ++i) { out[0][i] += scale * st.o[0][i]; out[1][i] += scale * st.o[1][i]; }
}
DI void store_out(bf16_t* AO, int tokrow, int head, int h, const f32x16 (&out)[2]) {
    bf16_t* base = AO + (size_t)tokrow * D + head * 64 + 4 * h;
#pragma unroll
    for (int dt = 0; dt < 2; ++dt)
#pragma unroll
        for (int jj = 0; jj < 4; ++jj) {
            u32x2 w; w.x = pk2(out[dt][4 * jj], out[dt][4 * jj + 1]); w.y = pk2(out[dt][4 * jj + 2], out[dt][4 * jj + 3]);
            *(u32x2*)(base + 32 * dt + 8 * jj) = w;
        }
}


DI void lds_out_set(LAS unsigned char* ob, int c, int h, const AttnSt& st, float scale) {
#pragma unroll
    for (int dt = 0; dt < 2; ++dt)
#pragma unroll
        for (int jj = 0; jj < 4; ++jj) {
            f32x4 v = {st.o[dt][4 * jj] * scale, st.o[dt][4 * jj + 1] * scale, st.o[dt][4 * jj + 2] * scale, st.o[dt][4 * jj + 3] * scale};
            *(LAS f32x4*)(ob + (((dt * 4 + jj) * 2 + h) * 32 + c) * 16) = v;
        }
}
DI void lds_out_add(LAS unsigned char* ob, int c, int h, const AttnSt& st, float scale) {
#pragma unroll
    for (int dt = 0; dt < 2; ++dt)
#pragma unroll
        for (int jj = 0; jj < 4; ++jj) {
            LAS f32x4* p = (LAS f32x4*)(ob + (((dt * 4 + jj) * 2 + h) * 32 + c) * 16);
            f32x4 v = *p;
            v[0] += st.o[dt][4 * jj] * scale; v[1] += st.o[dt][4 * jj + 1] * scale; v[2] += st.o[dt][4 * jj + 2] * scale; v[3] += st.o[dt][4 * jj + 3] * scale;
            *p = v;
        }
}
DI void lds_out_final_store(LAS unsigned char* ob, int c, int h, const AttnSt& st, float scale, bf16_t* AO, int tokrow, int head) {
    bf16_t* base = AO + (size_t)tokrow * D + head * 64 + 4 * h;
#pragma unroll
    for (int dt = 0; dt < 2; ++dt)
#pragma unroll
        for (int jj = 0; jj < 4; ++jj) {
            const f32x4 v = *(const LAS f32x4*)(ob + (((dt * 4 + jj) * 2 + h) * 32 + c) * 16);
            u32x2 w; w.x = pk2(v[0] + st.o[dt][4 * jj] * scale, v[1] + st.o[dt][4 * jj + 1] * scale); w.y = pk2(v[2] + st.o[dt][4 * jj + 2] * scale, v[3] + st.o[dt][4 * jj + 3] * scale);
            *(u32x2*)(base + 32 * dt + 8 * jj) = w;
        }
}


DI void sel_gather(LAS unsigned char* lds, const bf16_t* K1, const bf16_t* V1T, const bf16x8 (&qf)[4], int cur, int tok_local, int t_col, AttnSt& st) {
    const int tid = opaque_tid(), lane = tid & 63, r = lane & 31, h = lane >> 5, wave = tid >> 6;
    const LAS unsigned* selm = (const LAS unsigned*)(lds + AT_SEL_OFF);
    unsigned u = selm[(wave * 8 + (lane >> 3)) * 8 + (lane & 7)];
    u |= (unsigned)__shfl_xor((int)u, 8); u |= (unsigned)__shfl_xor((int)u, 16); u |= (unsigned)__shfl_xor((int)u, 32);
    const unsigned foff = (unsigned)(r * 128 + 16 * h);
#define SG_LDK(dst, jj) do { const char* tb_ = (const char*)K1 + (size_t)(jj) * 8192; _Pragma("unroll") for (int kk = 0; kk < 4; ++kk) { \
        dst[kk][0] = *(const bf16x8*)(tb_ + foff + kk * 32); dst[kk][1] = *(const bf16x8*)(tb_ + 4096 + foff + kk * 32); } } while (0)
#define SG_LDV(dst, jj) do { const char* tb_ = (const char*)V1T + (size_t)(jj) * 8192; _Pragma("unroll") for (int sg = 0; sg < 4; ++sg) { \
        dst[sg][0] = *(const bf16x8*)(tb_ + foff + sg * 32); dst[sg][1] = *(const bf16x8*)(tb_ + 4096 + foff + sg * 32); } } while (0)
    int w = 0; unsigned Uw = (unsigned)__builtin_amdgcn_readlane((int)u, 0);
#define SG_NEXT(jout) do { while (Uw == 0u && w < 7) { ++w; Uw = (unsigned)__builtin_amdgcn_readlane((int)u, w); } \
        if (Uw == 0u) jout = -1; else { const int b_ = __builtin_ctz(Uw); Uw &= Uw - 1u; jout = 32 * w + b_; } } while (0)
    int j; SG_NEXT(j);
    bf16x8 kc[4][2];
    if (j >= 0) SG_LDK(kc, j);
    while (j >= 0) {
        int jn; SG_NEXT(jn);
        bf16x8 va[4][2];
        SG_LDV(va, j);
        const unsigned myw = selm[tok_local * 8 + (j >> 5)];
        const bool sel = (myw >> (j & 31)) & 1u;
        const int key0 = j * 64, lo = 0, hi = sel ? t_col : -1;
        f32x16 s0, s1;
#pragma unroll
        for (int i = 0; i < 16; ++i) { s0[i] = 0.f; s1[i] = 0.f; }
#pragma unroll
        for (int kk = 0; kk < 4; ++kk) { s0 = MFMA32(kc[kk][0], qf[kk], s0); s1 = MFMA32(kc[kk][1], qf[kk], s1); }
        if (jn >= 0) SG_LDK(kc, jn);
        const bool dead = !sel, fullv = sel && (hi >= key0 + 63);
        float rs = 0.f;
        bf16x8 pf[4];
        if (__all(dead || fullv)) {
            float mxr = fmx(s0[0], s1[0]);
#pragma unroll
            for (int i = 1; i < 16; ++i) mxr = fmx(mxr, fmx(s0[i], s1[i]));
            float mx = dead ? -INFINITY : mxr * LOG2E;
            mx = xh32_max(mx);
            const float mnew = fmx(st.m, mx);
            const float alpha = __builtin_amdgcn_exp2f(st.m - mnew);
            st.l *= alpha;
            if (!__all(mnew == st.m)) {
#pragma unroll
                for (int i = 0; i < 16; ++i) { st.o[0][i] *= alpha; st.o[1][i] *= alpha; } }
            st.m = mnew; const float nb = dead ? -INFINITY : -mnew;
#pragma unroll
            for (int i = 0; i < 16; ++i) {
                const float p0 = __builtin_amdgcn_exp2f(__builtin_fmaf(s0[i], LOG2E, nb)), p1 = __builtin_amdgcn_exp2f(__builtin_fmaf(s1[i], LOG2E, nb));
                s0[i] = p0; s1[i] = p1; rs += p0 + p1;
            }
#pragma unroll
            for (int sg = 0; sg < 4; ++sg) {
                u32x4 pw;
                if (sg < 2) { pw.x = pk2(s0[8 * sg + 0], s0[8 * sg + 1]); pw.y = pk2(s0[8 * sg + 2], s0[8 * sg + 3]); pw.z = pk2(s0[8 * sg + 4], s0[8 * sg + 5]); pw.w = pk2(s0[8 * sg + 6], s0[8 * sg + 7]); }
                else { const int q = sg - 2; pw.x = pk2(s1[8 * q + 0], s1[8 * q + 1]); pw.y = pk2(s1[8 * q + 2], s1[8 * q + 3]); pw.z = pk2(s1[8 * q + 4], s1[8 * q + 5]); pw.w = pk2(s1[8 * q + 6], s1[8 * q + 7]); }
                pf[sg] = __builtin_bit_cast(bf16x8, pw);
            }
        } else {
            float mx = -INFINITY;
#pragma unroll
            for (int i = 0; i < 16; ++i) {
                const int key = key0 + (i & 3) + 8 * (i >> 2) + 4 * h;
                float v = s0[i] * LOG2E; v = (key >= lo && key <= hi) ? v : -INFINITY; s0[i] = v; mx = fmx(mx, v);
                float x = s1[i] * LOG2E; x = (key + 32 >= lo && key + 32 <= hi) ? x : -INFINITY; s1[i] = x; mx = fmx(mx, x);
            }
            mx = xh32_max(mx);
            const float mnew = fmx(st.m, mx);
            const float alpha = __builtin_amdgcn_exp2f(st.m - mnew);
            st.l *= alpha;
            if (!__all(mnew == st.m)) {
#pragma unroll
                for (int i = 0; i < 16; ++i) { st.o[0][i] *= alpha; st.o[1][i] *= alpha; } }
            st.m = mnew;
#pragma unroll
            for (int i = 0; i < 16; ++i) {
                const float p0 = __builtin_amdgcn_exp2f(s0[i] - mnew), p1 = __builtin_amdgcn_exp2f(s1[i] - mnew);
                s0[i] = p0; s1[i] = p1; rs += p0 + p1;
            }
#pragma unroll
            for (int sg = 0; sg < 4; ++sg) {
                u32x4 pw;
                if (sg < 2) { pw.x = pk2(s0[8 * sg + 0], s0[8 * sg + 1]); pw.y = pk2(s0[8 * sg + 2], s0[8 * sg + 3]); pw.z = pk2(s0[8 * sg + 4], s0[8 * sg + 5]); pw.w = pk2(s0[8 * sg + 6], s0[8 * sg + 7]); }
                else { const int q = sg - 2; pw.x = pk2(s1[8 * q + 0], s1[8 * q + 1]); pw.y = pk2(s1[8 * q + 2], s1[8 * q + 3]); pw.z = pk2(s1[8 * q + 4], s1[8 * q + 5]); pw.w = pk2(s1[8 * q + 6], s1[8 * q + 7]); }
                pf[sg] = __builtin_bit_cast(bf16x8, pw);
            }
        }
        st.l += rs;
#pragma unroll
        for (int sg = 0; sg < 4; ++sg) { st.o[0] = MFMA32(va[sg][0], pf[sg], st.o[0]); st.o[1] = MFMA32(va[sg][1], pf[sg], st.o[1]); }
        j = jn;
    }
#undef SG_NEXT
#undef SG_LDK
#undef SG_LDV
}


#define MFMA16(a, b, c) __builtin_amdgcn_mfma_f32_16x16x32_bf16((a), (b), (c), 0, 0, 0)

struct Sel16St { f32x4 o[2][4]; float m[2], l[2]; };
DI void sel16_loop(LAS unsigned char* lds, const bf16_t* Kb, const bf16_t* VTb, int tile_hi, const bf16x8 (&qf)[2][2], int tokl0, int tcol0, Sel16St& st, bool primed) {
    const int tid = opaque_tid(), lane = tid & 63, c16 = lane & 15, q = lane >> 4, sw = (c16 >> 1) & 7;
    const int wave_u = __builtin_amdgcn_readfirstlane(tid >> 6);
    const int srow = tid >> 3, lc = (tid & 7) ^ ((srow >> 1) & 7);
    const bf16_t* ksrc = Kb + (size_t)srow * 64 + lc * 8;
    const bf16_t* vsrc = VTb + (size_t)srow * 64 + lc * 8;
    LAS unsigned char* wbase = lds + wave_u * 1024;
    const LAS unsigned* selm = (const LAS unsigned*)(lds + AT_SEL_OFF);
    const int tile_lo = 0;
    asm volatile("s_waitcnt lgkmcnt(0)" ::: "memory");
    if (!primed) __builtin_amdgcn_s_barrier();
    constexpr int GRP = SEL_NS / 2;
    if (!primed) {
#pragma unroll
        for (int i = 0; i < GRP; ++i) if (tile_lo + i <= tile_hi) AT_ISSUE(tile_lo + i, i);
    }
    unsigned wsel2[2] = {0u, 0u};
#pragma unroll 1
    for (int t = tile_lo; t <= tile_hi; ++t) {
        { const float dep_ = st.o[0][3][3] + st.o[1][3][3]; asm volatile("" :: "v"(dep_)); }
        const int rel = t - tile_lo, rem = tile_hi - t;
        if ((rel & (GRP - 1)) == 0) {
            asm volatile("s_waitcnt vmcnt(0)" ::: "memory");
            if (!AT_NO_BARRIER) __builtin_amdgcn_s_barrier();
            if (!SEL_SPREAD) {
#pragma unroll
                for (int i = 0; i < GRP; ++i) if (rem >= GRP + i) AT_ISSUE(t + GRP + i, (rel + GRP + i) & (SEL_NS - 1));
            }
        }
        if (SEL_SPREAD && rem >= GRP) AT_ISSUE(t + GRP, (rel + GRP) & (SEL_NS - 1));
        LAS unsigned char* kb = lds + (rel & (SEL_NS - 1)) * AT_KV_BYTES;
        LAS unsigned char* vb = kb + 8192;
        const int key0 = t * 64;
        bool selc[2];
        if ((t & 31) == 0 || t == tile_lo) {
#pragma unroll
            for (int ct = 0; ct < 2; ++ct) wsel2[ct] = selm[(tokl0 + 4 * ct + (c16 >> 2)) * 8 + (t >> 5)];
        }
#pragma unroll
        for (int ct = 0; ct < 2; ++ct) selc[ct] = (wsel2[ct] >> (t & 31)) & 1u;
        const bool any0 = __any(selc[0]), any1 = __any(selc[1]);
        if (any0 || any1) {
            bf16x8 ka[4][2];
#pragma unroll
            for (int kt = 0; kt < 4; ++kt)
#pragma unroll
                for (int ks = 0; ks < 2; ++ks) ka[kt][ks] = *(const LAS bf16x8*)(kb + (16 * kt + c16) * 128 + (((4 * ks + q) ^ sw) << 4));
            bf16x8 va[4][2];
#pragma unroll
            for (int dt = 0; dt < 4; ++dt)
#pragma unroll
                for (int a = 0; a < 2; ++a) va[dt][a] = *(const LAS bf16x8*)(vb + (16 * dt + c16) * 128 + (((4 * a + q) ^ sw) << 4));
#pragma unroll
            for (int ct = 0; ct < 2; ++ct) {
                if (ct == 0 ? !any0 : !any1) continue;
                f32x4 s[4];
                if (T5_PRIO) __builtin_amdgcn_s_setprio(1);
#pragma unroll
                for (int kt = 0; kt < 4; ++kt) { s[kt] = (f32x4){0.f, 0.f, 0.f, 0.f};
#pragma unroll
                    for (int ks = 0; ks < 2; ++ks) s[kt] = MFMA16(ka[kt][ks], qf[ct][ks], s[kt]); }
                if (T5_PRIO) __builtin_amdgcn_s_setprio(0);
                const int tcol = tcol0 + 4 * ct + (c16 >> 2);
                const bool dead = !selc[ct];
                const int hi = dead ? -1 : tcol;
                const bool fullv = !dead && (hi >= key0 + 63);
                float rs = 0.f;
                bf16x8 pf[2];
                if (AT_VAR == 1) { rs = 1.f + 1e-30f * (s[0][0] + s[1][0] + s[2][0] + s[3][0]); pf[0] = ka[0][0]; pf[1] = ka[1][0]; } else
                {
                    if (!__all(dead || fullv)) {
                        const int dhi = hi - key0 - 4 * q;
#pragma unroll
                        for (int kt = 0; kt < 4; ++kt)
#pragma unroll
                            for (int i = 0; i < 4; ++i) s[kt][i] = (16 * kt + i <= dhi) ? s[kt][i] : -INFINITY;
                    }
                    float mxr = fmx(fmx(s[0][0], s[0][1]), fmx(s[0][2], s[0][3]));
#pragma unroll
                    for (int kt = 1; kt < 4; ++kt) mxr = fmx(mxr, fmx(fmx(s[kt][0], s[kt][1]), fmx(s[kt][2], s[kt][3])));
                    float mx = dead ? -INFINITY : mxr * LOG2E;
                    if (__any(mx > st.m[ct] + (float)DEFER_THR)) {
                        mx = xh16_max(mx); mx = xh32_max(mx);
                        const float mnew = fmx(st.m[ct], mx);
                        const float alpha = __builtin_amdgcn_exp2f(st.m[ct] - mnew);
                        st.l[ct] *= alpha;
                        if (!__all(mnew == st.m[ct])) {
#pragma unroll
                            for (int dt = 0; dt < 4; ++dt) st.o[ct][dt] = st.o[ct][dt] * alpha; }
                        st.m[ct] = mnew;
                    }
                    const float nb = dead ? -INFINITY : -st.m[ct];
                    const f32x2 nb2 = {nb, nb}, l2e2 = {LOG2E, LOG2E};
                    f32x2 rs2 = {0.f, 0.f};
                    u32x4 pw[2];
#pragma unroll
                    for (int kt = 0; kt < 4; ++kt) {
                        f32x2 a0 = {s[kt][0], s[kt][1]}, a1 = {s[kt][2], s[kt][3]};
                        a0 = a0 * l2e2 + nb2; a1 = a1 * l2e2 + nb2;
                        a0.x = __builtin_amdgcn_exp2f(a0.x); a0.y = __builtin_amdgcn_exp2f(a0.y); a1.x = __builtin_amdgcn_exp2f(a1.x); a1.y = __builtin_amdgcn_exp2f(a1.y);
                        rs2 += a0 + a1;
                        pw[kt >> 1][2 * (kt & 1)] = pk2(a0.x, a0.y); pw[kt >> 1][2 * (kt & 1) + 1] = pk2(a1.x, a1.y);
                    }
                    rs = rs2.x + rs2.y;
                    pf[0] = __builtin_bit_cast(bf16x8, pw[0]); pf[1] = __builtin_bit_cast(bf16x8, pw[1]);
                }
                st.l[ct] += rs;
                if (T5_PRIO) __builtin_amdgcn_s_setprio(1);
#pragma unroll
                for (int dt = 0; dt < 4; ++dt)
#pragma unroll
                    for (int a = 0; a < 2; ++a) st.o[ct][dt] = MFMA16(va[dt][a], pf[a], st.o[ct][dt]);
                if (T5_PRIO) __builtin_amdgcn_s_setprio(0);
                if (ct == 0 && any1) { const float dep_ = st.o[0][3][3]; asm volatile("" :: "v"(dep_)); }
            }
        }
    }
    { const float dep_ = st.o[0][3][3] + st.o[1][3][3]; asm volatile("" :: "v"(dep_)); }
    if (SEL_NS > 4) { asm volatile("s_waitcnt lgkmcnt(0)" ::: "memory"); __builtin_amdgcn_s_barrier(); }
}

DI void nsa_tile(LAS unsigned char* lds, unsigned char* ws, int b, int g, int tq0) {
    const int tid = opaque_tid(), lane = tid & 63, wave = tid >> 6, c = lane & 31, h = lane >> 5, r = c & 3;
    const int tok_local = wave * 8 + (c >> 2), t_col = tq0 + tok_local, tokrow = b * S + t_col, head = g * 4 + r;
    const int cur = tq0 >> 6;
    const bf16_t* Q = (const bf16_t*)(ws + WS_Q);
    const size_t slab = (size_t)(b * NG + g) * S * 64;
    const bf16_t* KC = (const bf16_t*)(ws + WS_KC) + (size_t)(b * NG + g) * 1024 * 64;
    const bf16_t* VCT = (const bf16_t*)(ws + WS_VCT) + (size_t)(b * NG + g) * 64 * 1024;
    const bf16_t* K1 = (const bf16_t*)(ws + WS_KV + 2 * KVB) + slab;
    const bf16_t* V1T = (const bf16_t*)(ws + WS_KV + 3 * KVB) + slab;
    const bf16_t* K2 = (const bf16_t*)(ws + WS_KV + 4 * KVB) + slab;
    const bf16_t* V2T = (const bf16_t*)(ws + WS_KV + 5 * KVB) + slab;
    LAS float* imp = (LAS float*)(lds + AT_IMP_OFF);
    LAS unsigned* selm = (LAS unsigned*)(lds + AT_SEL_OFF);
    LAS float* imp_row = imp + tok_local * AT_IMP_STRIDE;
    bf16x8 qf[4];
    load_q(Q, tokrow, head, h, qf);
    const float* gp = (const float*)(ws + WS_G) + (size_t)tokrow * 48 + head * 3;
    float g_c = gp[0], g_s = gp[1], g_w = gp[2];
    asm volatile("" : "+v"(g_c), "+v"(g_s), "+v"(g_w));
    for (int i = lane; i < 8 * AT_IMP_STRIDE; i += 64) imp[wave * 8 * AT_IMP_STRIDE + i] = 0.f;
    LAS unsigned char* ob = lds + AT_IMP_OFF + wave * (8 * AT_IMP_STRIDE * 4);
    AttnSt st;
    const int hi_cmp = (t_col - 31) >> 4;
    const int ct_hi = ((tq0 + 32) >> 4) >> 6;
    st_reset(st);
    if (!NSA_SKIP_CMP) attn_loop<1, false>(lds, KC, VCT, 0, ct_hi, qf, 0, hi_cmp, st, 0.f, tok_local, t_col, imp_row);
    if (!NSA_SKIP_CMP) {
        const float ltot = st.l + __shfl_xor(st.l, 32);
        const float inv_l = ltot > 0.f ? 1.f / ltot : 0.f;
        const float mfin = st.m;
        st_reset(st); st.m = mfin;
        attn_loop<2, false>(lds, KC, VCT, 0, ct_hi, qf, 0, hi_cmp, st, inv_l, tok_local, t_col, imp_row);
        asm volatile("s_waitcnt lgkmcnt(0)" ::: "memory");
    }
    if (SEL_PRIME && SEL16 && !NSA_SKIP_SEL && SEL_NS == 8) {
        const int wave_u = __builtin_amdgcn_readfirstlane(wave);
        const int srow = tid >> 3, lc = (tid & 7) ^ ((srow >> 1) & 7);
        const bf16_t* ksrc = K1 + (size_t)srow * 64 + lc * 8;
        const bf16_t* vsrc = V1T + (size_t)srow * 64 + lc * 8;
        LAS unsigned char* wbase = lds + wave_u * 1024;
        asm volatile("s_waitcnt lgkmcnt(0)" ::: "memory");
        __builtin_amdgcn_s_barrier();
#pragma unroll
        for (int i = 0; i < 4; ++i) if (i <= cur) AT_ISSUE(i, i);
    }
    if (cur <= 15 || NSA_SKIP_TOPK) {
        if (lane < 64) { const int tk = lane >> 3, wd = lane & 7; unsigned bits = 0u;
            if (wd == 0) bits = (cur >= 31) ? 0xffffffffu : ((2u << cur) - 1u);
            if (NSA_SKIP_TOPK && cur > 15) { bits = (wd == 0) ? 1u : 0u; if (((cur - 1) >> 5) == wd) bits |= 1u << ((cur - 1) & 31); if ((cur >> 5) == wd) bits |= 1u << (cur & 31); }
            selm[(wave * 8 + tk) * 8 + wd] = bits; }
    } else {
        unsigned key[8][4], words[8];
#pragma unroll
        for (int tk = 0; tk < 8; ++tk) {
            words[tk] = 0u;
#pragma unroll
            for (int i = 0; i < 4; ++i) { const int s = lane + 64 * i; const unsigned bits = __builtin_bit_cast(unsigned, imp[(wave * 8 + tk) * AT_IMP_STRIDE + s]);
                key[tk][i] = (s >= 1 && s <= cur - 2) ? (((bits & 0xffffff00u) | (unsigned)(255 - s)) + 1u) : 0u; }
        }
#pragma unroll 1
        for (int round = 0; round < 13; ++round) {
#pragma unroll
            for (int tk = 0; tk < 8; ++tk) {
                const unsigned mloc = max(max(key[tk][0], key[tk][1]), max(key[tk][2], key[tk][3]));
                const unsigned W = wave_umax(mloc);
#pragma unroll
                for (int i = 0; i < 4; ++i) key[tk][i] = (key[tk][i] == W) ? 0u : key[tk][i];
                const int bs = 255 - (int)((W - 1u) & 255u);
                if (W != 0u && (bs >> 5) == (lane & 7)) words[tk] |= 1u << (bs & 31);
            }
        }
#pragma unroll
        for (int tk = 0; tk < 8; ++tk) {
            unsigned wv = words[tk]; const int wd = lane & 7;
            if (wd == 0) wv |= 1u;
            if (((cur - 1) >> 5) == wd) wv |= 1u << ((cur - 1) & 31);
            if ((cur >> 5) == wd) wv |= 1u << (cur & 31);
            if (lane < 8) selm[(wave * 8 + tk) * 8 + wd] = wv;
        }
    }
    asm volatile("s_waitcnt lgkmcnt(0)" ::: "memory");
    constexpr bool OUT_LATE = SEL16 && !NSA_SKIP_SEL && SEL_NS > 4;
    if (!OUT_LATE) lds_out_set(ob, c, h, st, g_c);
    if (!OUT_LATE) st_reset(st);
    if (!NSA_SKIP_SEL && SEL16) {
        const int c16 = lane & 15, q16 = lane >> 4;
        bf16x8 qf16[2][2];
#pragma unroll
        for (int ct = 0; ct < 2; ++ct)
#pragma unroll
            for (int ks = 0; ks < 2; ++ks)
                qf16[ct][ks] = *(const bf16x8*)(Q + (size_t)(b * S + tq0 + wave * 8 + 4 * ct + (c16 >> 2)) * D + (g * 4 + (c16 & 3)) * 64 + 32 * ks + 8 * q16);
        float gs16[2];
#pragma unroll
        for (int ct = 0; ct < 2; ++ct) gs16[ct] = ((const float*)(ws + WS_G))[(size_t)(b * S + tq0 + wave * 8 + 4 * ct + (c16 >> 2)) * 48 + (g * 4 + (c16 & 3)) * 3 + 1];
#pragma unroll
        for (int ct = 0; ct < 2; ++ct) { asm volatile("" : "+v"(qf16[ct][0]), "+v"(qf16[ct][1])); asm volatile("" : "+v"(gs16[ct])); }
        Sel16St s16;
#pragma unroll
        for (int ct = 0; ct < 2; ++ct) { s16.m[ct] = -1e30f; s16.l[ct] = 0.f;
#pragma unroll
            for (int dt = 0; dt < 4; ++dt) s16.o[ct][dt] = (f32x4){0.f, 0.f, 0.f, 0.f}; }
        sel16_loop(lds, K1, V1T, cur, qf16, wave * 8, tq0 + wave * 8, s16, SEL_PRIME && SEL_NS == 8);
        if (OUT_LATE) lds_out_set(ob, c, h, st, g_c);
#pragma unroll
        for (int ct = 0; ct < 2; ++ct) {
            float ltot = s16.l[ct]; ltot += __shfl_xor(ltot, 16); ltot += __shfl_xor(ltot, 32);
            const float sc = AT_NO_BARRIER ? 0.f : (ltot > 0.f ? gs16[ct] / ltot : 0.f);
#pragma unroll
            for (int dt = 0; dt < 4; ++dt) {
                LAS f32x4* p = (LAS f32x4*)(ob + (((((dt >> 1) * 4 + 2 * (dt & 1) + (q16 >> 1)) * 2 + (q16 & 1)) * 32) + 16 * ct + c16) * 16);
                f32x4 v = *p; v = v + s16.o[ct][dt] * sc; *p = v;
            }
        }
    } else {
    if (!NSA_SKIP_SEL) { if (SEL_GATHER) sel_gather(lds, K1, V1T, qf, cur, tok_local, t_col, st); else attn_loop<0, true>(lds, K1, V1T, 0, cur, qf, 0, t_col, st, 0.f, tok_local, t_col, imp_row); }
    { const float ltot = st.l + __shfl_xor(st.l, 32); lds_out_add(ob, c, h, st, ltot > 0.f ? g_s / ltot : 0.f); }
    }
    st_reset(st);
    if (!NSA_SKIP_WIN) attn_loop<0, false>(lds, K2, V2T, cur >= 8 ? cur - 8 : 0, cur, qf, t_col - 511, t_col, st, 0.f, tok_local, t_col, imp_row);
    { const float ltot = st.l + __shfl_xor(st.l, 32); lds_out_final_store(ob, c, h, st, ltot > 0.f ? g_w / ltot : 0.f, (bf16_t*)(ws + WS_AO), tokrow, head); }
}

DI void dil_tile(LAS unsigned char* lds, unsigned char* ws, int b, int g, int res16, int i0) {
    const int tid = opaque_tid(), lane = tid & 63, wave = tid >> 6, c = lane & 31, h = lane >> 5, r = c & 3;
    const int iq = i0 + wave * 8 + (c >> 2), t_col = 16 * iq + res16, tokrow = b * S + t_col, head = g * 4 + r;
    const bf16_t* Q = (const bf16_t*)(ws + WS_Q);
    const size_t slab = (size_t)(b * NG + g) * S * 64;
    bf16x8 qf[4];
    load_q(Q, tokrow, head, h, qf);
    AttnSt st; st_reset(st);
    {
        const bf16_t* Kb = (const bf16_t*)(ws + WS_KV + 4 * KVB) + slab + (size_t)res16 * 1024 * 64;
        const bf16_t* Vb = (const bf16_t*)(ws + WS_KV + 5 * KVB) + slab + (size_t)res16 * 64 * 1024;
        const int lq = iq, lmin = i0 - 128;
        attn_loop<0, false, DIL_NS>(lds, Kb, Vb, lmin > 0 ? lmin >> 6 : 0, (i0 + 63) >> 6, qf, lq - 128, lq, st, 0.f, 0, 0, nullptr);
    }
    {
        const int res4 = res16 & 3, c4 = res16 >> 2;
        const bf16_t* Kb = (const bf16_t*)(ws + WS_KV + 2 * KVB) + slab + (size_t)res4 * 4096 * 64;
        const bf16_t* Vb = (const bf16_t*)(ws + WS_KV + 3 * KVB) + slab + (size_t)res4 * 64 * 4096;
        const int lq = 4 * iq + c4, lmin = 4 * i0 + c4 - 128;
        if (DIL_PRIV) {
            asm volatile("s_waitcnt lgkmcnt(0)" ::: "memory");
            __builtin_amdgcn_s_barrier();
            const int wv = __builtin_amdgcn_readfirstlane(wave), lqmin = 4 * (i0 + 8 * wv) + c4, lqmax = lqmin + 28;
            attn_private(lds, Kb, Vb, lqmin - 128 > 0 ? (lqmin - 128) >> 6 : 0, lqmax >> 6, qf, lq - 128, lq, st);
        } else
        attn_loop<0, false, DIL_NS>(lds, Kb, Vb, lmin > 0 ? lmin >> 6 : 0, (4 * (i0 + 63) + c4) >> 6, qf, lq - 128, lq, st, 0.f, 0, 0, nullptr);
    }
    {
        const bf16_t* Kb = (const bf16_t*)(ws + WS_KV + 0 * KVB) + slab;
        const bf16_t* Vb = (const bf16_t*)(ws + WS_KV + 1 * KVB) + slab;
        const int lq = t_col, lmin = 16 * i0 + res16 - 128;
        if (DIL_PRIV) {
            const int wv = __builtin_amdgcn_readfirstlane(wave), lqmin = 16 * (i0 + 8 * wv) + res16, lqmax = lqmin + 112;
            attn_private(lds, Kb, Vb, lqmin - 128 > 0 ? (lqmin - 128) >> 6 : 0, lqmax >> 6, qf, lq - 128, lq, st);
        } else
        attn_loop<0, false, DIL_NS>(lds, Kb, Vb, lmin > 0 ? lmin >> 6 : 0, (16 * (i0 + 63) + res16) >> 6, qf, lq - 128, lq, st, 0.f, 0, 0, nullptr);
    }
    f32x16 out[2];
    const float ltot = st.l + __shfl_xor(st.l, 32), sc = ltot > 0.f ? 1.f / ltot : 0.f;
#pragma unroll
    for (int i = 0; i < 16; ++i) { out[0][i] = st.o[0][i] * sc; out[1][i] = st.o[1][i] * sc; }
    store_out((bf16_t*)(ws + WS_AO), tokrow, head, h, out);
}

constexpr int RT_RW_STRIDE = 128;
constexpr int RT_SC_OFF = 131072;
constexpr int RT_HIST_OFF = RT_SC_OFF + 8 * 8 * 32 * 4;
constexpr int MISC_OFF = 131072 + 12288;

DI void ln_router_phase(LAS unsigned char* lds, const Args& a, int layer, int G) {
    const int tid = opaque_tid(), lane = tid & 63, wave = tid >> 6;
    unsigned char* ws = a.ws;
    bf16_t* XB = (bf16_t*)(ws + WS_XB);
    bf16_t* HM = (bf16_t*)(ws + WS_HM);
    const float* modr = (const float*)(ws + WS_MOD) + (size_t)(layer * 2 + 1) * NB * 3072;
    const float* modm = (const float*)(ws + WS_MOD) + (size_t)(layer * 2 + 0) * NB * 3072;
    const float* xin = a.x;
#define LNR_LDX(tok_, j_) ((layer == 0) ? *(const f32x4*)(xin + (size_t)(tok_) * D + 4 * lane + 256 * (j_)) : bf4_to_f4(*(const u32x2*)(XB + (size_t)(tok_) * D + 4 * lane + 256 * (j_))))
    const bf16_t* Ym = (const bf16_t*)(ws + WS_Q);
    const float* lng = a.ln_g + (layer * 2 + 0) * D; const float* lnb = a.ln_b + (layer * 2 + 0) * D;
    int* eidx = (int*)(ws + WS_EIDX); float* ewt = (float*)(ws + WS_EWT);
    unsigned* ctl = (unsigned*)(ws + WS_CTL);
    LAS unsigned* hist = (LAS unsigned*)(lds + RT_HIST_OFF);
    LAS float* sc = (LAS float*)(lds + RT_SC_OFF) + wave * 256;
    constexpr int ROWB = 2064;
    LAS unsigned char* sthi = lds;
    LAS unsigned char* stlo = lds + 16 * ROWB;
    LAS float* part = (LAS float*)(lds + 2 * 16 * ROWB);
    f32x4 xn[4]; u32x2 yn[4];
    { const int tok0 = blockIdx.x * 16 + 2 * wave;
      if (tok0 < NTOK) {
#pragma unroll
        for (int j = 0; j < 4; ++j) { xn[j] = LNR_LDX(tok0, j); yn[j] = *(const u32x2*)(Ym + (size_t)tok0 * D + 4 * lane + 256 * j); } } }
    const int er = lane & 31, kh = lane >> 5;
    bf16x8 whi[8], wlo[8];
#pragma unroll
    for (int ks = 0; ks < 8; ++ks) {
        u32x4 hi, lo;
#pragma unroll
        for (int p = 0; p < 4; ++p) {
            const float w0 = a.router_w[(size_t)(128 * wave + 16 * ks + 8 * kh + 2 * p) * 32 + er], w1 = a.router_w[(size_t)(128 * wave + 16 * ks + 8 * kh + 2 * p + 1) * 32 + er];
            const unsigned hp = pk2(w0, w1);
            hi[p] = hp; lo[p] = pk2(w0 - bf2f((unsigned short)(hp & 0xffffu)), w1 - bf2f((unsigned short)(hp >> 16)));
        }
        whi[ks] = __builtin_bit_cast(bf16x8, hi); wlo[ks] = __builtin_bit_cast(bf16x8, lo);
    }
    const float rbias = a.router_b[lane & 31];
    if (tid < 32) hist[tid] = 0u;
    __syncthreads();
#pragma unroll 1
    for (int base = blockIdx.x * 16; base < NTOK; base += G * 16) {
#pragma unroll 1
        for (int ti = 0; ti < 2; ++ti) {
            const int tok = base + 2 * wave + ti, b = tok >> 14;
            bf16_t* xr = XB + (size_t)tok * D;
            f32x4 xc[4]; u32x2 yc[4];
#pragma unroll
            for (int j = 0; j < 4; ++j) { xc[j] = xn[j]; yc[j] = yn[j]; }
            { const int tokn = ti == 0 ? tok + 1 : base + G * 16 + 2 * wave;
              if (tokn < NTOK) {
#pragma unroll
                for (int j = 0; j < 4; ++j) { xn[j] = LNR_LDX(tokn, j); yn[j] = *(const u32x2*)(Ym + (size_t)tokn * D + 4 * lane + 256 * j); } } }
            f32x4 v[4]; float s = 0.f;
#pragma unroll
            for (int j = 0; j < 4; ++j) {
                const int col = 4 * lane + 256 * j;
                const f32x4 x = xc[j], gt = *(const f32x4*)(modm + b * 3072 + 2 * D + col);
                const u32x2 yy = yc[j];
                f32x4 yf; yf.x = bf2f((unsigned short)(yy.x & 0xffffu)); yf.y = bf2f((unsigned short)(yy.x >> 16)); yf.z = bf2f((unsigned short)(yy.y & 0xffffu)); yf.w = bf2f((unsigned short)(yy.y >> 16));
                v[j] = x * ALPHA + gt * yf;
                s += (v[j].x + v[j].y) + (v[j].z + v[j].w);
            }
            const float mean = wave_sum(s) * (1.f / D); float s2 = 0.f;
#pragma unroll
            for (int j = 0; j < 4; ++j) { v[j] = v[j] - mean; s2 += (v[j].x * v[j].x + v[j].y * v[j].y) + (v[j].z * v[j].z + v[j].w * v[j].w); }
            const float rstd = 1.f / sqrtf(wave_sum(s2) * (1.f / D) + LN_EPS);
#pragma unroll
            for (int j = 0; j < 4; ++j) {
                const int col = 4 * lane + 256 * j;
                const f32x4 gg = *(const f32x4*)(lng + col), bb = *(const f32x4*)(lnb + col);
                const f32x4 sh = *(const f32x4*)(modr + b * 3072 + col), scl = *(const f32x4*)(modr + b * 3072 + D + col);
                const f32x4 xnv = v[j] * rstd * gg + bb;
                { u32x2 xo; xo.x = pk2(xnv.x, xnv.y); xo.y = pk2(xnv.z, xnv.w); *(u32x2*)(xr + col) = xo; }
                const f32x4 hm = xnv * (scl + 1.f) + sh;
                u32x2 o; o.x = pk2(hm.x, hm.y); o.y = pk2(hm.z, hm.w);
                *(u32x2*)(HM + (size_t)tok * D + col) = o;
                u32x2 l2;
                l2.x = pk2(hm.x - bf2f((unsigned short)(o.x & 0xffffu)), hm.y - bf2f((unsigned short)(o.x >> 16)));
                l2.y = pk2(hm.z - bf2f((unsigned short)(o.y & 0xffffu)), hm.w - bf2f((unsigned short)(o.y >> 16)));
                *(LAS u32x2*)(sthi + (2 * wave + ti) * ROWB + col * 2) = o;
                *(LAS u32x2*)(stlo + (2 * wave + ti) * ROWB + col * 2) = l2;
            }
        }
        __syncthreads();
        f32x16 acc;
#pragma unroll
        for (int i = 0; i < 16; ++i) acc[i] = 0.f;
        { const int rowo = (lane & 15) * ROWB;
#pragma unroll
          for (int ks = 0; ks < 8; ++ks) {
              const int kb = (128 * wave + 16 * ks + 8 * kh) * 2;
              const bf16x8 bh = *(const LAS bf16x8*)(sthi + rowo + kb), bl = *(const LAS bf16x8*)(stlo + rowo + kb);
              acc = MFMA32(whi[ks], bh, acc); acc = MFMA32(wlo[ks], bh, acc); acc = MFMA32(whi[ks], bl, acc);
          } }
        if ((lane & 31) < 16) {
#pragma unroll
            for (int jj = 0; jj < 4; ++jj) { const f32x4 pv = {acc[4 * jj], acc[4 * jj + 1], acc[4 * jj + 2], acc[4 * jj + 3]};
                *(LAS f32x4*)(part + ((wave * 16 + (lane & 31)) * 32 + 8 * jj + 4 * kh)) = pv; }
        }
        __syncthreads();
        {
            const int tl = 2 * wave + (lane >> 5), e = lane & 31; float lg = 0.f;
#pragma unroll
            for (int w2 = 0; w2 < 8; ++w2) lg += part[(w2 * 16 + tl) * 32 + e];
            const float sg = 1.f / (1.f + expf(-lg));
            const float x = sg + rbias;
            float g1 = x; g1 = fmx(g1, DPPF(g1, 0xB1, 0xf)); g1 = fmx(g1, DPPF(g1, 0x4E, 0xf)); { const float t_ = DPPF(g1, 0x141, 0xf); g1 = fmx(g1, DPPF(t_, 0x1B, 0xf)); }
            const unsigned long long b1 = __ballot(x == g1);
            const int first1 = __ffs((unsigned)(b1 >> (lane & ~7)) & 0xffu) - 1;
            const float x2 = ((lane & 7) == first1) ? -INFINITY : x;
            float g2 = x2; g2 = fmx(g2, DPPF(g2, 0xB1, 0xf)); g2 = fmx(g2, DPPF(g2, 0x4E, 0xf)); { const float t_ = DPPF(g2, 0x141, 0xf); g2 = fmx(g2, DPPF(t_, 0x1B, 0xf)); }
            const unsigned long long b2 = __ballot(x2 == g2);
            const int first2 = __ffs((unsigned)(b2 >> (lane & ~7)) & 0xffu) - 1;
            const float gs = g1 + g2;
            float bs = fmx(gs, DPPF(gs, 0x128, 0xf)); bs = xh16_max(bs);
            const unsigned long long bb = __ballot(gs == bs);
            const int best = (__ffs((unsigned)(bb >> (lane & 32))) - 1) >> 3;
            const int src = (lane & 32) + best * 8;
            const int i1 = __shfl(first1, src), i2 = __shfl(first2, src);
            const int e1 = best * 8 + i1, e2 = best * 8 + i2;
            const float w1 = __shfl(sg, (lane & 32) + e1), w2 = __shfl(sg, (lane & 32) + e2);
            if (e == 0) {
                const int tok = base + tl; const float inv = 1.f / (w1 + w2);
                eidx[tok * 2] = e1; eidx[tok * 2 + 1] = e2; ewt[tok * 2] = w1 * inv; ewt[tok * 2 + 1] = w2 * inv;
                (void)__hip_atomic_fetch_add(hist + e1, 1u, __ATOMIC_RELAXED, __HIP_MEMORY_SCOPE_WORKGROUP); (void)__hip_atomic_fetch_add(hist + e2, 1u, __ATOMIC_RELAXED, __HIP_MEMORY_SCOPE_WORKGROUP);
            }
        }
    }
    __syncthreads();
    if (tid < 32) { const unsigned hv = hist[tid]; if (hv) atomicAdd(ctl + CW_CNT + layer * 32 + tid, hv); }
}

DI void build_tile_table(LAS int* tstart, const unsigned* cnt) {
    if (threadIdx.x < 64) { const int e = threadIdx.x; int nt = 0;
        if (e < 32) nt = (int)((__hip_atomic_load(cnt + e, __ATOMIC_RELAXED, __HIP_MEMORY_SCOPE_AGENT) + 255u) >> 8);
        int inc = nt;
#pragma unroll
        for (int d = 1; d < 32; d <<= 1) { const int o = __shfl_up(inc, d); if (e >= d) inc += o; }
        if (e < 32) tstart[e] = inc - nt;
        if (e == 31) tstart[32] = inc; }
    __syncthreads();
    for (int t = threadIdx.x; t < 320; t += NTHREADS) { int e = 0;
#pragma unroll 1
        for (int j = 1; j < 32; ++j) e += (tstart[j] <= t) ? 1 : 0;
        ((LAS unsigned char*)tstart)[2048 + t] = (unsigned char)e; }
    __syncthreads();
}

DI void scatter_phase(LAS unsigned char* lds, const Args& a, int layer, int G) {
    const int tid = opaque_tid(), lane = tid & 63, wave = tid >> 6;
    unsigned char* ws = a.ws;
    unsigned* ctl = (unsigned*)(ws + WS_CTL);
    LAS int* tstart = (LAS int*)(lds + MISC_OFF);
    LAS unsigned* lh = (LAS unsigned*)(lds + MISC_OFF + 256);
    LAS unsigned* lbase = (LAS unsigned*)(lds + MISC_OFF + 512);
    LAS int* slots = (LAS int*)(lds + MISC_OFF + 1024);
    const int* eidx = (const int*)(ws + WS_EIDX); const float* ewt = (const float*)(ws + WS_EWT);
    int* row_tok = (int*)(ws + WS_ROWTOK) + layer * ROWS_PAD; float* row_w = (float*)(ws + WS_ROWW) + layer * ROWS_PAD;
    const bf16_t* HM = (const bf16_t*)(ws + WS_HM); bf16_t* HS = (bf16_t*)(ws + WS_HS);
    build_tile_table(tstart, ctl + CW_CNT + layer * 32);
    for (int chunk = blockIdx.x; chunk < NTOK / 128; chunk += G) {
        if (tid < 32) lh[tid] = 0u;
        __syncthreads();
        int e = 0; unsigned rank = 0;
        if (tid < 256) { e = eidx[chunk * 256 + tid]; rank = __hip_atomic_fetch_add(lh + e, 1u, __ATOMIC_RELAXED, __HIP_MEMORY_SCOPE_WORKGROUP); }
        __syncthreads();
        if (tid < 32) { const unsigned n = lh[tid]; lbase[tid] = n ? atomicAdd(ctl + CW_CUR + layer * 32 + tid, n) : 0u; }
        __syncthreads();
        if (tid < 256) {
            const int slot = tstart[e] * 256 + (int)(lbase[e] + rank);
            slots[tid] = slot;
            row_tok[slot] = chunk * 256 + tid;
            row_w[slot] = ewt[chunk * 256 + tid];
        }
        __syncthreads();
        if (!MOE_GATHER)
        for (int i0 = wave * 32; i0 < wave * 32 + 32; i0 += 8) {
            u32x4 v0[8], v1[8];
#pragma unroll
            for (int u = 0; u < 8; ++u) { const int tok = chunk * 128 + ((i0 + u) >> 1); const u32x4* src = (const u32x4*)(HM + (size_t)tok * D) + lane; v0[u] = src[0]; v1[u] = src[64]; }
#pragma unroll
            for (int u = 0; u < 8; ++u) { u32x4* dst = (u32x4*)(HS + (size_t)slots[i0 + u] * D) + lane; dst[0] = v0[u]; dst[64] = v1[u]; }
        }
        __syncthreads();
    }
}

DI void ln_moe_phase(const Args& a, int layer, int G, bool write_hm) {
    const int tid = opaque_tid(), lane = tid & 63, wave = tid >> 6;
    unsigned char* ws = a.ws;
    float* X = a.out; bf16_t* XB = (bf16_t*)(ws + WS_XB);
    const bf16_t* Y = (const bf16_t*)(ws + WS_Y);
    const float* modc = (const float*)(ws + WS_MOD) + (size_t)(layer * 2 + 1) * NB * 3072;
    const float* modn = (const float*)(ws + WS_MOD) + (size_t)((layer + 1) * 2 + 0) * NB * 3072;
    const float* lng = a.ln_g + (layer * 2 + 1) * D; const float* lnb = a.ln_b + (layer * 2 + 1) * D;
    bf16_t* HM = (bf16_t*)(ws + WS_HM);
    for (int tok = blockIdx.x * NWAVES + wave; tok < NTOK; tok += G * NWAVES) {
        const int b = tok >> 14;
        float* xr = X + (size_t)tok * D; bf16_t* xb = XB + (size_t)tok * D;
        f32x4 v[4]; float s = 0.f;
#pragma unroll
        for (int j = 0; j < 4; ++j) {
            const int col = 4 * lane + 256 * j;
            const f32x4 x = bf4_to_f4(*(const u32x2*)(xb + col)), gt = *(const f32x4*)(modc + b * 3072 + 2 * D + col);
            const u32x2 y0 = *(const u32x2*)(Y + (size_t)tok * D + col), y1 = *(const u32x2*)(Y + ((size_t)NTOK + tok) * D + col);
            f32x4 ys;
            ys.x = bf2f((unsigned short)(y0.x & 0xffffu)) + bf2f((unsigned short)(y1.x & 0xffffu));
            ys.y = bf2f((unsigned short)(y0.x >> 16)) + bf2f((unsigned short)(y1.x >> 16));
            ys.z = bf2f((unsigned short)(y0.y & 0xffffu)) + bf2f((unsigned short)(y1.y & 0xffffu));
            ys.w = bf2f((unsigned short)(y0.y >> 16)) + bf2f((unsigned short)(y1.y >> 16));
            v[j] = x * ALPHA + gt * ys;
            s += (v[j].x + v[j].y) + (v[j].z + v[j].w);
        }
        const float mean = wave_sum(s) * (1.f / D); float s2 = 0.f;
#pragma unroll
        for (int j = 0; j < 4; ++j) { v[j] = v[j] - mean; s2 += (v[j].x * v[j].x + v[j].y * v[j].y) + (v[j].z * v[j].z + v[j].w * v[j].w); }
        const float rstd = 1.f / sqrtf(wave_sum(s2) * (1.f / D) + LN_EPS);
#pragma unroll
        for (int j = 0; j < 4; ++j) {
            const int col = 4 * lane + 256 * j;
            const f32x4 gg = *(const f32x4*)(lng + col), bb = *(const f32x4*)(lnb + col);
            const f32x4 xn = v[j] * rstd * gg + bb;
            if (layer == 1) *(f32x4*)(xr + col) = xn;
            else { u32x2 xo; xo.x = pk2(xn.x, xn.y); xo.y = pk2(xn.z, xn.w); *(u32x2*)(xb + col) = xo; }
            if (write_hm) {
                const f32x4 sh = *(const f32x4*)(modn + b * 3072 + col), scl = *(const f32x4*)(modn + b * 3072 + D + col);
                const f32x4 hm = xn * (scl + 1.f) + sh;
                u32x2 o; o.x = pk2(hm.x, hm.y); o.y = pk2(hm.z, hm.w);
                *(u32x2*)(HM + (size_t)tok * D + col) = o;
            }
        }
    }
}

DI void cmp2_phase(LAS unsigned char* lds, const Args& a, int G) {
    const int tid = opaque_tid(), lane = tid & 63, wave = tid >> 6;
    unsigned char* ws = a.ws;
    const bf16_t* hid = (const bf16_t*)(ws + WS_HID);
    const float* rope = (const float*)(ws + WS_ROPE);
    bf16_t* KC = (bf16_t*)(ws + WS_KC); bf16_t* VCT = (bf16_t*)(ws + WS_VCT);
    LAS float* w2s = (LAS float*)lds;
    LAS unsigned char* hs = lds + 65536 + wave * 4096;
    for (int rg0 = blockIdx.x * NWAVES; rg0 < 2048; rg0 += G * NWAVES) {
        const int R0 = (rg0 + wave) * 8;
        const int kv = (rg0 * 8) >> 13, bg = (R0 >> 10) & 7, n0 = R0 & 1023;
        const float* w2 = kv ? a.cw2_v : a.cw2_k;
        __syncthreads();
        for (int i = tid; i < 256 * 16; i += NTHREADS) *(LAS f32x4*)(w2s + 4 * i) = *(const f32x4*)(w2 + 4 * i);
#pragma unroll
#if CMP_SPLITK
        for (int i = 0; i < 4; ++i) {
            const int e0 = (lane + 64 * i) * 8, c0 = e0 & 255; const size_t ro = (size_t)(R0 + (e0 >> 8)) * 256 + c0;
            const float* P0 = (const float*)(ws + WS_CMPP); const float* P1 = P0 + (size_t)16384 * 256; const float* bs = (const float*)(ws + WS_CBIAS) + kv * 256 + c0;
            f32x4 v0 = *(const f32x4*)(P0 + ro) + *(const f32x4*)(P1 + ro) + *(const f32x4*)bs, v1 = *(const f32x4*)(P0 + ro + 4) + *(const f32x4*)(P1 + ro + 4) + *(const f32x4*)(bs + 4);
#pragma unroll
            for (int j = 0; j < 4; ++j) {
                float x = v0[j]; v0[j] = 0.5f * x * (1.f + tanhf(0.7978845608028654f * (x + 0.044715f * x * x * x)));
                x = v1[j];       v1[j] = 0.5f * x * (1.f + tanhf(0.7978845608028654f * (x + 0.044715f * x * x * x)));
            }
            u32x4 w; w.x = pk2(v0[0], v0[1]); w.y = pk2(v0[2], v0[3]); w.z = pk2(v1[0], v1[1]); w.w = pk2(v1[2], v1[3]);
            *(LAS u32x4*)(hs + (lane + 64 * i) * 16) = w;
        }
#else
        for (int i = 0; i < 4; ++i) *(LAS u32x4*)(hs + (lane + 64 * i) * 16) = *(const u32x4*)(hid + (size_t)R0 * 256 + (lane + 64 * i) * 8);
#endif
        __syncthreads();
        float acc[8];
#pragma unroll
        for (int i = 0; i < 8; ++i) acc[i] = 0.f;
#pragma unroll 4
        for (int k = 0; k < 256; k += 8) {
            float w[8];
#pragma unroll
            for (int j = 0; j < 8; ++j) w[j] = w2s[(k + j) * 64 + lane];
#pragma unroll
            for (int i = 0; i < 8; ++i) {
                const u32x4 hp = *(const LAS u32x4*)(hs + i * 512 + k * 2);
#pragma unroll
                for (int j = 0; j < 4; ++j) { acc[i] += bf2f((unsigned short)(hp[j] & 0xffffu)) * w[2 * j]; acc[i] += bf2f((unsigned short)(hp[j] >> 16)) * w[2 * j + 1]; }
            }
        }
#pragma unroll
        for (int i = 0; i < 8; ++i) {
            const int n = n0 + i;
            float v = n < 1023 ? acc[i] : 0.f;
            if (kv == 0) {
                const float partner = __shfl_xor(v, 8);
                if (lane < 16 && n < 1023) {
                    const int b = bg >> 2; const float* cs = rope + ((size_t)b * S + 16 * n + 31) * 16; const int f = lane & 7;
                    v = (lane < 8) ? v * cs[f] - partner * cs[8 + f] : partner * cs[8 + f] + v * cs[f];
                }
                KC[((size_t)bg * 1024 + n) * 64 + lane] = (bf16_t)(pk2(v, 0.f) & 0xffffu);
            } else {
                VCT[(size_t)bg * 65536 + (size_t)(n >> 6) * 4096 + lane * 64 + vperm(n & 63)] = (bf16_t)(pk2(v, 0.f) & 0xffffu);
            }
        }
    }
}

#define XB_TMO      128
#define XB_XCNT(j)  (256  + 64 * (j))
#define XB_XSUB(j)  (1280 + 64 * (j))
#define XB_XGEN(j)  (2304 + 64 * (j))
#define XB_TOP      3328
#define XB_TOPGEN   3392
#define XCD_BAR_WORDS 3456
#define XB_SPIN_CAP (1u << 22)

__device__ __forceinline__ unsigned xb_ld(unsigned* p)              { return __hip_atomic_load(p, __ATOMIC_RELAXED, __HIP_MEMORY_SCOPE_AGENT); }
__device__ __forceinline__ unsigned xb_add(unsigned* p, unsigned v) { return __hip_atomic_fetch_add(p, v, __ATOMIC_RELAXED, __HIP_MEMORY_SCOPE_AGENT); }
__device__ __forceinline__ unsigned xb_xcc_id() { return (unsigned)__builtin_amdgcn_s_getreg((3 << 11) | 20) & 0xFu; }
#define XB_SPIN(cond, bar) do { unsigned _sp = 0; while (cond) { __builtin_amdgcn_s_sleep(1); \
    if ((++_sp & 255u) == 0u) { if (xb_ld(&(bar)[XB_TMO])) break; if (_sp > XB_SPIN_CAP) { atomicAdd(&(bar)[XB_TMO], 1u); break; } } } } while (0)

struct XcdBarrier {
    unsigned* bar; unsigned x;
    volatile LAS unsigned* st;
};

__device__ __forceinline__ XcdBarrier xcd_barrier_post(unsigned* bar, volatile LAS unsigned* st) {
    XcdBarrier b; b.bar = bar; b.x = xb_xcc_id(); b.st = st;
    if (threadIdx.x == 0) (void)xb_add(&bar[XB_XCNT(b.x)], 1u);
    return b;
}
__device__ __forceinline__ void xcd_barrier_complete(unsigned* bar, unsigned x, unsigned& nloc, unsigned& nx) {
    const unsigned G = gridDim.x * gridDim.y * gridDim.z;
    unsigned sum, cnt, mine, sp = 0u;
    for (;;) {
        sum = 0u; cnt = 0u; mine = 0u;
#pragma unroll
        for (unsigned j = 0; j < 16; ++j) { const unsigned c = xb_ld(&bar[XB_XCNT(j)]); sum += c; cnt += (c > 0u) ? 1u : 0u; mine = (j == x) ? c : mine; }
        if (sum == G) break;
        __builtin_amdgcn_s_sleep(1);
        if ((++sp & 255u) == 0u) { if (xb_ld(&bar[XB_TMO])) break; if (sp > XB_SPIN_CAP) { atomicAdd(&bar[XB_TMO], 1u); break; } }
    }
    nloc = mine > 0u ? mine : 1u; nx = cnt > 0u ? cnt : 1u;
}

__device__ __forceinline__ void xcd_barrier(const XcdBarrier& b) {
    asm volatile("s_waitcnt vmcnt(0)" ::: "memory");
    __syncthreads();
    if (threadIdx.x == 0) {
        unsigned* bar = b.bar;
        __builtin_amdgcn_s_waitcnt(0);
        unsigned nloc = b.st[0], nx = b.st[1];
        if (nloc == 0u) { xcd_barrier_complete(bar, b.x, nloc, nx); b.st[0] = nloc; b.st[1] = nx; }
        const unsigned old = xb_add(&bar[XB_XSUB(b.x)], 1u);
        const unsigned gen = old / nloc;
        if (old + 1u == (gen + 1u) * nloc) {
            __builtin_amdgcn_fence(__ATOMIC_RELEASE, "agent");
            asm volatile("s_waitcnt vmcnt(0)" ::: "memory");
            const unsigned og = xb_add(&bar[XB_TOP], 1u);
            const unsigned tg = og / nx;
            if (og + 1u == (tg + 1u) * nx) xb_add(&bar[XB_TOPGEN], 1u);
            else XB_SPIN(xb_ld(&bar[XB_TOPGEN]) == tg, bar);
            __builtin_amdgcn_fence(__ATOMIC_ACQUIRE, "agent");
            xb_add(&bar[XB_XGEN(b.x)], 1u);
            asm volatile("s_waitcnt vmcnt(0)" ::: "memory");
        } else {
            XB_SPIN(xb_ld(&bar[XB_XGEN(b.x)]) == gen, bar);
            __builtin_amdgcn_fence(__ATOMIC_ACQUIRE, "agent");
            asm volatile("s_waitcnt vmcnt(0)" ::: "memory");
        }
    }
    __syncthreads();
}

DI void prologue_phase(LAS unsigned char* lds, const Args& a, int G) {
    const int tid = opaque_tid(), lane = tid & 63, wave = tid >> 6;
    unsigned char* ws = a.ws;
    LAS float* red = (LAS float*)(lds + 131072);
    LAS float* sil = (LAS float*)lds;
    if ((int)blockIdx.x < 200) {
        for (int i = tid; i < 2 * D; i += NTHREADS) { const float cv = a.c[i]; sil[i] = cv / (1.f + expf(-cv)); }
        __syncthreads();
    }
    for (int bt = blockIdx.x; bt < 200; bt += G) {
        float a0 = 0.f, a1 = 0.f;
        if (bt < 192) {
            const int is = bt / 48, col = (bt % 48) * 64 + lane;
            const float* W = a.ada_w + (size_t)is * D * 3072;
#pragma unroll 16
            for (int k = wave * 128; k < wave * 128 + 128; ++k) {
                const float w = W[(size_t)k * 3072 + col];
                a0 += sil[k] * w; a1 += sil[D + k] * w;
            }
        } else {
            const int kv = (bt - 192) >> 2, col = ((bt - 192) & 3) * 64 + lane;
            const float* pe = kv ? a.cpos_v : a.cpos_k; const float* w1 = kv ? a.cw1_v : a.cw1_k;
            for (int k = wave * 256; k < wave * 256 + 256; ++k) a0 += pe[k] * w1[(size_t)k * 256 + col];
        }
        red[(wave * 2 + 0) * 64 + lane] = a0; red[(wave * 2 + 1) * 64 + lane] = a1;
        __syncthreads();
        if (wave < 2) {
            float s = 0.f;
#pragma unroll
            for (int w = 0; w < 8; ++w) s += red[(w * 2 + wave) * 64 + lane];
            if (bt < 192) { const int is = bt / 48, col = (bt % 48) * 64 + lane; ((float*)(ws + WS_MOD))[((size_t)is * NB + wave) * 3072 + col] = s + a.ada_b[is * 3072 + col]; }
            else if (wave == 0) { const int kv = (bt - 192) >> 2, col = ((bt - 192) & 3) * 64 + lane; ((float*)(ws + WS_CBIAS))[kv * 256 + col] = s; }
        }
        __syncthreads();
    }
    const int gtid = blockIdx.x * NTHREADS + tid, gn = G * NTHREADS;
    for (int idx = gtid; idx < NTOK * 8; idx += gn) {
        const int tok = idx >> 3, i = idx & 7;
        const float inv = powf(500000.0f, -(float)i * 0.125f);
        const float ang = (float)a.pos[tok] * inv;
        float sn, cs; sincosf(ang, &sn, &cs);
        float* rp = (float*)(ws + WS_ROPE) + (size_t)tok * 16;
        rp[i] = cs; rp[8 + i] = sn;
    }
    for (int idx = gtid; idx < 2 * ROWS_PAD; idx += gn) ((int*)(ws + WS_ROWTOK))[idx] = -1;
    LAS float* scr = (LAS float*)(lds + wave * 16384);
    const int gw = blockIdx.x * NWAVES + wave, NGW = G * NWAVES;
    constexpr int I_IN0 = 16 * (NSA_NP / 32), I_O = 16 * 32, I_IN1 = 16 * (DIL_N / 32), I_C1 = 32 * 8;
    constexpr int NITEMS = I_IN0 + 2 * I_O + I_IN1 + 2 * I_C1 + MOE_ITEMS;
    for (int it = gw; it < NITEMS; it += NGW) {
        int r = it;
        if (r < I_IN0) { transpose_plain(a.nsa_w_in, D, NSA_N, NSA_NP, (bf16_t*)(ws + WS_WIN0T), scr, r, lane); continue; } r -= I_IN0;
        if (r < I_O) { transpose_plain(a.nsa_w_o, D, D, D, (bf16_t*)(ws + WS_WO0T), scr, r, lane); continue; } r -= I_O;
        if (r < I_IN1) { transpose_plain(a.dil_w_in, D, DIL_N, DIL_N, (bf16_t*)(ws + WS_WIN1T), scr, r, lane); continue; } r -= I_IN1;
        if (r < I_O) { transpose_plain(a.dil_w_o, D, D, D, (bf16_t*)(ws + WS_WO1T), scr, r, lane); continue; } r -= I_O;
#if CMP_SPLITK
        if (r < 2 * I_C1) { const int kv = r >= I_C1, rr = kv ? r - I_C1 : r, kb = rr >> 3, nb = rr & 7, k0 = 64 * kb, n0 = 32 * nb;
            transpose_item((kv ? a.cw1_v : a.cw1_k) + (size_t)k0 * 256 + n0, 256, 32, (bf16_t*)(ws + WS_CW1T) + ((size_t)(kv * 2 + (k0 >> 10)) * 256 + n0) * 1024 + (k0 & 1023), 1024, scr, lane); continue; } r -= 2 * I_C1;
#else
        if (r < I_C1) { transpose_plain(a.cw1_k, 2048, 256, 256, (bf16_t*)(ws + WS_CW1T), scr, r, lane); continue; } r -= I_C1;
        if (r < I_C1) { transpose_plain(a.cw1_v, 2048, 256, 256, (bf16_t*)(ws + WS_CW1T) + (size_t)256 * 2048, scr, r, lane); continue; } r -= I_C1;
#endif
        moe_convert_item(a.moe_wg, a.moe_wu, a.moe_wd, (bf16_t*)(ws + WS_GUT), (bf16_t*)(ws + WS_DNT), scr, r, lane);
    }
}

template <int layer>
DI void layer_body(LAS unsigned char* lds, const Args& a, const XcdBarrier& bar, int G) {
    unsigned char* ws = a.ws;
    const float* rope = (const float*)(ws + WS_ROPE);
    const float* mod = (const float*)(ws + WS_MOD);
    unsigned* ctl = (unsigned*)(ws + WS_CTL);
    LAS int* tstart = (LAS int*)(lds + MISC_OFF);

#if PH_PROJ
        if (layer == 0) {
            pg8::Gemm g{(const bf16_t*)(ws + WS_HM), (const bf16_t*)(ws + WS_WIN0T)}; pg8::StaticOrder So; So.init(NTOK, NSA_NP, G, (int)blockIdx.x);
            EpiProj<0> E{ws, rope};
            pg8::gemm_phase<D, D, EpiProj<0>, pg8::StaticOrder, true, true>(lds, g, So, E);
        } else {
            pg8::Gemm g{(const bf16_t*)(ws + WS_HM), (const bf16_t*)(ws + WS_WIN1T)}; pg8::StaticOrder So; So.init(NTOK, DIL_N, G, (int)blockIdx.x);
            EpiProj<1> E{ws, rope};
#if PROJ1_PERM
            { const int tid3 = opaque_tid(); LAS unsigned* rtl = (LAS unsigned*)(lds + pg8::AG_RT_OFF);
              __syncthreads();
              for (int idx = tid3; idx < 12 * 256; idx += NTHREADS) { pg8::Unit uu; if (So.next(idx >> 8, uu)) rtl[idx] = (unsigned)proj1_tok(uu.pm * 256 + (idx & 255)) * (unsigned)(D * 2); }
              __syncthreads(); }
            pg8::gemm_phase<D, D, EpiProj<1>, pg8::StaticOrder, true, true, true>(lds, g, So, E);
#else
            pg8::gemm_phase<D, D, EpiProj<1>, pg8::StaticOrder, true, true>(lds, g, So, E);
#endif
        }
#endif
        xcd_barrier(bar); STAMP(layer == 0 ? 3 : 13);
        if (layer == 0) {
#if PH_CMP
#if CMP_SPLITK
            { pg8::Gemm g{(const bf16_t*)(ws + WS_KV), (const bf16_t*)(ws + WS_CW1T)}; CmpOrder2 So{G, (int)blockIdx.x};
              EpiCmpP E{(float*)(ws + WS_CMPP)};
              pg8::gemm_phase<1024, 1024, EpiCmpP, CmpOrder2, true, true>(lds, g, So, E); }
#else
            { pg8::Gemm g{(const bf16_t*)(ws + WS_KV), (const bf16_t*)(ws + WS_CW1T)}; CmpOrder So{G, (int)blockIdx.x};
              EpiCmp1 E{(bf16_t*)(ws + WS_HID), (const float*)(ws + WS_CBIAS)};
              pg8::gemm_phase<1024, 2048, EpiCmp1, CmpOrder, true, true>(lds, g, So, E); }
#endif
            xcd_barrier(bar); STAMP(4);
            cmp2_phase(lds, a, G);
#endif
            xcd_barrier(bar); STAMP(5);
#if PH_NSA
            if (T5_STATIC && __builtin_amdgcn_readfirstlane(threadIdx.x) >= 256) __builtin_amdgcn_s_setprio(1);
            { int it = 0; for (int T = blockIdx.x; T < 2048; T += G, ++it) { const int bg = T & 7; int qt = T >> 3;
                if (G == 256 && (it & 1)) qt = (qt & ~31) + (31 - (qt & 31));
                nsa_tile(lds, ws, bg >> 2, bg & 3, qt * 64); } }
            if (T5_STATIC) __builtin_amdgcn_s_setprio(0);
#endif
        } else {
#if PH_DIL
            for (int T = blockIdx.x; T < 2048; T += G) { const int bg = T & 7, rest = T >> 3; dil_tile(lds, ws, bg >> 2, bg & 3, rest >> 4, (rest & 15) * 64); }
#endif
        }
        xcd_barrier(bar); STAMP(layer == 0 ? 6 : 14);
#if PH_WO
        {
            pg8::Gemm g{(const bf16_t*)(ws + WS_AO), (const bf16_t*)(ws + (layer == 0 ? WS_WO0T : WS_WO1T))}; pg8::StaticOrder So; So.init(NTOK, D, G, (int)blockIdx.x);
            EpiWo E{(bf16_t*)(ws + WS_Q)};
            pg8::gemm_phase<D, D, EpiWo, pg8::StaticOrder, true, true>(lds, g, So, E);
        }
#endif
        xcd_barrier(bar); STAMP(layer == 0 ? 7 : 15);
#if PH_LNR
        ln_router_phase(lds, a, layer, G);
#endif
        xcd_barrier(bar); STAMP(layer == 0 ? 8 : 16);
#if PH_SCAT
        scatter_phase(lds, a, layer, G);
#endif
        xcd_barrier(bar); STAMP(layer == 0 ? 9 : 17);
        build_tile_table(tstart, ctl + CW_CNT + layer * 32);
#if PH_GU
#if MOE_GATHER
        { const int tid3 = opaque_tid(); __syncthreads(); const int ntl = tstart[32]; const int* rowtok = (const int*)(ws + WS_ROWTOK) + layer * ROWS_PAD;
          LAS unsigned* rtl = (LAS unsigned*)(lds + pg8::AG_RT_OFF);
          for (int idx = tid3; idx < 12 * 256; idx += NTHREADS) { const int L = (idx >> 8) * G + (int)blockIdx.x;
              if (L < ntl * 4) { unsigned tok = (unsigned)rowtok[(L >> 2) * 256 + (idx & 255)] >> 1; tok = tok < (unsigned)NTOK ? tok : 0u; rtl[idx] = tok * (unsigned)(D * 2); } }
          __syncthreads(); }
        { pg8::Gemm g{(const bf16_t*)(ws + WS_HM), (const bf16_t*)(ws + WS_GUT)}; MoeOrder So{tstart, G, (int)blockIdx.x};
          EpiGU E{(bf16_t*)(ws + WS_HH)};
          pg8::gemm_phase<D, D, EpiGU, MoeOrder, true, true, true>(lds, g, So, E); }
#else
        { pg8::Gemm g{(const bf16_t*)(ws + WS_HS), (const bf16_t*)(ws + WS_GUT)}; MoeOrder So{tstart, G, (int)blockIdx.x};
          EpiGU E{(bf16_t*)(ws + WS_HH)};
          pg8::gemm_phase<D, D, EpiGU, MoeOrder, true, true>(lds, g, So, E); }
#endif
#endif
        xcd_barrier(bar); STAMP(layer == 0 ? 10 : 18);
#if PH_DN
        { pg8::Gemm g{(const bf16_t*)(ws + WS_HH), (const bf16_t*)(ws + WS_DNT)}; MoeOrder So{tstart, G, (int)blockIdx.x};
          EpiDown E{(bf16_t*)(ws + WS_Y), (const int*)(ws + WS_ROWTOK) + layer * ROWS_PAD, (const float*)(ws + WS_ROWW) + layer * ROWS_PAD};
          pg8::gemm_phase<FE, FE, EpiDown, MoeOrder, true, true>(lds, g, So, E); }
#endif
        xcd_barrier(bar); STAMP(layer == 0 ? 11 : 19);
#if PH_LNM
        ln_moe_phase(a, layer, G, layer == 0);
#endif
        if (layer == 0) {
            const int tid2 = opaque_tid(), lane = tid2 & 63, wave = tid2 >> 6;
            LAS float* scr = (LAS float*)(lds + wave * 16384);
            const size_t wo = (size_t)NE * D * FE;
            for (int it = blockIdx.x * NWAVES + wave; it < MOE_ITEMS; it += G * NWAVES)
                moe_convert_item(a.moe_wg + wo, a.moe_wu + wo, a.moe_wd + wo, (bf16_t*)(ws + WS_GUT), (bf16_t*)(ws + WS_DNT), scr, it, lane);
            xcd_barrier(bar); STAMP(12);
        }
}

__global__ void __launch_bounds__(NTHREADS, 2) mega_fwd(Args a) {
    extern __shared__ __attribute__((aligned(16))) unsigned char lds_raw[];
    LAS unsigned char* lds = (LAS unsigned char*)lds_raw;
    cg::grid_group grid = cg::this_grid();
    { volatile LAS unsigned* st0 = (volatile LAS unsigned*)(lds + 146432); if (threadIdx.x < 2) st0[threadIdx.x] = 0u; }
    __syncthreads();
    const XcdBarrier bar = xcd_barrier_post((unsigned*)(a.ws + WS_CTL) + CW_BAR, (volatile LAS unsigned*)(lds + 146432));
    const int G = gridDim.x, tid = opaque_tid(), lane = tid & 63, wave = tid >> 6;
    unsigned char* ws = a.ws;
    const float* rope = (const float*)(ws + WS_ROPE);
    const float* mod = (const float*)(ws + WS_MOD);
    unsigned* ctl = (unsigned*)(ws + WS_CTL);
    LAS int* tstart = (LAS int*)(lds + MISC_OFF);

    STAMP(0);
#if PH_PRO
    prologue_phase(lds, a, G);
#endif
    grid.sync(); STAMP(1);
    {
        const int wv = blockIdx.x * NWAVES + wave, NW = G * NWAVES;
        for (int b = 0; b < NB; ++b) {
            f32x4 sh[4], sc1[4];
#pragma unroll
            for (int j = 0; j < 4; ++j) { const int col = 4 * lane + 256 * j; sh[j] = *(const f32x4*)(mod + (size_t)b * 3072 + col); sc1[j] = *(const f32x4*)(mod + (size_t)b * 3072 + D + col) + 1.f; }
            for (int tok0 = b * S + wv; tok0 < (b + 1) * S; tok0 += 4 * NW) {
                f32x4 v[4][4];
#pragma unroll
                for (int u = 0; u < 4; ++u) { const int tok = tok0 + u * NW;
                    if (tok < (b + 1) * S) {
#pragma unroll
                        for (int j = 0; j < 4; ++j) v[u][j] = *(const f32x4*)(a.x + (size_t)tok * D + 4 * lane + 256 * j); } }
#pragma unroll
                for (int u = 0; u < 4; ++u) { const int tok = tok0 + u * NW;
                    if (tok < (b + 1) * S) {
#pragma unroll
                        for (int j = 0; j < 4; ++j) { const f32x4 h4 = v[u][j] * sc1[j] + sh[j];
                            u32x2 o; o.x = pk2(h4.x, h4.y); o.y = pk2(h4.z, h4.w);
                            *(u32x2*)((bf16_t*)(ws + WS_HM) + (size_t)tok * D + 4 * lane + 256 * j) = o; } } }
            }
        }
    }
    xcd_barrier(bar); STAMP(2);

    layer_body<0>(lds, a, bar, G);
#ifdef EXTRA_SYNCS
    for (int i = 0; i < 20; ++i) xcd_barrier(bar);
#endif
    layer_body<1>(lds, a, bar, G);
#if PROBE_A || PROBE_B
    xcd_barrier(bar); STAMP(20);
    if (blockIdx.x == 0 && threadIdx.x == 0) {
        const unsigned long long* ts = (const unsigned long long*)(a.ws + 2048);
#ifdef PROBE_CLK
        if (PROBE_A) { const float us = (float)(ts[PROBE_A] - ts[PROBE_A - 1]) * 0.01f; const float cyc = (float)(ts[32 + PROBE_A] - ts[32 + PROBE_A - 1]); a.out[0] += 4.f + cyc / us * 0.01f; }
#else
        if (PROBE_A) { const float us = (float)(ts[PROBE_A] - ts[PROBE_A - 1]) * 0.01f; a.out[0] += 4.f + (us - (float)PROBE_OFF) / (float)PROBE_DIV; }
#endif
        if (PROBE_B) { const float us = (float)(ts[PROBE_B] - ts[PROBE_B - 1]) * 0.01f; const int n = (int)(us * 0.5f); for (int i = 1; i <= n && i < NTOK; ++i) a.out[(size_t)i * D] += 3.0f; }
    }
#endif
}

extern "C" void kernel_launch(void* const* d_in, const int* in_sizes, int n_in, void* d_out, int out_size, void* d_ws, size_t ws_size, hipStream_t stream) {
    static int grid = 0;
    if (grid == 0) {
        if (n_in != 22 || out_size != NTOK * D || ws_size < WS_END) { fprintf(stderr, "kernel_launch: unexpected shapes (n_in %d, out %d, ws %zu)\n", n_in, out_size, ws_size); grid = -1; return; }
        int dev = 0, cus = 0, per_cu = 0;
        if (hipGetDevice(&dev) != hipSuccess || hipDeviceGetAttribute(&cus, hipDeviceAttributeMultiprocessorCount, dev) != hipSuccess) { grid = -1; return; }
        if (hipFuncSetAttribute((const void*)mega_fwd, hipFuncAttributeMaxDynamicSharedMemorySize, LDS_BYTES) != hipSuccess) { fprintf(stderr, "kernel_launch: hipFuncSetAttribute failed\n"); grid = -1; return; }
        if (hipOccupancyMaxActiveBlocksPerMultiprocessor(&per_cu, (const void*)mega_fwd, NTHREADS, LDS_BYTES) != hipSuccess || per_cu < 1) { fprintf(stderr, "kernel_launch: occupancy query failed (%d)\n", per_cu); grid = -1; return; }
        grid = cus * per_cu;
    }
    if (grid < 0) return;
    (void)hipMemsetAsync((char*)d_ws + WS_CTL, 0, CTL_ZERO_BYTES, stream);
    Args a{};
    a.x = (const float*)d_in[0]; a.c = (const float*)d_in[1]; a.pos = (const int*)d_in[2]; a.ada_w = (const float*)d_in[3]; a.ada_b = (const float*)d_in[4];
    a.ln_g = (const float*)d_in[5]; a.ln_b = (const float*)d_in[6]; a.nsa_w_in = (const float*)d_in[7]; a.cpos_k = (const float*)d_in[8]; a.cw1_k = (const float*)d_in[9];
    a.cw2_k = (const float*)d_in[10]; a.cpos_v = (const float*)d_in[11]; a.cw1_v = (const float*)d_in[12]; a.cw2_v = (const float*)d_in[13]; a.nsa_w_o = (const float*)d_in[14];
    a.dil_w_in = (const float*)d_in[15]; a.dil_w_o = (const float*)d_in[16]; a.router_w = (const float*)d_in[17]; a.router_b = (const float*)d_in[18];
    a.moe_wg = (const float*)d_in[19]; a.moe_wu = (const float*)d_in[20]; a.moe_wd = (const float*)d_in[21];
    a.out = (float*)d_out; a.ws = (unsigned char*)d_ws;
    void* args[] = {&a};
    const hipError_t e = hipLaunchCooperativeKernel((const void*)mega_fwd, dim3(grid), dim3(NTHREADS), args, LDS_BYTES, stream);
    if (e != hipSuccess) fprintf(stderr, "kernel_launch: cooperative launch failed: %s (grid %d)\n", hipGetErrorString(e), grid);
}
```

```cpp
#include <hip/hip_runtime.h>
#include <hip/hip_cooperative_groups.h>
#include <cstdio>
#include <cstdint>
namespace cg = cooperative_groups;
#ifndef PH_PRO
#define PH_PRO 1
#endif
#ifndef PH_PROJ
#define PH_PROJ 1
#endif
#ifndef PH_CMP
#define PH_CMP 1
#endif
#ifndef PH_NSA
#define PH_NSA 1
#endif
#ifndef PH_DIL
#define PH_DIL 1
#endif
#ifndef PH_WO
#define PH_WO 1
#endif
#ifndef PH_LNR
#define PH_LNR 1
#endif
#ifndef PH_SCAT
#define PH_SCAT 1
#endif
#ifndef PH_GU
#define PH_GU 1
#endif
#ifndef PH_DN
#define PH_DN 1
#endif
#ifndef PH_LNM
#define PH_LNM 1
#endif

namespace pg8 {
#define PG8_LAS __attribute__((address_space(3)))
typedef unsigned short bf16_t;
typedef short bf16x8 __attribute__((ext_vector_type(8)));
typedef float f32x4 __attribute__((ext_vector_type(4)));
typedef unsigned u32x4 __attribute__((ext_vector_type(4)));
constexpr int AG_RT_OFF = 131072;
constexpr int BM = 256, BK = 64, HALF = 128, HTB = HALF * BK * 2  , STAGE_BYTES = 8 * HTB, NXCD = 8, WGM = 8;

__host__ __device__ __forceinline__ int lds_byte(int r, int c) { const int st = (r >> 4) * 2 + (c >> 5), rr = r & 15, cc = c & 31, ob = rr * 64 + cc * 2; return st * 1024 + (ob ^ (((ob >> 9) & 1) << 5)); }
__host__ __device__ __forceinline__ void stage_rc(int b, int& R, int& C) { const int st = b / 1024, sb = b % 1024, swz = sb ^ (((sb >> 9) & 1) << 5); R = (st >> 1) * 16 + swz / 64; C = (st & 1) * 32 + (swz % 64) / 2; }
__host__ __device__ __forceinline__ int perm32(int rho) { const int n = rho >> 4, i = rho & 15; return 8 * (i >> 2) + 4 * n + (i & 3); }

struct Unit { int pm, pn; int ord = 0; };
struct Gemm { const bf16_t* A; const bf16_t* Bt; };

struct StaticOrder {
    int nM, nN, nwg, G, c;
    __host__ __device__ void init(int M, int N, int G_, int c_) { nM = M / BM; nN = N / BM; nwg = nM * nN; G = G_; c = c_; }
    __host__ __device__ bool next(int i, Unit& u) const {
        const long L = (long)i * G + c; if (L >= nwg) return false;
        int wgid = (int)L; { const int q = nwg / NXCD, r = nwg % NXCD, xcd = wgid % NXCD, off = wgid / NXCD; wgid = (xcd < r ? xcd * (q + 1) : r * (q + 1) + (xcd - r) * q) + off; }
        const int nig = WGM * nN, gid = wgid / nig, fm = gid * WGM, gsz = (nM - fm) < WGM ? (nM - fm) : WGM;
        u.pm = fm + ((wgid % nig) % gsz); u.pn = (wgid % nig) / gsz; return true;
    }
    __device__ __forceinline__ void a_ready(const Unit&) const {}
    __device__ __forceinline__ void done(const Unit&) const {}
};

template <int LDA, int KK, class Epi, class Sched, bool ALIGN_EPI = false, bool SP2 = false, bool AG = false>
__device__ __forceinline__ void gemm_phase(PG8_LAS unsigned char* lds, const Gemm g, const Sched& S, const Epi& E) {
    int tid_ = threadIdx.x; asm volatile("" : "+v"(tid_));
    const int tid = tid_, wid = __builtin_amdgcn_readfirstlane(tid >> 6), lane = tid & 63, wr = wid >> 2, wc = wid & 3, fr = lane & 15, fq = lane >> 4;
    constexpr int K = KK, nt = K / BK;
    unsigned voffA[2], voffB[2];
    int Rrow[2]; unsigned Ccol2[2];
#pragma unroll
    for (int i = 0; i < 2; ++i) { int R, C; stage_rc(tid * 16 + i * 8192, R, C); const int Rb = Epi::PERM ? ((R & ~31) + perm32(R & 31)) : R;
        voffA[i] = (unsigned)(R * LDA + C) * 2u; voffB[i] = (unsigned)(Rb * K + C) * 2u; Rrow[i] = R; Ccol2[i] = (unsigned)C * 2u; }
    const PG8_LAS unsigned* rtl = (const PG8_LAS unsigned*)(lds + AG_RT_OFF);
    unsigned gc[2][2], gn[2][2];
#define PG8_GLOAD(dst, uidx) do { _Pragma("unroll") for (int h_ = 0; h_ < 2; ++h_) _Pragma("unroll") for (int i_ = 0; i_ < 2; ++i_) dst[h_][i_] = rtl[(uidx) * 256 + 128 * h_ + Rrow[i_]] + Ccol2[i_]; } while (0)
#define PG8_STAGE_G(bufoff, kbyte, gv) do { _Pragma("unroll") for (int _i = 0; _i < 2; ++_i) \
        __builtin_amdgcn_global_load_lds((const unsigned*)((const char*)g.A + (size_t)(kbyte) + (size_t)(gv)[_i]), (PG8_LAS unsigned*)(lds + (bufoff) + ldsw + _i * 8192), 16, 0, 0); } while (0)
    constexpr size_t kstep = (size_t)(BK * 2);
    constexpr size_t hstepA = (size_t)HALF * LDA * 2, hstepB = (size_t)HALF * K * 2;
    constexpr size_t tstepA = 2 * hstepA, tstepB = 2 * hstepB;
    const unsigned ldsw = (unsigned)wid * 1024u;
    const int aoff = lds_byte(wr * 64 + fr, fq * 8), boff = lds_byte(wc * 32 + fr, fq * 8);
#define PG8_SA(b, h) (((b) * 2 + (h)) * HTB)
#define PG8_SB(b, h) ((4 + (b) * 2 + (h)) * HTB)
#define PG8_STAGE(bufoff, gbase, voff) do { _Pragma("unroll") for (int _i = 0; _i < 2; ++_i) \
        __builtin_amdgcn_global_load_lds((const unsigned*)((const char*)(gbase) + (voff)[_i]), (PG8_LAS unsigned*)(lds + (bufoff) + ldsw + _i * 8192), 16, 0, 0); } while (0)
#define PG8_LDA(dst, b, h) do { _Pragma("unroll") for (int m = 0; m < 4; ++m) _Pragma("unroll") for (int k = 0; k < 2; ++k) dst[m][k] = *(const PG8_LAS bf16x8*)(lds + PG8_SA(b, h) + aoff + m * 2048 + k * 1024); } while (0)
#define PG8_LDB(dst, b, h) do { _Pragma("unroll") for (int n = 0; n < 2; ++n) _Pragma("unroll") for (int k = 0; k < 2; ++k) dst[n][k] = *(const PG8_LAS bf16x8*)(lds + PG8_SB(b, h) + boff + n * 2048 + k * 1024); } while (0)
#define PG8_MMA(ai, bj, At, Bt) do { __builtin_amdgcn_s_setprio(1); _Pragma("unroll") for (int m = 0; m < 4; ++m) _Pragma("unroll") for (int n = 0; n < 2; ++n) _Pragma("unroll") for (int k = 0; k < 2; ++k) \
        acc[ai][bj][m][n] = __builtin_amdgcn_mfma_f32_16x16x32_bf16(Bt[n][k], At[m][k], acc[ai][bj][m][n], 0, 0, 0); __builtin_amdgcn_s_setprio(0); } while (0)
#define PG8_WAIT_V(n) asm volatile("s_waitcnt vmcnt(" #n ")" ::: "memory")
#define PG8_WAIT_L(n) asm volatile("s_waitcnt lgkmcnt(" #n ")" ::: "memory")
#define PG8_BAR __builtin_amdgcn_s_barrier()
#define PG8_SCHED __builtin_amdgcn_sched_barrier(0)
    Unit cur, nxt; int ui = 0;
    if (!S.next(0, cur)) return;
    f32x4 acc[2][2][4][2];
#pragma unroll
    for (int a = 0; a < 2; ++a)
#pragma unroll
        for (int b = 0; b < 2; ++b)
#pragma unroll
            for (int m = 0; m < 4; ++m)
#pragma unroll
                for (int n = 0; n < 2; ++n) acc[a][b][m][n] = (f32x4){0.f, 0.f, 0.f, 0.f};
    bf16x8 At[4][2], B0[2][2], B1[2][2];
    const char* cA = (const char*)g.A + (size_t)cur.pm * tstepA; const char* cB = (const char*)g.Bt + (size_t)cur.pn * tstepB;
    S.a_ready(cur);
    if constexpr (SP2) {
        if constexpr (AG) { PG8_GLOAD(gc, 0); }
        PG8_STAGE(PG8_SB(0, 0), cB, voffB); PG8_STAGE(PG8_SB(0, 1), cB + hstepB, voffB);
        if constexpr (AG) { PG8_STAGE_G(PG8_SA(0, 0), 0, gc[0]); PG8_STAGE_G(PG8_SA(0, 1), 0, gc[1]); } else { PG8_STAGE(PG8_SA(0, 0), cA, voffA); PG8_STAGE(PG8_SA(0, 1), cA + hstepA, voffA); }
        if (wr == 1) PG8_BAR;
        PG8_WAIT_V(2); PG8_BAR;
        PG8_STAGE(PG8_SB(1, 0), cB + kstep, voffB);
        if constexpr (AG) PG8_STAGE_G(PG8_SA(1, 0), kstep, gc[0]); else PG8_STAGE(PG8_SA(1, 0), cA + kstep, voffA);
        PG8_STAGE(PG8_SB(1, 1), cB + hstepB + kstep, voffB);
        PG8_WAIT_V(6); PG8_BAR;
    } else {
        PG8_STAGE(PG8_SB(0, 0), cB, voffB); PG8_STAGE(PG8_SA(0, 0), cA, voffA); PG8_STAGE(PG8_SB(0, 1), cB + hstepB, voffB); PG8_STAGE(PG8_SA(0, 1), cA + hstepA, voffA);
        if (wr == 1) PG8_BAR;
        PG8_WAIT_V(4); PG8_BAR;
        PG8_STAGE(PG8_SB(1, 0), cB + kstep, voffB); PG8_STAGE(PG8_SA(1, 0), cA + kstep, voffA); PG8_STAGE(PG8_SB(1, 1), cB + hstepB + kstep, voffB);
        PG8_WAIT_V(6); PG8_BAR;
    }
    for (;;) {
        const bool has_next = S.next(ui + 1, nxt);
        const char* nA = has_next ? (const char*)g.A + (size_t)nxt.pm * tstepA : cA; const char* nB = has_next ? (const char*)g.Bt + (size_t)nxt.pn * tstepB : cB;
        if constexpr (AG) { if (has_next) { PG8_GLOAD(gn, ui + 1); } else {
#pragma unroll
            for (int h_ = 0; h_ < 2; ++h_)
#pragma unroll
                for (int i_ = 0; i_ < 2; ++i_) gn[h_][i_] = gc[h_][i_]; } }
        for (int t = 0; t < nt; t += 2) {
            const bool last = (t == nt - 2);
            const char* a1 = cA + (size_t)(t + 1) * kstep;
            const char* a2 = last ? nA : cA + (size_t)(t + 2) * kstep; const char* b2 = last ? nB : cB + (size_t)(t + 2) * kstep;
            const char* a3 = a2 + kstep; const char* b3 = b2 + kstep;
            if (last && has_next) S.a_ready(nxt);
            unsigned g2[2][2]; size_t k2 = 0;
            if constexpr (AG) {
#pragma unroll
                for (int h_ = 0; h_ < 2; ++h_)
#pragma unroll
                    for (int i_ = 0; i_ < 2; ++i_) g2[h_][i_] = last ? gn[h_][i_] : gc[h_][i_];
                k2 = last ? (size_t)0 : (size_t)(t + 2) * kstep;
            }
            if constexpr (SP2) {
            PG8_LDB(B0, 0, 0); PG8_LDB(B1, 0, 1); PG8_SCHED; PG8_LDA(At, 0, 0); if constexpr (AG) PG8_STAGE_G(PG8_SA(1, 1), (size_t)(t + 1) * kstep, gc[1]); else PG8_STAGE(PG8_SA(1, 1), a1 + hstepA, voffA);
            PG8_WAIT_V(8); PG8_WAIT_L(0); PG8_BAR; PG8_MMA(0, 0, At, B0); PG8_MMA(0, 1, At, B1); PG8_BAR; PG8_SCHED;
            PG8_LDA(At, 0, 1); PG8_STAGE(PG8_SB(0, 0), b2, voffB); PG8_STAGE(PG8_SB(0, 1), b2 + hstepB, voffB); if constexpr (AG) PG8_STAGE_G(PG8_SA(0, 0), k2, g2[0]); else PG8_STAGE(PG8_SA(0, 0), a2, voffA);
            PG8_WAIT_V(8); PG8_WAIT_L(0); PG8_BAR; PG8_MMA(1, 0, At, B0); PG8_MMA(1, 1, At, B1); PG8_BAR; PG8_SCHED;
            PG8_LDB(B0, 1, 0); PG8_LDB(B1, 1, 1); PG8_SCHED; PG8_LDA(At, 1, 0); if constexpr (AG) PG8_STAGE_G(PG8_SA(0, 1), k2, g2[1]); else PG8_STAGE(PG8_SA(0, 1), a2 + hstepA, voffA);
            PG8_WAIT_V(8); PG8_WAIT_L(0); PG8_BAR; PG8_MMA(0, 0, At, B0); PG8_MMA(0, 1, At, B1); PG8_BAR; PG8_SCHED;
            PG8_LDA(At, 1, 1); PG8_STAGE(PG8_SB(1, 0), b3, voffB); PG8_STAGE(PG8_SB(1, 1), b3 + hstepB, voffB); if constexpr (AG) PG8_STAGE_G(PG8_SA(1, 0), k2 + kstep, g2[0]); else PG8_STAGE(PG8_SA(1, 0), a3, voffA);
            PG8_WAIT_V(8); PG8_WAIT_L(0); PG8_BAR; PG8_MMA(1, 0, At, B0); PG8_MMA(1, 1, At, B1); PG8_BAR; PG8_SCHED;
            } else {
            PG8_LDB(B0, 0, 0); PG8_SCHED; PG8_LDA(At, 0, 0); PG8_STAGE(PG8_SA(1, 1), a1 + hstepA, voffA);
            PG8_WAIT_L(8); PG8_BAR; PG8_WAIT_L(0); PG8_MMA(0, 0, At, B0); PG8_BAR; PG8_SCHED;
            PG8_LDB(B1, 0, 1); PG8_STAGE(PG8_SB(0, 0), b2, voffB);
            PG8_BAR; PG8_WAIT_L(0); PG8_MMA(0, 1, At, B1); PG8_BAR;
            PG8_LDA(At, 0, 1); PG8_STAGE(PG8_SA(0, 0), a2, voffA);
            PG8_BAR; PG8_WAIT_L(0); PG8_MMA(1, 0, At, B0); PG8_BAR; PG8_SCHED;
            PG8_STAGE(PG8_SB(0, 1), b2 + hstepB, voffB);
            PG8_WAIT_V(6); PG8_BAR; PG8_MMA(1, 1, At, B1); PG8_BAR;
            PG8_LDB(B0, 1, 0); PG8_SCHED; PG8_LDA(At, 1, 0); PG8_STAGE(PG8_SA(0, 1), a2 + hstepA, voffA);
            PG8_WAIT_L(8); PG8_BAR; PG8_WAIT_L(0); PG8_MMA(0, 0, At, B0); PG8_BAR; PG8_SCHED;
            PG8_LDB(B1, 1, 1); PG8_STAGE(PG8_SB(1, 0), b3, voffB);
            PG8_BAR; PG8_WAIT_L(0); PG8_MMA(0, 1, At, B1); PG8_BAR;
            PG8_LDA(At, 1, 1); PG8_STAGE(PG8_SA(1, 0), a3, voffA);
            PG8_BAR; PG8_WAIT_L(0); PG8_MMA(1, 0, At, B0); PG8_BAR; PG8_SCHED;
            PG8_STAGE(PG8_SB(1, 1), b3 + hstepB, voffB);
            PG8_WAIT_V(6); PG8_BAR; PG8_MMA(1, 1, At, B1); PG8_BAR;
            }
        }
        if constexpr (ALIGN_EPI) { if (wr == 0) PG8_BAR; }
        if constexpr (!Epi::AFTER_DRAIN) { E(acc, cur, wr, wc, fr, fq); S.done(cur); }
        if (!has_next) break;
#pragma unroll
        for (int a = 0; a < 2; ++a)
#pragma unroll
            for (int b = 0; b < 2; ++b)
#pragma unroll
                for (int m = 0; m < 4; ++m)
#pragma unroll
                    for (int n = 0; n < 2; ++n) acc[a][b][m][n] = (f32x4){0.f, 0.f, 0.f, 0.f};
        cur = nxt; cA = nA; cB = nB; ++ui;
        if constexpr (AG) {
#pragma unroll
            for (int h_ = 0; h_ < 2; ++h_)
#pragma unroll
                for (int i_ = 0; i_ < 2; ++i_) gc[h_][i_] = gn[h_][i_]; }
        if constexpr (ALIGN_EPI) { if (wr == 1) PG8_BAR; }
    }
    PG8_WAIT_V(0);
    if constexpr (!ALIGN_EPI) { if (wr == 0) PG8_BAR; }
    PG8_BAR;
    if constexpr (Epi::AFTER_DRAIN) { E.fused(acc, cur, wr, wc, fr, fq, lds, wid, lane); S.done(cur); }
#undef PG8_SA
#undef PG8_SB
#undef PG8_STAGE
#undef PG8_STAGE_G
#undef PG8_GLOAD
#undef PG8_LDA
#undef PG8_LDB
#undef PG8_MMA
#undef PG8_WAIT_V
#undef PG8_WAIT_L
#undef PG8_BAR
#undef PG8_SCHED
}
}


#ifndef SEL16
#define SEL16 1
#endif
#ifndef SEL_GATHER
#define SEL_GATHER 0
#endif
#ifndef T5_STATIC
#define T5_STATIC 0
#endif
#ifndef T5_PRIO
#define T5_PRIO 0
#endif
#ifndef PREQK
#define PREQK 0
#endif
#ifndef AT_VAR
#define AT_VAR 0
#endif
#ifndef AT_STAG
#define AT_STAG 0
#endif
#ifndef AT_STAG_MODE
#define AT_STAG_MODE 0
#endif
#ifndef V_AFTER_QK
#define V_AFTER_QK 1
#endif
#ifndef AT_NO_BARRIER
#define AT_NO_BARRIER 0
#endif
#ifndef SEL_NS
#define SEL_NS 8
#endif
#ifndef SEL_PRIME
#define SEL_PRIME 0
#endif
#ifndef MOE_GATHER
#define MOE_GATHER 1
#endif
#ifndef DIL_NS
#define DIL_NS 4
#endif
#ifndef DIL_PRIV
#define DIL_PRIV 1
#endif
#ifndef DEFER_THR
#define DEFER_THR 8
#endif
#ifndef SEL_SPREAD
#define SEL_SPREAD 1
#endif
#ifndef ROPE_INLANE
#define ROPE_INLANE 1
#endif
#ifndef WIN_FRAG
#define WIN_FRAG 1
#endif
#ifndef CMP_FRAG
#define CMP_FRAG 1
#endif
#ifndef GATES_SPLIT
#define GATES_SPLIT 1
#endif
#ifndef AT_NO_COMPUTE
#define AT_NO_COMPUTE 0
#endif
#ifndef NSA_SKIP_SEL
#define NSA_SKIP_SEL 0
#endif
#ifndef NSA_SKIP_TOPK
#define NSA_SKIP_TOPK 0
#endif
#ifndef NSA_SKIP_CMP
#define NSA_SKIP_CMP 0
#endif
#ifndef NSA_SKIP_WIN
#define NSA_SKIP_WIN 0
#endif
#ifndef PROBE_A
#define PROBE_A 0
#endif
#ifndef PROBE_OFF
#define PROBE_OFF 0
#endif
#ifndef PROBE_DIV
#define PROBE_DIV 100
#endif
#ifndef PROBE_B
#define PROBE_B 0
#endif
#define STAMP(k) do { if ((PROBE_A || PROBE_B) && blockIdx.x == 0 && threadIdx.x == 0) { ((unsigned long long*)(a.ws + 2048))[k] = __builtin_amdgcn_s_memrealtime(); ((unsigned long long*)(a.ws + 2048))[32 + (k)] = __builtin_amdgcn_s_memtime(); } } while (0)
#define LAS __attribute__((address_space(3)))
#define DI __device__ __forceinline__
__device__ __forceinline__ int opaque_tid() { int t = threadIdx.x; asm volatile("" : "+v"(t)); return t; }
typedef unsigned short bf16_t;
typedef short bf16x8 __attribute__((ext_vector_type(8)));
typedef float f32x4 __attribute__((ext_vector_type(4)));
typedef float f32x16 __attribute__((ext_vector_type(16)));
typedef float f32x2 __attribute__((ext_vector_type(2)));
typedef __bf16 bf16x2n __attribute__((ext_vector_type(2)));
typedef unsigned u32x4 __attribute__((ext_vector_type(4)));
typedef unsigned u32x2 __attribute__((ext_vector_type(2)));

constexpr int D = 1024, NB = 2, S = 16384, NTOK = NB * S, NG = 4;
constexpr int NSA_N = 2608, NSA_NP = 2816, DIL_N = 2560;
constexpr int NE = 32, FE = 512;
constexpr int ROWS_PAD = 73728;
constexpr float ALPHA = 1.41421356237309515f, LN_EPS = 1e-5f, LOG2E = 1.4426950408889634f;
constexpr int NWAVES = 8, NTHREADS = 512;
constexpr int LDS_BYTES = 147456;
constexpr int RING_BYTES = 131072;

constexpr size_t MiB = 1u << 20;
constexpr size_t WS_CTL = 0;
constexpr size_t CTL_ZERO_BYTES = 32768;
constexpr int CW_BAR = 4096;
constexpr size_t WS_MOD = 1 * MiB;
constexpr size_t WS_CBIAS = 1 * MiB + 128 * 1024;
constexpr size_t WS_ROPE = 2 * MiB;
constexpr size_t WS_EIDX = 4 * MiB;
constexpr size_t WS_EWT = 4 * MiB + 256 * 1024;
constexpr size_t WS_ROWTOK = 4 * MiB + 512 * 1024;
constexpr size_t WS_ROWW = 5 * MiB + 128 * 1024;
constexpr size_t WS_WIN0T = 6 * MiB;
constexpr size_t WS_WO0T = 12 * MiB;
constexpr size_t WS_WIN1T = 14 * MiB;
constexpr size_t WS_WO1T = 19 * MiB;
constexpr size_t WS_CW1T = 21 * MiB;
constexpr size_t WS_KC = 23 * MiB;
constexpr size_t WS_VCT = 24 * MiB;
constexpr size_t WS_G = 25 * MiB;
constexpr size_t WS_HID = 31 * MiB;
constexpr size_t WS_GUT = 40 * MiB;
constexpr size_t WS_DNT = 104 * MiB;
constexpr size_t WS_HM = 136 * MiB;
constexpr size_t WS_Q = 200 * MiB;
constexpr size_t WS_KV = 264 * MiB;
constexpr size_t KVB = 16 * MiB;
constexpr size_t WS_AO = 360 * MiB;
constexpr size_t WS_HS = 200 * MiB;
constexpr size_t WS_HH = 344 * MiB;
constexpr size_t WS_Y = 200 * MiB;
constexpr size_t WS_XB = 424 * MiB;
constexpr size_t WS_END = 488 * MiB;
constexpr int CW_CNT = 0;
constexpr int CW_CUR = 64;

struct Args {
    const float* x; const float* c; const int* pos; const float* ada_w; const float* ada_b; const float* ln_g; const float* ln_b;
    const float* nsa_w_in; const float* cpos_k; const float* cw1_k; const float* cw2_k; const float* cpos_v; const float* cw1_v; const float* cw2_v;
    const float* nsa_w_o; const float* dil_w_in; const float* dil_w_o; const float* router_w; const float* router_b;
    const float* moe_wg; const float* moe_wu; const float* moe_wd;
    float* out; unsigned char* ws;
};

DI unsigned pk2(float lo, float hi) { f32x2 v = {lo, hi}; return __builtin_bit_cast(unsigned, __builtin_convertvector(v, bf16x2n)); }
DI float bf2f(unsigned short b) { return __builtin_bit_cast(float, (unsigned)b << 16); }
#define DPPF(x, ctrl, rmask) __builtin_bit_cast(float, __builtin_amdgcn_update_dpp(0, __builtin_bit_cast(int, (x)), (ctrl), (rmask), 0xf, true))
DI float wave_sum(float v) {
    v += DPPF(v, 0x111, 0xf); v += DPPF(v, 0x112, 0xf); v += DPPF(v, 0x114, 0xf); v += DPPF(v, 0x118, 0xf);
    v += DPPF(v, 0x142, 0xa); v += DPPF(v, 0x143, 0xc);
    return __builtin_bit_cast(float, __builtin_amdgcn_readlane(__builtin_bit_cast(int, v), 63));
}
DI int vperm32(int l) { return (l & ~31) | (((l >> 2) & 3) << 3) | (((l >> 4) & 1) << 2) | (l & 3); }
DI int vperm(int l) { return (l & ~12) | ((l & 4) << 1) | ((l & 8) >> 1); }

DI unsigned wave_umax(unsigned v) {
    v = max(v, (unsigned)__builtin_amdgcn_update_dpp(0, (int)v, 0x111, 0xf, 0xf, true));
    v = max(v, (unsigned)__builtin_amdgcn_update_dpp(0, (int)v, 0x112, 0xf, 0xf, true));
    v = max(v, (unsigned)__builtin_amdgcn_update_dpp(0, (int)v, 0x114, 0xf, 0xf, true));
    v = max(v, (unsigned)__builtin_amdgcn_update_dpp(0, (int)v, 0x118, 0xf, 0xf, true));
    v = max(v, (unsigned)__builtin_amdgcn_update_dpp(0, (int)v, 0x142, 0xa, 0xf, true));
    v = max(v, (unsigned)__builtin_amdgcn_update_dpp(0, (int)v, 0x143, 0xc, 0xf, true));
    return (unsigned)__builtin_amdgcn_readlane((int)v, 63);
}
DI float fmx(float a, float b) { return __builtin_elementwise_maximum(a, b); }
DI float xh32_max(float v) { unsigned x_ = __builtin_bit_cast(unsigned, v), y_ = x_; asm volatile("s_nop 1\n\tv_permlane32_swap_b32 %0, %1" : "+v"(x_), "+v"(y_)); return fmx(__builtin_bit_cast(float, x_), __builtin_bit_cast(float, y_)); }
DI float xh16_max(float v) { unsigned x_ = __builtin_bit_cast(unsigned, v), y_ = x_; asm volatile("s_nop 1\n\tv_permlane16_swap_b32 %0, %1" : "+v"(x_), "+v"(y_)); return fmx(__builtin_bit_cast(float, x_), __builtin_bit_cast(float, y_)); }
DI float sigmoidf_(float v) { return 1.f / (1.f + __expf(-v)); }
#define MFMA32(a, b, c) __builtin_amdgcn_mfma_f32_32x32x16_bf16((a), (b), (c), 0, 0, 0)

DI void transpose_item(const float* src, int ldn, int nvalid, bf16_t* dst, int ldk, LAS float* scr, int lane, bool rperm = false) {
    const int nn = lane & 31;
#pragma unroll 8
    for (int i = 0; i < 32; ++i) { const int kk = 2 * i + (lane >> 5); scr[kk * 33 + nn] = (nn < nvalid) ? src[(size_t)kk * ldn + nn] : 0.f; }
    asm volatile("s_waitcnt lgkmcnt(0)" ::: "memory");
    const int c = lane & 7;
#pragma unroll
    for (int j = 0; j < 4; ++j) { const int n = (lane >> 3) + 8 * j; const LAS float* s = scr + (8 * c) * 33 + ((rperm && n < 16) ? vperm(n) : n);
        u32x4 o; o.x = pk2(s[0 * 33], s[1 * 33]); o.y = pk2(s[2 * 33], s[3 * 33]); o.z = pk2(s[4 * 33], s[5 * 33]); o.w = pk2(s[6 * 33], s[7 * 33]);
        *(u32x4*)(dst + (size_t)n * ldk + 8 * c) = o; }
    asm volatile("s_waitcnt lgkmcnt(0)" ::: "memory");
}
DI void transpose_plain(const float* W, int K, int N, int Npad, bf16_t* WT, LAS float* scr, int item, int lane, int ropemode = 0) {
    const int nblk = Npad / 32, kb = item / nblk, nb = item % nblk, k0 = 64 * kb, n0 = 32 * nb;
    int nvalid = N - n0; nvalid = nvalid < 0 ? 0 : (nvalid > 32 ? 32 : nvalid);
    bool rp = false;
    if (ROPE_INLANE && ropemode && (n0 & 63) == 0) { const int pn = n0 >> 8; rp = pn < 4 || (pn <= 9 && ((pn - 4) & 1) == 0 && (ropemode == 2 || ((pn - 4) >> 1) >= 1)); }
    transpose_item(W + (size_t)k0 * N + (nvalid > 0 ? n0 : 0), N, nvalid, WT + (size_t)n0 * K + k0, K, scr, lane, rp);
}
constexpr int MOE_ITEMS_GU = NE * 16 * 16;
constexpr int MOE_ITEMS_DN = NE * 8 * 32;
constexpr int MOE_ITEMS = 2 * MOE_ITEMS_GU + MOE_ITEMS_DN;
DI void moe_convert_item(const float* wg, const float* wu, const float* wd, bf16_t* GUT, bf16_t* DNT, LAS float* scr, int item, int lane) {
    if (item < 2 * MOE_ITEMS_GU) {
        const int up = item >= MOE_ITEMS_GU; int r = up ? item - MOE_ITEMS_GU : item;
        const int e = r >> 8, kb = (r >> 4) & 15, nb = r & 15, k0 = 64 * kb, n0 = 32 * nb;
        const float* W = (up ? wu : wg) + (size_t)e * D * FE;
        const int row0 = e * 1024 + (n0 >> 7) * 256 + up * 128 + (n0 & 127);
        transpose_item(W + (size_t)k0 * FE + n0, FE, 32, GUT + (size_t)row0 * D + k0, D, scr, lane);
    } else {
        const int r = item - 2 * MOE_ITEMS_GU; const int e = r >> 8, kb = (r >> 5) & 7, nb = r & 31, k0 = 64 * kb, n0 = 32 * nb;
        const float* W = wd + (size_t)e * FE * D;
        transpose_item(W + (size_t)k0 * D + n0, D, 32, DNT + ((size_t)e * 1024 + n0) * FE + k0, FE, scr, lane);
    }
}

DI f32x4 bf4_to_f4(u32x2 w) { f32x4 r; r.x = bf2f((unsigned short)(w.x & 0xffffu)); r.y = bf2f((unsigned short)(w.x >> 16)); r.z = bf2f((unsigned short)(w.y & 0xffffu)); r.w = bf2f((unsigned short)(w.y >> 16)); return r; }
DI void hmod_row(const float* xrow, const float* modb  , bf16_t* orow, int lane) {
#pragma unroll
    for (int j = 0; j < 4; ++j) {
        const int col = 4 * lane + 256 * j;
        const f32x4 v = *(const f32x4*)(xrow + col), sh = *(const f32x4*)(modb + col), sc = *(const f32x4*)(modb + D + col);
        u32x2 o; o.x = pk2(v.x * (1.f + sc.x) + sh.x, v.y * (1.f + sc.y) + sh.y); o.y = pk2(v.z * (1.f + sc.z) + sh.z, v.w * (1.f + sc.w) + sh.w);
        *(u32x2*)(orow + col) = o;
    }
}

using pg8::Unit;
constexpr int HALF = 128;
#define EPI_ROWS(u, wr, fr, ai, m) ((u).pm * 256 + (ai) * 128 + (wr) * 64 + (m) * 16 + (fr))

DI void rope8(f32x4& v0, f32x4& v1, const float* cs  , int fq, bool active) {
    f32x4 p0, p1;
#pragma unroll
    for (int j = 0; j < 4; ++j) { p0[j] = __shfl_xor(v0[j], 16); p1[j] = __shfl_xor(v1[j], 16); }
    if (active) {
        const f32x4 c0 = *(const f32x4*)(cs), c1 = *(const f32x4*)(cs + 4), s0 = *(const f32x4*)(cs + 8), s1 = *(const f32x4*)(cs + 12);
        if (fq == 0) { v0 = v0 * c0 - p0 * s0; v1 = v1 * c1 - p1 * s1; }
        else         { v0 = p0 * s0 + v0 * c0; v1 = p1 * s1 + v1 * c1; }
    }
}

#ifndef PROJ1_PERM
#define PROJ1_PERM 1
#endif
DI int proj1_tok(int R, int sh) { const int lpb = 14 - sh; return PROJ1_PERM ? (R & ~16383) + ((R & ((1 << lpb) - 1)) << sh) + ((R >> lpb) & ((1 << sh) - 1)) : R; }
DI int proj1_sh(int pn) { return pn < 4 ? 0 : 2 * ((pn - 4) >> 1); }
#ifndef DIL_FRAG
#define DIL_FRAG 1
#endif
DI int dil_koff(int key, int dim) { return ((((dim >> 4) * 2 + (key >> 5)) * 64 + ((dim >> 3) & 1) * 32 + (key & 31)) << 3) + (dim & 7); }
DI int dil_voff(int pos, int dim) { return ((((pos >> 4) * 2 + (dim >> 5)) * 64 + (dim & 31) * 2 + ((pos >> 3) & 1)) << 3) + (pos & 7); }
template <int LAYER> struct EpiProj {
    static constexpr bool PERM = true, AFTER_DRAIN = false;
    unsigned char* ws; const float* rope;
    DI void operator()(const f32x4 (&acc)[2][2][4][2], const Unit& u, int wr, int wc, int fr, int fq) const {
#ifdef EPI_OFF
        _Pragma("unroll") for (int ai = 0; ai < 2; ++ai) _Pragma("unroll") for (int bj = 0; bj < 2; ++bj) _Pragma("unroll") for (int m = 0; m < 4; ++m) { asm volatile("" :: "v"(acc[ai][bj][m][0]), "v"(acc[ai][bj][m][1])); }
        return;
#endif
        const int pn = u.pn;
        int kind, p = 0;
        if (pn < 4) kind = 0;
        else if (LAYER == 0) { if (pn == 10) kind = 5; else { p = (pn - 4) >> 1; const int isv = (pn - 4) & 1; kind = isv ? (p == 0 ? 3 : 4) : (p == 0 ? 2 : 1); } }
        else { p = (pn - 4) >> 1; kind = ((pn - 4) & 1) ? 4 : 1; }
        const int dil_sh = LAYER == 1 ? 2 * p : 0;
        const int Lp = S >> dil_sh;
        if (kind <= 3) {
            const bool do_rope = (kind <= 1) && ((wc & 1) == 0);
            const bool rope_lane = do_rope && fq < 2;
            const float qs = kind == 0 ? 0.125f : 1.f;
            bf16_t* base = kind == 0 ? (bf16_t*)(ws + WS_Q) : (bf16_t*)(ws + WS_KV + (size_t)(2 * p + (kind == 3 ? 1 : 0)) * KVB);
            f32x4 cN = {0.f, 0.f, 0.f, 0.f}, sN = {0.f, 0.f, 0.f, 0.f};
            if (ROPE_INLANE && rope_lane) { const int r0 = LAYER == 1 ? proj1_tok(EPI_ROWS(u, wr, fr, 0, 0), dil_sh) : EPI_ROWS(u, wr, fr, 0, 0);
                cN = *(const f32x4*)(rope + (size_t)r0 * 16 + 4 * fq); sN = *(const f32x4*)(rope + (size_t)r0 * 16 + 8 + 4 * fq); }
#pragma unroll
            for (int ai = 0; ai < 2; ++ai)
#pragma unroll
                for (int m = 0; m < 4; ++m) {
                    asm volatile("" ::: "memory");
                    const int row = LAYER == 1 ? proj1_tok(EPI_ROWS(u, wr, fr, ai, m), dil_sh) : EPI_ROWS(u, wr, fr, ai, m);
                    const int b = row >> 14, t = row & (S - 1);
                    const float* cs = rope + (size_t)row * 16;
                    const int res = t & ((1 << dil_sh) - 1), l = t >> dil_sh;
                    const f32x4 c4 = cN, s4 = sN;
                    if (ROPE_INLANE && rope_lane && !(ai == 1 && m == 3)) { const int an = m == 3 ? ai + 1 : ai, mn = m == 3 ? 0 : m + 1;
                        const int rn = LAYER == 1 ? proj1_tok(EPI_ROWS(u, wr, fr, an, mn), dil_sh) : EPI_ROWS(u, wr, fr, an, mn);
                        cN = *(const f32x4*)(rope + (size_t)rn * 16 + 4 * fq); sN = *(const f32x4*)(rope + (size_t)rn * 16 + 8 + 4 * fq); }
#pragma unroll
                    for (int bj = 0; bj < 2; ++bj) {
                        f32x4 v0 = acc[ai][bj][m][0], v1 = acc[ai][bj][m][1];
                        const int cl = bj * 128 + wc * 32 + fq * 8;
                        if (ROPE_INLANE) {
                            if (rope_lane) {
                                const f32x4 t1 = v0, t2 = v1; v0 = t1 * c4 - t2 * s4; v1 = t1 * s4 + t2 * c4; }
                        } else if (do_rope) rope8(v0, v1, cs, fq, rope_lane);
                        v0 = v0 * qs; v1 = v1 * qs;
                        u32x4 w; w.x = pk2(v0[0], v0[1]); w.y = pk2(v0[2], v0[3]); w.z = pk2(v1[0], v1[1]); w.w = pk2(v1[2], v1[3]);
                        if ((LAYER == 1 && DIL_FRAG && kind == 1) || (LAYER == 0 && WIN_FRAG && kind == 1 && p == 2)) {
                            const int rowi = res * Lp + l; bf16_t* tb = base + (size_t)(b * NG + (cl >> 6)) * S * 64 + (size_t)(rowi >> 6) * 4096; const int key = rowi & 63, d0 = cl & 63;
                            if (ROPE_INLANE && rope_lane) { u32x2 lo2 = {w.x, w.y}, hi2 = {w.z, w.w}; *(u32x2*)(tb + dil_koff(key, 4 * fq)) = lo2; *(u32x2*)(tb + dil_koff(key, 8 + 4 * fq)) = hi2; }
                            else *(u32x4*)(tb + dil_koff(key, d0)) = w;
                        } else {
                        bf16_t* dst = kind == 0 ? base + (size_t)row * D + pn * 256 + cl
                                                : base + ((size_t)(b * NG + (cl >> 6)) * S + res * Lp + l) * 64 + (cl & 63);
                        if (ROPE_INLANE && rope_lane) { u32x2 lo2 = {w.x, w.y}, hi2 = {w.z, w.w}; bf16_t* d0 = dst - 8 * fq; *(u32x2*)(d0 + 4 * fq) = lo2; *(u32x2*)(d0 + 8 + 4 * fq) = hi2; }
                        else *(u32x4*)dst = w;
                        }
                    }
                }
        } else if (kind == 4) {
            bf16_t* base = (bf16_t*)(ws + WS_KV + (size_t)(2 * p + 1) * KVB);
#pragma unroll
            for (int ai = 0; ai < 2; ++ai)
#pragma unroll
                for (int m = 0; m < 4; ++m) {
                    asm volatile("" ::: "memory");
                    const int row = LAYER == 1 ? proj1_tok(EPI_ROWS(u, wr, fr, ai, m), dil_sh) : EPI_ROWS(u, wr, fr, ai, m);
                    const int b = row >> 14, t = row & (S - 1);
                    const int res = t & ((1 << dil_sh) - 1), l = t >> dil_sh;
#pragma unroll
                    for (int bj = 0; bj < 2; ++bj) {
                        const f32x4 v0 = acc[ai][bj][m][0], v1 = acc[ai][bj][m][1];
                        const int cl = bj * 128 + wc * 32 + fq * 8, g = cl >> 6, dim = cl & 63;
                        const int rowi = res * Lp + l;
                        bf16_t* vp = base + (size_t)(b * NG + g) * S * 64 + (size_t)(rowi >> 6) * 4096 + dim * 64 + ((LAYER == 0 && p == 1 && SEL16) ? vperm32(rowi & 63) : vperm(rowi & 63));
                        if ((LAYER == 1 && DIL_FRAG) || (LAYER == 0 && WIN_FRAG && p == 2)) {
                            bf16_t* vq = base + (size_t)(b * NG + g) * S * 64 + (size_t)(rowi >> 6) * 4096 + dil_voff(vperm(rowi & 63), dim);
#pragma unroll
                            for (int j = 0; j < 4; ++j) { vq[j * 16] = (bf16_t)(pk2(v0[j], 0.f) & 0xffffu); vq[(4 + j) * 16] = (bf16_t)(pk2(v1[j], 0.f) & 0xffffu); }
                        } else {
#pragma unroll
                        for (int j = 0; j < 4; ++j) { vp[j * 64] = (bf16_t)(pk2(v0[j], 0.f) & 0xffffu); vp[(4 + j) * 64] = (bf16_t)(pk2(v1[j], 0.f) & 0xffffu); }
                        }
                    }
                }
        } else {
            const int cl = wc * 32 + fq * 8;
            if (cl < 48) {
#pragma unroll
                for (int ai = 0; ai < 2; ++ai)
#pragma unroll
                    for (int m = 0; m < 4; ++m) {
                        const int row = EPI_ROWS(u, wr, fr, ai, m);
                        float* gp = (float*)(ws + WS_G) + (size_t)row * 48 + cl;
                        f32x4 g0, g1;
#pragma unroll
                        for (int j = 0; j < 4; ++j) { g0[j] = sigmoidf_(acc[ai][0][m][0][j]); g1[j] = sigmoidf_(acc[ai][0][m][1][j]); }
                        *(f32x4*)gp = g0; *(f32x4*)(gp + 4) = g1;
                    }
            }
        }
    }
};

struct EpiCmp1 {
    static constexpr bool PERM = true, AFTER_DRAIN = false;
    bf16_t* hid; const float* bias;
    DI void operator()(const f32x4 (&acc)[2][2][4][2], const Unit& u, int wr, int wc, int fr, int fq) const {
        const int kv = u.pn;
#pragma unroll
        for (int bj = 0; bj < 2; ++bj) {
            const int cl = bj * 128 + wc * 32 + fq * 8;
            const f32x4 b0 = *(const f32x4*)(bias + kv * 256 + cl), b1 = *(const f32x4*)(bias + kv * 256 + cl + 4);
#pragma unroll
            for (int ai = 0; ai < 2; ++ai)
#pragma unroll
                for (int m = 0; m < 4; ++m) {
                    const int row = EPI_ROWS(u, wr, fr, ai, m);
                    f32x4 v0 = acc[ai][bj][m][0] + b0, v1 = acc[ai][bj][m][1] + b1;
#pragma unroll
                    for (int j = 0; j < 4; ++j) {
                        float x = v0[j]; v0[j] = 0.5f * x * (1.f + tanhf(0.7978845608028654f * (x + 0.044715f * x * x * x)));
                        x = v1[j];       v1[j] = 0.5f * x * (1.f + tanhf(0.7978845608028654f * (x + 0.044715f * x * x * x)));
                    }
                    u32x4 w; w.x = pk2(v0[0], v0[1]); w.y = pk2(v0[2], v0[3]); w.z = pk2(v1[0], v1[1]); w.w = pk2(v1[2], v1[3]);
                    *(u32x4*)(hid + (size_t)row * 256 + cl) = w;
                }
        }
    }
};

struct EpiWo {
    static constexpr bool PERM = true, AFTER_DRAIN = false;
    bf16_t* Y;
    DI void operator()(const f32x4 (&acc)[2][2][4][2], const Unit& u, int wr, int wc, int fr, int fq) const {
#pragma unroll
        for (int ai = 0; ai < 2; ++ai)
#pragma unroll
            for (int m = 0; m < 4; ++m) {
                bf16_t* yr = Y + (size_t)EPI_ROWS(u, wr, fr, ai, m) * D + u.pn * 256 + wc * 32 + fq * 8;
#pragma unroll
                for (int bj = 0; bj < 2; ++bj) {
                    const f32x4 v0 = acc[ai][bj][m][0], v1 = acc[ai][bj][m][1];
                    u32x4 o; o.x = pk2(v0[0], v0[1]); o.y = pk2(v0[2], v0[3]); o.z = pk2(v1[0], v1[1]); o.w = pk2(v1[2], v1[3]);
                    *(u32x4*)(yr + bj * 128) = o;
                }
            }
    }
};

struct EpiGU {
    static constexpr bool PERM = true, AFTER_DRAIN = false;
    bf16_t* hh;
    DI void operator()(const f32x4 (&acc)[2][2][4][2], const Unit& u, int wr, int wc, int fr, int fq) const {
        const int col = (u.pn & 3) * 128 + wc * 32 + fq * 8;
#pragma unroll
        for (int ai = 0; ai < 2; ++ai)
#pragma unroll
            for (int m = 0; m < 4; ++m) {
                const int row = EPI_ROWS(u, wr, fr, ai, m);
                f32x4 h0, h1;
#pragma unroll
                for (int j = 0; j < 4; ++j) {
                    const float g0 = acc[ai][0][m][0][j], g1 = acc[ai][0][m][1][j];
                    h0[j] = g0 * __builtin_amdgcn_rcpf(1.f + __expf(-g0)) * acc[ai][1][m][0][j];
                    h1[j] = g1 * __builtin_amdgcn_rcpf(1.f + __expf(-g1)) * acc[ai][1][m][1][j];
                }
                u32x4 w; w.x = pk2(h0[0], h0[1]); w.y = pk2(h0[2], h0[3]); w.z = pk2(h1[0], h1[1]); w.w = pk2(h1[2], h1[3]);
                *(u32x4*)(hh + (size_t)row * FE + col) = w;
            }
    }
};

struct EpiDown {
    static constexpr bool PERM = true, AFTER_DRAIN = false;
    bf16_t* Y; const int* row_tok; const float* row_w; const LAS int* ltab;
    DI void operator()(const f32x4 (&acc)[2][2][4][2], const Unit& u, int wr, int wc, int fr, int fq) const {
#pragma unroll
        for (int ai = 0; ai < 2; ++ai)
#pragma unroll
            for (int m = 0; m < 4; ++m) {
                const int row = EPI_ROWS(u, wr, fr, ai, m);
                const int li = (u.ord * 256 + (row & 255)) * 2;
                const int tk = u.ord < 6 ? ltab[li] : row_tok[row];
                if (tk < 0) continue;
                const float w = u.ord < 6 ? __builtin_bit_cast(float, ltab[li + 1]) : row_w[row];
                bf16_t* yr = Y + ((size_t)(tk & 1) * NTOK + (tk >> 1)) * D + (u.pn & 3) * 256 + wc * 32 + fq * 8;
#pragma unroll
                for (int bj = 0; bj < 2; ++bj) {
                    const f32x4 v0 = acc[ai][bj][m][0] * w, v1 = acc[ai][bj][m][1] * w;
                    u32x4 o; o.x = pk2(v0[0], v0[1]); o.y = pk2(v0[2], v0[3]); o.z = pk2(v1[0], v1[1]); o.w = pk2(v1[2], v1[3]);
                    *(u32x4*)(yr + bj * 128) = o;
                }
            }
    }
};

struct CmpOrder {
    int G, c;
    DI bool next(int i, Unit& u) const { const int L = i * G + c; if (L >= 64) return false; u.pm = L; u.pn = L >> 5; return true; }
    DI void a_ready(const Unit&) const {}
    DI void done(const Unit&) const {}
};
struct GateOrder {
    int G, c;
    DI bool next(int i, Unit& u) const { if (G <= 64 || c < 64) return false; const int L = i * (G - 64) + (c - 64); if (L >= NTOK / 256) return false; u.pm = L; u.pn = 10; return true; }
    DI void a_ready(const Unit&) const {}
    DI void done(const Unit&) const {}
    DI bool half_only(const Unit&) const { return false; }
};
struct MoeOrder {
    const LAS int* tstart; int G, c;
    DI bool next(int i, Unit& u) const {
        const int L = i * G + c; const int nt = tstart[32];
        if (L >= nt * 4) return false;
        const int tile = L >> 2; const int e = ((const LAS unsigned char*)tstart)[2048 + tile];
        u.pm = tile; u.pn = e * 4 + (L & 3); u.ord = i; return true;
    }
    DI void a_ready(const Unit&) const {}
    DI void done(const Unit&) const {}
};

constexpr int AT_KV_BYTES = 16384;
constexpr int AT_NSLOT = 4;
constexpr int AT_IMP_OFF = AT_NSLOT * AT_KV_BYTES;
constexpr int AT_IMP_STRIDE = 260;
constexpr int AT_CNT_OFF = 146496;
constexpr int AT_SEL_OFF = AT_IMP_OFF + 64 * AT_IMP_STRIDE * 4;
static_assert(AT_SEL_OFF + 64 * 8 * 4 <= 143360, "attention LDS map");

struct AttnSt { f32x16 o[2]; float m, l; };


#define AT_ISSUE_V true
#define AT_ISSUE(tile, slot) do { \
        __builtin_amdgcn_global_load_lds((const unsigned*)(ksrc + (size_t)(tile) * 64 * 64), (LAS unsigned*)(wbase + (slot) * AT_KV_BYTES), 16, 0, 0); \
        if (AT_ISSUE_V) __builtin_amdgcn_global_load_lds((const unsigned*)(vsrc + (size_t)(tile) * 64 * 64), (LAS unsigned*)(wbase + (slot) * AT_KV_BYTES + 8192), 16, 0, 0); } while (0)

#undef AT_ISSUE_V
#define AT_ISSUE_V (MODE != 1)
template <int MODE, bool SEL, int NS = 4>
DI void attn_loop(LAS unsigned char* lds, const bf16_t* Kb, const bf16_t* VTb, int tile_lo, int tile_hi,
                  const bf16x8 (&qf)[4], int lo_c, int hi_c, AttnSt& st, float inv_l, int tok_local, int t_col, LAS float* imp_row) {
    const int tid = opaque_tid(), lane = tid & 63, r = lane & 31, h = lane >> 5, sw = (r >> 1) & 7;
    const int wave_u = __builtin_amdgcn_readfirstlane(tid >> 6);
    if (tile_lo > tile_hi) return;
    const float l2inv = (MODE == 2) ? __builtin_amdgcn_logf(inv_l) : 0.f;
    const int srow = tid >> 3, lc = (tid & 7) ^ ((srow >> 1) & 7);
    const bf16_t* ksrc = Kb + (size_t)srow * 64 + lc * 8;
    const bf16_t* vsrc = VTb + (size_t)srow * 64 + lc * 8;
    LAS unsigned char* wbase = lds + wave_u * 1024;
    constexpr bool DEC = false;
    LAS unsigned* cnt = (LAS unsigned*)(lds + AT_CNT_OFF);
    const unsigned cnt_addr = (unsigned)(size_t)cnt;
    asm volatile("s_waitcnt lgkmcnt(0)" ::: "memory");
    __builtin_amdgcn_s_barrier();
    if (DEC) { if (tid < 8) cnt[tid] = 0u; asm volatile("s_waitcnt lgkmcnt(0)" ::: "memory"); __builtin_amdgcn_s_barrier(); }
    constexpr int GRP = NS / 2;
#pragma unroll
    for (int i = 0; i < GRP; ++i) if (tile_lo + i <= tile_hi) AT_ISSUE(tile_lo + i, i);
    if (DEC && tile_lo + 2 <= tile_hi) AT_ISSUE(tile_lo + 2, 2);
#define AT_SIGNAL(idx) do { if (lane == 0) asm volatile("ds_add_u32 %0, %1" :: "v"(cnt_addr + 4u * (unsigned)(idx)), "v"(1u) : "memory"); } while (0)
#define AT_WAIT(idx, target) do { unsigned sp_ = 0; while ((unsigned)__builtin_amdgcn_readfirstlane((int)*(volatile LAS unsigned*)(cnt + (idx))) < (unsigned)(target)) { __builtin_amdgcn_s_sleep(1); if (++sp_ > (1u << 20)) break; } } while (0)
    f32x16 sb0, sb1; bool pre_b = false;
#pragma unroll
    for (int i = 0; i < 16; ++i) { sb0[i] = 0.f; sb1[i] = 0.f; }
#pragma unroll 1
    for (int t = tile_lo; t <= tile_hi; ++t) {
      {
        if (MODE != 1) { const float dep_ = st.o[0][15] + st.o[1][15]; asm volatile("" :: "v"(dep_)); }
        const int rel = t - tile_lo, rem = tile_hi - t;
        if (!DEC) {
            if ((rel & (GRP - 1)) == 0) {
                asm volatile("s_waitcnt vmcnt(0)" ::: "memory");
                __builtin_amdgcn_s_barrier();
#pragma unroll
                for (int i = 0; i < GRP; ++i) if (rem >= GRP + i) AT_ISSUE(t + GRP + i, (rel + GRP + i) & (NS - 1));
                if (AT_STAG && (AT_STAG_MODE ? (wave_u & 1) : (wave_u >= 4))) __builtin_amdgcn_s_sleep(AT_STAG);
            }
        } else {
            if (rem >= 2) asm volatile("s_waitcnt vmcnt(4)" ::: "memory");
            else if (rem == 1) asm volatile("s_waitcnt vmcnt(2)" ::: "memory");
            else asm volatile("s_waitcnt vmcnt(0)" ::: "memory");
            AT_SIGNAL(rel & 3);
            if (rem >= 3) { AT_WAIT(4 + ((rel + 3) & 3), 8 * ((rel + 3) >> 2)); AT_ISSUE(t + 3, (rel + 3) & 3); }
            AT_WAIT(rel & 3, 8 * ((rel >> 2) + 1));
        }
        LAS unsigned char* kb = lds + ((t - tile_lo) & (NS - 1)) * AT_KV_BYTES;
        LAS unsigned char* vb = kb + 8192;
        const int key0 = t * 64;
        int lo = lo_c, hi = hi_c;
        if (SEL) { const unsigned wsel = ((LAS unsigned*)(lds + AT_SEL_OFF))[tok_local * 8 + (t >> 5)]; hi = ((wsel >> (t & 31)) & 1u) ? t_col : -1; }
        const bool act = (key0 + 63 >= lo) && (key0 <= hi);
        if (!AT_NO_COMPUTE && __any(act)) {
            bf16x8 va[4][2];
#define AT_LOAD_V() do { if (MODE != 1) { _Pragma("unroll") for (int sg = 0; sg < 4; ++sg) { \
                    if (AT_VAR == 3) { va[sg][0] = qf[sg]; va[sg][1] = qf[(sg + 1) & 3]; continue; } \
                    va[sg][0] = *(const LAS bf16x8*)(vb + r * 128 + (((2 * sg + h) ^ sw) << 4)); \
                    va[sg][1] = *(const LAS bf16x8*)(vb + 4096 + r * 128 + (((2 * sg + h) ^ sw) << 4)); } } } while (0)
            if (!V_AFTER_QK) AT_LOAD_V();
            f32x16 s0, s1;
            const bool odd = ((t - tile_lo) & 1) != 0;
            if (PREQK && !DEC && !SEL && odd && pre_b) { s0 = sb0; s1 = sb1; }
            else {
#pragma unroll
                for (int i = 0; i < 16; ++i) { s0[i] = 0.f; s1[i] = 0.f; }
                bf16x8 ka[4][2];
#pragma unroll
                for (int kk = 0; kk < 4; ++kk) {
                    if (AT_VAR == 3) { ka[kk][0] = qf[kk]; ka[kk][1] = qf[(kk + 1) & 3]; continue; }
                    ka[kk][0] = *(const LAS bf16x8*)(kb + r * 128 + (((2 * kk + h) ^ sw) << 4));
                    ka[kk][1] = *(const LAS bf16x8*)(kb + 4096 + r * 128 + (((2 * kk + h) ^ sw) << 4));
                }
                bool do_b = false;
                if (PREQK && !DEC && !SEL && !odd && t + 1 <= tile_hi) { const bool act_b = (key0 + 64 + 63 >= lo) && (key0 + 64 <= hi); do_b = __any(act_b); }
                __builtin_amdgcn_sched_barrier(0);
                if (T5_PRIO) __builtin_amdgcn_s_setprio(1);
#pragma unroll
                for (int kk = 0; kk < 4; ++kk) {
                    if (AT_VAR == 2) { asm volatile("" :: "v"(__builtin_bit_cast(u32x4, ka[kk][0])), "v"(__builtin_bit_cast(u32x4, ka[kk][1]))); s0[kk] = (float)lane * 1e-3f; s1[kk] = (float)kk; continue; }
                    s0 = MFMA32(ka[kk][0], qf[kk], s0);
                    s1 = MFMA32(ka[kk][1], qf[kk], s1);
                }
                if (T5_PRIO) __builtin_amdgcn_s_setprio(0);
                if (V_AFTER_QK && MODE != 1) {
                    const float dq_ = s0[15] + s1[15]; int z_; asm volatile("v_mov_b32 %0, 0" : "=v"(z_) : "v"(dq_));
                    vb += z_;
                    AT_LOAD_V();
                }
                if (do_b) {
                    LAS unsigned char* kb2 = lds + ((t + 1 - tile_lo) & 3) * AT_KV_BYTES;
#ifdef PREQK_NOP
                    asm volatile("s_nop 15\n\ts_nop 15\n\ts_nop 15\n\ts_nop 15\n\ts_nop 15\n\ts_nop 15\n\ts_nop 15\n\ts_nop 15" ::: "memory");
#endif
#pragma unroll
                    for (int kk = 0; kk < 4; ++kk) {
                        ka[kk][0] = *(const LAS bf16x8*)(kb2 + r * 128 + (((2 * kk + h) ^ sw) << 4));
                        ka[kk][1] = *(const LAS bf16x8*)(kb2 + 4096 + r * 128 + (((2 * kk + h) ^ sw) << 4));
                    }
#pragma unroll
                    for (int i = 0; i < 16; ++i) { sb0[i] = 0.f; sb1[i] = 0.f; }
#pragma unroll
                    for (int kk = 0; kk < 4; ++kk) {
                        sb0 = MFMA32(ka[kk][0], qf[kk], sb0);
                        sb1 = MFMA32(ka[kk][1], qf[kk], sb1);
                    }
                }
                if (!odd) pre_b = do_b;
            }
            const bool dead = (hi < key0) || (lo > key0 + 63), fullv = (lo <= key0) && (hi >= key0 + 63);
            float rs = 0.f;
            bf16x8 pf[4];
            if (!__all(dead || fullv)) {
                const int dhi = hi - key0 - 4 * h, dlo = lo - key0 - 4 * h;
                const bool need_lo = __any(!dead && lo > key0), need_hi = __any(!dead && hi < key0 + 63);
                if (need_lo && need_hi) {
#pragma unroll
                    for (int i = 0; i < 16; ++i) { const int off = (i & 3) + 8 * (i >> 2);
                        s0[i] = (off <= dhi && off >= dlo) ? s0[i] : -INFINITY; s1[i] = (off + 32 <= dhi && off + 32 >= dlo) ? s1[i] : -INFINITY; }
                } else if (need_hi) {
#pragma unroll
                    for (int i = 0; i < 16; ++i) { const int off = (i & 3) + 8 * (i >> 2);
                        s0[i] = (off <= dhi) ? s0[i] : -INFINITY; s1[i] = (off + 32 <= dhi) ? s1[i] : -INFINITY; }
                } else {
#pragma unroll
                    for (int i = 0; i < 16; ++i) { const int off = (i & 3) + 8 * (i >> 2);
                        s0[i] = (off >= dlo) ? s0[i] : -INFINITY; s1[i] = (off + 32 >= dlo) ? s1[i] : -INFINITY; }
                }
            }
            if (AT_VAR == 1) { rs = 1.f + 1e-30f * (s0[0] + s1[0]);
#pragma unroll
                for (int sg = 0; sg < 4; ++sg) pf[sg] = qf[sg]; } else
            {
                float mxr = fmx(s0[0], s1[0]);
#pragma unroll
                for (int i = 1; i < 16; ++i) mxr = fmx(mxr, fmx(s0[i], s1[i]));
                float nb;
                if (MODE == 2) nb = dead ? -INFINITY : (l2inv - st.m);
                else {
                    float mx = dead ? -INFINITY : mxr * LOG2E;
                    if (__any(mx > st.m + (float)DEFER_THR)) {
                        mx = xh32_max(mx);
                        const float mnew = fmx(st.m, mx);
                        const float alpha = __builtin_amdgcn_exp2f(st.m - mnew);
                        st.l *= alpha;
                        if (MODE == 0) { if (!__all(mnew == st.m)) {
#pragma unroll
                            for (int i = 0; i < 16; ++i) { st.o[0][i] *= alpha; st.o[1][i] *= alpha; } } }
                        st.m = mnew;
                    }
                    nb = dead ? -INFINITY : -st.m;
                }
                const f32x2 nb2 = {nb, nb}, l2e2 = {LOG2E, LOG2E};
                f32x2 rs2 = {0.f, 0.f};
                u32x4 pw[4];
#pragma unroll
                for (int i = 0; i < 8; ++i) {
                    f32x2 a0 = {s0[2 * i], s0[2 * i + 1]}, a1 = {s1[2 * i], s1[2 * i + 1]};
                    a0 = a0 * l2e2 + nb2; a1 = a1 * l2e2 + nb2;
                    a0.x = __builtin_amdgcn_exp2f(a0.x); a0.y = __builtin_amdgcn_exp2f(a0.y); a1.x = __builtin_amdgcn_exp2f(a1.x); a1.y = __builtin_amdgcn_exp2f(a1.y);
                    rs2 += a0 + a1;
                    if (MODE == 2) { s0[2 * i] = a0.x; s0[2 * i + 1] = a0.y; s1[2 * i] = a1.x; s1[2 * i + 1] = a1.y; }
                    pw[i >> 2][i & 3] = pk2(a0.x, a0.y); pw[2 + (i >> 2)][i & 3] = pk2(a1.x, a1.y);
                }
                rs = rs2.x + rs2.y;
#pragma unroll
                for (int sg = 0; sg < 4; ++sg) pf[sg] = __builtin_bit_cast(bf16x8, pw[sg]);
            }
            if (MODE != 2) st.l += rs;
            if (MODE == 2) {
#pragma unroll
                for (int kt = 0; kt < 2; ++kt)
#pragma unroll
                    for (int jj = 0; jj < 4; ++jj) {
                        float gs = kt ? (s1[4 * jj] + s1[4 * jj + 1]) + (s1[4 * jj + 2] + s1[4 * jj + 3]) : (s0[4 * jj] + s0[4 * jj + 1]) + (s0[4 * jj + 2] + s0[4 * jj + 3]);
                        float ls = kt ? s1[4 * jj + 3] : s0[4 * jj + 3];
                        gs += DPPF(gs, 0xB1, 0xf); gs += DPPF(gs, 0x4E, 0xf);
                        ls += DPPF(ls, 0xB1, 0xf); ls += DPPF(ls, 0x4E, 0xf);
                        if ((lane & 3) == 0) {
                            const int gidx = t * 16 + 8 * kt + 2 * jj + h;
                            const unsigned ia = (unsigned)(size_t)(imp_row + gidx);
                            asm volatile("ds_add_f32 %0, %1\n\tds_add_f32 %0, %2 offset:4" :: "v"(ia), "v"(gs), "v"(ls) : "memory");
                        }
                    }
            }
            if (MODE != 1) {
                if (T5_PRIO) __builtin_amdgcn_s_setprio(1);
#pragma unroll
                for (int sg = 0; sg < 4; ++sg) {
                    if (AT_VAR == 2) { asm volatile("" :: "v"(__builtin_bit_cast(u32x4, va[sg][0])), "v"(__builtin_bit_cast(u32x4, va[sg][1])), "v"(__builtin_bit_cast(u32x4, pf[sg]))); continue; }
                    st.o[0] = MFMA32(va[sg][0], pf[sg], st.o[0]);
                    st.o[1] = MFMA32(va[sg][1], pf[sg], st.o[1]);
                }
                if (T5_PRIO) __builtin_amdgcn_s_setprio(0);
            }
        } else if (((t - tile_lo) & 1) == 0) pre_b = false;
        if (DEC) { asm volatile("s_waitcnt lgkmcnt(0)" ::: "memory"); AT_SIGNAL(4 + ((t - tile_lo) & 3)); }
      }
    }
    if (MODE != 1) { const float dep_ = st.o[0][15] + st.o[1][15]; asm volatile("" :: "v"(dep_)); }
#undef AT_SIGNAL
#undef AT_WAIT
}

template <int MODE>
DI void pp_softmax(f32x16& s0, f32x16& s1, bf16x8 (&pf)[4], AttnSt& st, int t, int lo, int hi, float l2inv, int lane, int h, LAS float* imp_row) {
    const int key0 = t * 64;
    const bool dead = (hi < key0) || (lo > key0 + 63), fullv = (lo <= key0) && (hi >= key0 + 63);
    float rs = 0.f;
    if (!__all(dead || fullv)) {
        const int dhi = hi - key0 - 4 * h, dlo = lo - key0 - 4 * h;
        const bool need_lo = __any(!dead && lo > key0), need_hi = __any(!dead && hi < key0 + 63);
        if (need_lo && need_hi) {
#pragma unroll
            for (int i = 0; i < 16; ++i) { const int off = (i & 3) + 8 * (i >> 2);
                s0[i] = (off <= dhi && off >= dlo) ? s0[i] : -INFINITY; s1[i] = (off + 32 <= dhi && off + 32 >= dlo) ? s1[i] : -INFINITY; }
        } else if (need_hi) {
#pragma unroll
            for (int i = 0; i < 16; ++i) { const int off = (i & 3) + 8 * (i >> 2);
                s0[i] = (off <= dhi) ? s0[i] : -INFINITY; s1[i] = (off + 32 <= dhi) ? s1[i] : -INFINITY; }
        } else {
#pragma unroll
            for (int i = 0; i < 16; ++i) { const int off = (i & 3) + 8 * (i >> 2);
                s0[i] = (off >= dlo) ? s0[i] : -INFINITY; s1[i] = (off + 32 >= dlo) ? s1[i] : -INFINITY; }
        }
    }
    float mxr = fmx(s0[0], s1[0]);
#pragma unroll
    for (int i = 1; i < 16; ++i) mxr = fmx(mxr, fmx(s0[i], s1[i]));
    float nb;
    if (MODE == 2) nb = dead ? -INFINITY : (l2inv - st.m);
    else {
        float mx = dead ? -INFINITY : mxr * LOG2E;
        if (__any(mx > st.m + (float)DEFER_THR)) {
            mx = xh32_max(mx);
            const float mnew = fmx(st.m, mx);
            const float alpha = __builtin_amdgcn_exp2f(st.m - mnew);
            st.l *= alpha;
            if (MODE == 0) { if (!__all(mnew == st.m)) {
#pragma unroll
                for (int i = 0; i < 16; ++i) { st.o[0][i] *= alpha; st.o[1][i] *= alpha; } } }
            st.m = mnew;
        }
        nb = dead ? -INFINITY : -st.m;
    }
    const f32x2 nb2 = {nb, nb}, l2e2 = {LOG2E, LOG2E};
    f32x2 rs2 = {0.f, 0.f};
    u32x4 pw[4];
#pragma unroll
    for (int i = 0; i < 8; ++i) {
        f32x2 a0 = {s0[2 * i], s0[2 * i + 1]}, a1 = {s1[2 * i], s1[2 * i + 1]};
        a0 = a0 * l2e2 + nb2; a1 = a1 * l2e2 + nb2;
        a0.x = __builtin_amdgcn_exp2f(a0.x); a0.y = __builtin_amdgcn_exp2f(a0.y); a1.x = __builtin_amdgcn_exp2f(a1.x); a1.y = __builtin_amdgcn_exp2f(a1.y);
        rs2 += a0 + a1;
        if (MODE == 2) { s0[2 * i] = a0.x; s0[2 * i + 1] = a0.y; s1[2 * i] = a1.x; s1[2 * i + 1] = a1.y; }
        pw[i >> 2][i & 3] = pk2(a0.x, a0.y); pw[2 + (i >> 2)][i & 3] = pk2(a1.x, a1.y);
    }
    rs = rs2.x + rs2.y;
    if (MODE != 1) {
#pragma unroll
        for (int sg = 0; sg < 4; ++sg) pf[sg] = __builtin_bit_cast(bf16x8, pw[sg]);
    }
    if (MODE != 2) st.l += rs;
    if (MODE == 2) {
#pragma unroll
        for (int kt = 0; kt < 2; ++kt)
#pragma unroll
            for (int jj = 0; jj < 4; ++jj) {
                float gs = kt ? (s1[4 * jj] + s1[4 * jj + 1]) + (s1[4 * jj + 2] + s1[4 * jj + 3]) : (s0[4 * jj] + s0[4 * jj + 1]) + (s0[4 * jj + 2] + s0[4 * jj + 3]);
                float ls = kt ? s1[4 * jj + 3] : s0[4 * jj + 3];
                gs += DPPF(gs, 0xB1, 0xf); gs += DPPF(gs, 0x4E, 0xf);
                ls += DPPF(ls, 0xB1, 0xf); ls += DPPF(ls, 0x4E, 0xf);
                if ((lane & 3) == 0) {
                    const int gidx = t * 16 + 8 * kt + 2 * jj + h;
                    const unsigned ia = (unsigned)(size_t)(imp_row + gidx);
                    asm volatile("ds_add_f32 %0, %1\n\tds_add_f32 %0, %2 offset:4" :: "v"(ia), "v"(gs), "v"(ls) : "memory");
                }
            }
    }
}

DI void attn_private(LAS unsigned char* lds, const bf16_t* Kb, const bf16_t* VTb, int tile_lo, int tile_hi, const bf16x8 (&qf)[4], int lo_c, int hi_c, AttnSt& st) {
    const int tid = opaque_tid(), lane = tid & 63, r = lane & 31, h = lane >> 5, sw = (r >> 1) & 7;
    const int wave_u = __builtin_amdgcn_readfirstlane(tid >> 6);
    if (tile_lo > tile_hi) return;
    LAS unsigned char* slot = lds + wave_u * AT_KV_BYTES;
    const int prow = lane >> 3, pch = lane & 7;
#define PRIV_ISSUE(base, tile, off) do { _Pragma("unroll") for (int p_ = 0; p_ < 8; ++p_) { const int srow_ = 8 * p_ + prow; const int lc_ = pch ^ ((srow_ >> 1) & 7); \
        __builtin_amdgcn_global_load_lds((const unsigned*)((base) + (size_t)(tile) * 4096 + srow_ * 64 + lc_ * 8), (LAS unsigned*)(slot + (off) + p_ * 1024), 16, 0, 0); } } while (0)
    PRIV_ISSUE(Kb, tile_lo, 0); PRIV_ISSUE(VTb, tile_lo, 8192);
#pragma unroll 1
    for (int t = tile_lo; t <= tile_hi; ++t) {
        { const float dep_ = st.o[0][15] + st.o[1][15]; asm volatile("" :: "v"(dep_)); }
        const bool more = t < tile_hi;
        asm volatile("s_waitcnt vmcnt(8)" ::: "memory");
        LAS unsigned char* kb = slot;
        bf16x8 ka[4][2];
#pragma unroll
        for (int kk = 0; kk < 4; ++kk) {
            ka[kk][0] = *(const LAS bf16x8*)(kb + r * 128 + (((2 * kk + h) ^ sw) << 4));
            ka[kk][1] = *(const LAS bf16x8*)(kb + 4096 + r * 128 + (((2 * kk + h) ^ sw) << 4));
        }
        asm volatile("s_waitcnt lgkmcnt(0)" ::: "memory");
        if (more) PRIV_ISSUE(Kb, t + 1, 0);
        f32x16 s0, s1;
#pragma unroll
        for (int i = 0; i < 16; ++i) { s0[i] = 0.f; s1[i] = 0.f; }
#pragma unroll
        for (int kk = 0; kk < 4; ++kk) { s0 = MFMA32(ka[kk][0], qf[kk], s0); s1 = MFMA32(ka[kk][1], qf[kk], s1); }
        const float dq_ = s0[15] + s1[15]; int z_; asm volatile("v_mov_b32 %0, 0" : "=v"(z_) : "v"(dq_));
        if (more) asm volatile("s_waitcnt vmcnt(8)" ::: "memory"); else asm volatile("s_waitcnt vmcnt(0)" ::: "memory");
        LAS unsigned char* vb = slot + 8192 + z_;
        bf16x8 va[4][2];
#pragma unroll
        for (int sg = 0; sg < 4; ++sg) {
            va[sg][0] = *(const LAS bf16x8*)(vb + r * 128 + (((2 * sg + h) ^ sw) << 4));
            va[sg][1] = *(const LAS bf16x8*)(vb + 4096 + r * 128 + (((2 * sg + h) ^ sw) << 4));
        }
        asm volatile("s_waitcnt lgkmcnt(0)" ::: "memory");
        if (more) PRIV_ISSUE(VTb, t + 1, 8192);
        bf16x8 pf[4];
        pp_softmax<0>(s0, s1, pf, st, t, lo_c, hi_c, 0.f, lane, h, nullptr);
#pragma unroll
        for (int sg = 0; sg < 4; ++sg) { st.o[0] = MFMA32(va[sg][0], pf[sg], st.o[0]); st.o[1] = MFMA32(va[sg][1], pf[sg], st.o[1]); }
    }
    { const float dep_ = st.o[0][15] + st.o[1][15]; asm volatile("" :: "v"(dep_)); }
#undef PRIV_ISSUE
}

template <int MODE = 0>
DI void attn_direct(const bf16_t* Kb, const bf16_t* VTb, int tile_lo, int tile_hi, const bf16x8 (&qf)[4], int lo_c, int hi_c, AttnSt& st, float inv_l = 0.f, LAS float* imp_row = nullptr) {
    const int tid = opaque_tid(), lane = tid & 63, h = lane >> 5;
    if (tile_lo > tile_hi) return;
    const float l2inv = (MODE == 2) ? __builtin_amdgcn_logf(inv_l) : 0.f;
    bf16x8 ka[4][2];
    { const float dep_ = st.o[0][15] + st.o[1][15]; int z_; asm volatile("v_mov_b32 %0, 0" : "=v"(z_) : "v"(dep_));
      const bf16x8* kp = (const bf16x8*)(Kb + (size_t)tile_lo * 4096) + lane + z_;
#pragma unroll
      for (int kk = 0; kk < 4; ++kk) { ka[kk][0] = kp[(kk * 2) * 64]; ka[kk][1] = kp[(kk * 2 + 1) * 64]; } }
#pragma unroll 1
    for (int t = tile_lo; t <= tile_hi; ++t) {
        f32x16 s0, s1;
#pragma unroll
        for (int i = 0; i < 16; ++i) { s0[i] = 0.f; s1[i] = 0.f; }
#pragma unroll
        for (int kk = 0; kk < 4; ++kk) { s0 = MFMA32(ka[kk][0], qf[kk], s0); s1 = MFMA32(ka[kk][1], qf[kk], s1); }
        const float dq_ = s0[15] + s1[15]; int z_; asm volatile("v_mov_b32 %0, 0" : "=v"(z_) : "v"(dq_));
        bf16x8 va[4][2];
        if (MODE != 1) { const bf16x8* vp = (const bf16x8*)(VTb + (size_t)t * 4096) + ((lane & 31) * 2 + h) + z_;
#pragma unroll
          for (int sg = 0; sg < 4; ++sg) { va[sg][0] = vp[(sg * 2) * 64]; va[sg][1] = vp[(sg * 2 + 1) * 64]; } }
        if (t < tile_hi) { const bf16x8* kp = (const bf16x8*)(Kb + (size_t)(t + 1) * 4096) + lane + z_;
#pragma unroll
          for (int kk = 0; kk < 4; ++kk) { ka[kk][0] = kp[(kk * 2) * 64]; ka[kk][1] = kp[(kk * 2 + 1) * 64]; } }
        bf16x8 pf[4];
        pp_softmax<MODE>(s0, s1, pf, st, t, lo_c, hi_c, l2inv, lane, h, imp_row);
        if (MODE != 1) {
#pragma unroll
            for (int sg = 0; sg < 4; ++sg) { st.o[0] = MFMA32(va[sg][0], pf[sg], st.o[0]); st.o[1] = MFMA32(va[sg][1], pf[sg], st.o[1]); }
            { const float dep_ = st.o[0][15] + st.o[1][15]; asm volatile("" :: "v"(dep_)); }
        }
    }
}

#undef AT_ISSUE_V
#define AT_ISSUE_V true
DI void st_reset(AttnSt& st) {
#pragma unroll
    for (int i = 0; i < 16; ++i) { st.o[0][i] = 0.f; st.o[1][i] = 0.f; }
    st.m = -1e30f; st.l = 0.f;
}
DI void load_q(const bf16_t* Q, int tokrow, int head, int h, bf16x8 (&qf)[4]) {
#pragma unroll
    for (int kk = 0; kk < 4; ++kk) qf[kk] = *(const bf16x8*)(Q + (size_t)tokrow * D + head * 64 + 16 * kk + 8 * h);
    if (!(CMP_FRAG && WIN_FRAG && DIL_FRAG)) {
#pragma unroll
    for (int kk = 0; kk < 4; ++kk) asm volatile("" : "+v"(qf[kk]));
    }
}
DI void acc_out(f32x16 (&out)[2], const AttnSt& st, float scale) {
#pragma unroll
    for (int i = 0; i < 16; ++i) { out[0][i] += scale * st.o[0][i]; out[1][i] += scale * st.o[1][i]; }
}
DI void store_out(bf16_t* AO, int tokrow, int head, int h, const f32x16 (&out)[2]) {
    bf16_t* base = AO + (size_t)tokrow * D + head * 64 + 4 * h;
#pragma unroll
    for (int dt = 0; dt < 2; ++dt)
#pragma unroll
        for (int jj = 0; jj < 4; ++jj) {
            u32x2 w; w.x = pk2(out[dt][4 * jj], out[dt][4 * jj + 1]); w.y = pk2(out[dt][4 * jj + 2], out[dt][4 * jj + 3]);
            *(u32x2*)(base + 32 * dt + 8 * jj) = w;
        }
}


DI void lds_out_set(LAS unsigned char* ob, int c, int h, const AttnSt& st, float scale) {
#pragma unroll
    for (int dt = 0; dt < 2; ++dt)
#pragma unroll
        for (int jj = 0; jj < 4; ++jj) {
            f32x4 v = {st.o[dt][4 * jj] * scale, st.o[dt][4 * jj + 1] * scale, st.o[dt][4 * jj + 2] * scale, st.o[dt][4 * jj + 3] * scale};
            *(LAS f32x4*)(ob + (((dt * 4 + jj) * 2 + h) * 32 + c) * 16) = v;
        }
}
DI void lds_out_add(LAS unsigned char* ob, int c, int h, const AttnSt& st, float scale) {
#pragma unroll
    for (int dt = 0; dt < 2; ++dt)
#pragma unroll
        for (int jj = 0; jj < 4; ++jj) {
            LAS f32x4* p = (LAS f32x4*)(ob + (((dt * 4 + jj) * 2 + h) * 32 + c) * 16);
            f32x4 v = *p;
            v[0] += st.o[dt][4 * jj] * scale; v[1] += st.o[dt][4 * jj + 1] * scale; v[2] += st.o[dt][4 * jj + 2] * scale; v[3] += st.o[dt][4 * jj + 3] * scale;
            *p = v;
        }
}
DI void lds_out_final_store(LAS unsigned char* ob, int c, int h, const AttnSt& st, float scale, bf16_t* AO, int tokrow, int head) {
    bf16_t* base = AO + (size_t)tokrow * D + head * 64 + 4 * h;
#pragma unroll
    for (int dt = 0; dt < 2; ++dt)
#pragma unroll
        for (int jj = 0; jj < 4; ++jj) {
            const f32x4 v = *(const LAS f32x4*)(ob + (((dt * 4 + jj) * 2 + h) * 32 + c) * 16);
            u32x2 w; w.x = pk2(v[0] + st.o[dt][4 * jj] * scale, v[1] + st.o[dt][4 * jj + 1] * scale); w.y = pk2(v[2] + st.o[dt][4 * jj + 2] * scale, v[3] + st.o[dt][4 * jj + 3] * scale);
            *(u32x2*)(base + 32 * dt + 8 * jj) = w;
        }
}


DI void sel_gather(LAS unsigned char* lds, const bf16_t* K1, const bf16_t* V1T, const bf16x8 (&qf)[4], int cur, int tok_local, int t_col, AttnSt& st) {
    const int tid = opaque_tid(), lane = tid & 63, r = lane & 31, h = lane >> 5, wave = tid >> 6;
    const LAS unsigned* selm = (const LAS unsigned*)(lds + AT_SEL_OFF);
    unsigned u = selm[(wave * 8 + (lane >> 3)) * 8 + (lane & 7)];
    u |= (unsigned)__shfl_xor((int)u, 8); u |= (unsigned)__shfl_xor((int)u, 16); u |= (unsigned)__shfl_xor((int)u, 32);
    const unsigned foff = (unsigned)(r * 128 + 16 * h);
#define SG_LDK(dst, jj) do { const char* tb_ = (const char*)K1 + (size_t)(jj) * 8192; _Pragma("unroll") for (int kk = 0; kk < 4; ++kk) { \
        dst[kk][0] = *(const bf16x8*)(tb_ + foff + kk * 32); dst[kk][1] = *(const bf16x8*)(tb_ + 4096 + foff + kk * 32); } } while (0)
#define SG_LDV(dst, jj) do { const char* tb_ = (const char*)V1T + (size_t)(jj) * 8192; _Pragma("unroll") for (int sg = 0; sg < 4; ++sg) { \
        dst[sg][0] = *(const bf16x8*)(tb_ + foff + sg * 32); dst[sg][1] = *(const bf16x8*)(tb_ + 4096 + foff + sg * 32); } } while (0)
    int w = 0; unsigned Uw = (unsigned)__builtin_amdgcn_readlane((int)u, 0);
#define SG_NEXT(jout) do { while (Uw == 0u && w < 7) { ++w; Uw = (unsigned)__builtin_amdgcn_readlane((int)u, w); } \
        if (Uw == 0u) jout = -1; else { const int b_ = __builtin_ctz(Uw); Uw &= Uw - 1u; jout = 32 * w + b_; } } while (0)
    int j; SG_NEXT(j);
    bf16x8 kc[4][2];
    if (j >= 0) SG_LDK(kc, j);
    while (j >= 0) {
        int jn; SG_NEXT(jn);
        bf16x8 va[4][2];
        SG_LDV(va, j);
        const unsigned myw = selm[tok_local * 8 + (j >> 5)];
        const bool sel = (myw >> (j & 31)) & 1u;
        const int key0 = j * 64, lo = 0, hi = sel ? t_col : -1;
        f32x16 s0, s1;
#pragma unroll
        for (int i = 0; i < 16; ++i) { s0[i] = 0.f; s1[i] = 0.f; }
#pragma unroll
        for (int kk = 0; kk < 4; ++kk) { s0 = MFMA32(kc[kk][0], qf[kk], s0); s1 = MFMA32(kc[kk][1], qf[kk], s1); }
        if (jn >= 0) SG_LDK(kc, jn);
        const bool dead = !sel, fullv = sel && (hi >= key0 + 63);
        float rs = 0.f;
        bf16x8 pf[4];
        if (__all(dead || fullv)) {
            float mxr = fmx(s0[0], s1[0]);
#pragma unroll
            for (int i = 1; i < 16; ++i) mxr = fmx(mxr, fmx(s0[i], s1[i]));
            float mx = dead ? -INFINITY : mxr * LOG2E;
            mx = xh32_max(mx);
            const float mnew = fmx(st.m, mx);
            const float alpha = __builtin_amdgcn_exp2f(st.m - mnew);
            st.l *= alpha;
            if (!__all(mnew == st.m)) {
#pragma unroll
                for (int i = 0; i < 16; ++i) { st.o[0][i] *= alpha; st.o[1][i] *= alpha; } }
            st.m = mnew; const float nb = dead ? -INFINITY : -mnew;
#pragma unroll
            for (int i = 0; i < 16; ++i) {
                const float p0 = __builtin_amdgcn_exp2f(__builtin_fmaf(s0[i], LOG2E, nb)), p1 = __builtin_amdgcn_exp2f(__builtin_fmaf(s1[i], LOG2E, nb));
                s0[i] = p0; s1[i] = p1; rs += p0 + p1;
            }
#pragma unroll
            for (int sg = 0; sg < 4; ++sg) {
                u32x4 pw;
                if (sg < 2) { pw.x = pk2(s0[8 * sg + 0], s0[8 * sg + 1]); pw.y = pk2(s0[8 * sg + 2], s0[8 * sg + 3]); pw.z = pk2(s0[8 * sg + 4], s0[8 * sg + 5]); pw.w = pk2(s0[8 * sg + 6], s0[8 * sg + 7]); }
                else { const int q = sg - 2; pw.x = pk2(s1[8 * q + 0], s1[8 * q + 1]); pw.y = pk2(s1[8 * q + 2], s1[8 * q + 3]); pw.z = pk2(s1[8 * q + 4], s1[8 * q + 5]); pw.w = pk2(s1[8 * q + 6], s1[8 * q + 7]); }
                pf[sg] = __builtin_bit_cast(bf16x8, pw);
            }
        } else {
            float mx = -INFINITY;
#pragma unroll
            for (int i = 0; i < 16; ++i) {
                const int key = key0 + (i & 3) + 8 * (i >> 2) + 4 * h;
                float v = s0[i] * LOG2E; v = (key >= lo && key <= hi) ? v : -INFINITY; s0[i] = v; mx = fmx(mx, v);
                float x = s1[i] * LOG2E; x = (key + 32 >= lo && key + 32 <= hi) ? x : -INFINITY; s1[i] = x; mx = fmx(mx, x);
            }
            mx = xh32_max(mx);
            const float mnew = fmx(st.m, mx);
            const float alpha = __builtin_amdgcn_exp2f(st.m - mnew);
            st.l *= alpha;
            if (!__all(mnew == st.m)) {
#pragma unroll
                for (int i = 0; i < 16; ++i) { st.o[0][i] *= alpha; st.o[1][i] *= alpha; } }
            st.m = mnew;
#pragma unroll
            for (int i = 0; i < 16; ++i) {
                const float p0 = __builtin_amdgcn_exp2f(s0[i] - mnew), p1 = __builtin_amdgcn_exp2f(s1[i] - mnew);
                s0[i] = p0; s1[i] = p1; rs += p0 + p1;
            }
#pragma unroll
            for (int sg = 0; sg < 4; ++sg) {
                u32x4 pw;
                if (sg < 2) { pw.x = pk2(s0[8 * sg + 0], s0[8 * sg + 1]); pw.y = pk2(s0[8 * sg + 2], s0[8 * sg + 3]); pw.z = pk2(s0[8 * sg + 4], s0[8 * sg + 5]); pw.w = pk2(s0[8 * sg + 6], s0[8 * sg + 7]); }
                else { const int q = sg - 2; pw.x = pk2(s1[8 * q + 0], s1[8 * q + 1]); pw.y = pk2(s1[8 * q + 2], s1[8 * q + 3]); pw.z = pk2(s1[8 * q + 4], s1[8 * q + 5]); pw.w = pk2(s1[8 * q + 6], s1[8 * q + 7]); }
                pf[sg] = __builtin_bit_cast(bf16x8, pw);
            }
        }
        st.l += rs;
#pragma unroll
        for (int sg = 0; sg < 4; ++sg) { st.o[0] = MFMA32(va[sg][0], pf[sg], st.o[0]); st.o[1] = MFMA32(va[sg][1], pf[sg], st.o[1]); }
        j = jn;
    }
#undef SG_NEXT
#undef SG_LDK
#undef SG_LDV
}


#define MFMA16(a, b, c) __builtin_amdgcn_mfma_f32_16x16x32_bf16((a), (b), (c), 0, 0, 0)

struct Sel16St { f32x4 o[2][4]; float m[2], l[2]; };
DI void sel16_loop(LAS unsigned char* lds, const bf16_t* Kb, const bf16_t* VTb, int tile_hi, const bf16x8 (&qf)[2][2], int tokl0, int tcol0, Sel16St& st, bool primed) {
    const int tid = opaque_tid(), lane = tid & 63, c16 = lane & 15, q = lane >> 4, sw = (c16 >> 1) & 7;
    const int wave_u = __builtin_amdgcn_readfirstlane(tid >> 6);
    const int srow = tid >> 3, lc = (tid & 7) ^ ((srow >> 1) & 7);
    const bf16_t* ksrc = Kb + (size_t)srow * 64 + lc * 8;
    const bf16_t* vsrc = VTb + (size_t)srow * 64 + lc * 8;
    LAS unsigned char* wbase = lds + wave_u * 1024;
    const LAS unsigned* selm = (const LAS unsigned*)(lds + AT_SEL_OFF);
    const int tile_lo = 0;
    asm volatile("s_waitcnt lgkmcnt(0)" ::: "memory");
    if (!primed) __builtin_amdgcn_s_barrier();
    constexpr int GRP = SEL_NS / 2;
    if (!primed) {
#pragma unroll
        for (int i = 0; i < GRP; ++i) if (tile_lo + i <= tile_hi) AT_ISSUE(tile_lo + i, i);
    }
    unsigned wsel2[2] = {0u, 0u};
#pragma unroll 1
    for (int t = tile_lo; t <= tile_hi; ++t) {
        { const float dep_ = st.o[0][3][3] + st.o[1][3][3]; asm volatile("" :: "v"(dep_)); }
        const int rel = t - tile_lo, rem = tile_hi - t;
        if ((rel & (GRP - 1)) == 0) {
            asm volatile("s_waitcnt vmcnt(0)" ::: "memory");
            if (!AT_NO_BARRIER) __builtin_amdgcn_s_barrier();
            if (!SEL_SPREAD) {
#pragma unroll
                for (int i = 0; i < GRP; ++i) if (rem >= GRP + i) AT_ISSUE(t + GRP + i, (rel + GRP + i) & (SEL_NS - 1));
            }
        }
        if (SEL_SPREAD && rem >= GRP) AT_ISSUE(t + GRP, (rel + GRP) & (SEL_NS - 1));
        LAS unsigned char* kb = lds + (rel & (SEL_NS - 1)) * AT_KV_BYTES;
        LAS unsigned char* vb = kb + 8192;
        const int key0 = t * 64;
        bool selc[2];
        if ((t & 31) == 0 || t == tile_lo) {
#pragma unroll
            for (int ct = 0; ct < 2; ++ct) wsel2[ct] = selm[(tokl0 + 4 * ct + (c16 >> 2)) * 8 + (t >> 5)];
        }
#pragma unroll
        for (int ct = 0; ct < 2; ++ct) selc[ct] = (wsel2[ct] >> (t & 31)) & 1u;
        const bool any0 = __any(selc[0]), any1 = __any(selc[1]);
        if (any0 || any1) {
            bf16x8 ka[4][2];
#pragma unroll
            for (int kt = 0; kt < 4; ++kt)
#pragma unroll
                for (int ks = 0; ks < 2; ++ks) ka[kt][ks] = *(const LAS bf16x8*)(kb + (16 * kt + c16) * 128 + (((4 * ks + q) ^ sw) << 4));
            bf16x8 va[4][2];
#pragma unroll
            for (int dt = 0; dt < 4; ++dt)
#pragma unroll
                for (int a = 0; a < 2; ++a) va[dt][a] = *(const LAS bf16x8*)(vb + (16 * dt + c16) * 128 + (((4 * a + q) ^ sw) << 4));
#pragma unroll
            for (int ct = 0; ct < 2; ++ct) {
                if (ct == 0 ? !any0 : !any1) continue;
                f32x4 s[4];
                if (T5_PRIO) __builtin_amdgcn_s_setprio(1);
#pragma unroll
                for (int kt = 0; kt < 4; ++kt) { s[kt] = (f32x4){0.f, 0.f, 0.f, 0.f};
#pragma unroll
                    for (int ks = 0; ks < 2; ++ks) s[kt] = MFMA16(ka[kt][ks], qf[ct][ks], s[kt]); }
                if (T5_PRIO) __builtin_amdgcn_s_setprio(0);
                const int tcol = tcol0 + 4 * ct + (c16 >> 2);
                const bool dead = !selc[ct];
                const int hi = dead ? -1 : tcol;
                const bool fullv = !dead && (hi >= key0 + 63);
                float rs = 0.f;
                bf16x8 pf[2];
                if (AT_VAR == 1) { rs = 1.f + 1e-30f * (s[0][0] + s[1][0] + s[2][0] + s[3][0]); pf[0] = ka[0][0]; pf[1] = ka[1][0]; } else
                {
                    if (!__all(dead || fullv)) {
                        const int dhi = hi - key0 - 4 * q;
#pragma unroll
                        for (int kt = 0; kt < 4; ++kt)
#pragma unroll
                            for (int i = 0; i < 4; ++i) s[kt][i] = (16 * kt + i <= dhi) ? s[kt][i] : -INFINITY;
                    }
                    float mxr = fmx(fmx(s[0][0], s[0][1]), fmx(s[0][2], s[0][3]));
#pragma unroll
                    for (int kt = 1; kt < 4; ++kt) mxr = fmx(mxr, fmx(fmx(s[kt][0], s[kt][1]), fmx(s[kt][2], s[kt][3])));
                    float mx = dead ? -INFINITY : mxr * LOG2E;
                    if (__any(mx > st.m[ct] + (float)DEFER_THR)) {
                        mx = xh16_max(mx); mx = xh32_max(mx);
                        const float mnew = fmx(st.m[ct], mx);
                        const float alpha = __builtin_amdgcn_exp2f(st.m[ct] - mnew);
                        st.l[ct] *= alpha;
                        if (!__all(mnew == st.m[ct])) {
#pragma unroll
                            for (int dt = 0; dt < 4; ++dt) st.o[ct][dt] = st.o[ct][dt] * alpha; }
                        st.m[ct] = mnew;
                    }
                    const float nb = dead ? -INFINITY : -st.m[ct];
                    const f32x2 nb2 = {nb, nb}, l2e2 = {LOG2E, LOG2E};
                    f32x2 rs2 = {0.f, 0.f};
                    u32x4 pw[2];
#pragma unroll
                    for (int kt = 0; kt < 4; ++kt) {
                        f32x2 a0 = {s[kt][0], s[kt][1]}, a1 = {s[kt][2], s[kt][3]};
                        a0 = a0 * l2e2 + nb2; a1 = a1 * l2e2 + nb2;
                        a0.x = __builtin_amdgcn_exp2f(a0.x); a0.y = __builtin_amdgcn_exp2f(a0.y); a1.x = __builtin_amdgcn_exp2f(a1.x); a1.y = __builtin_amdgcn_exp2f(a1.y);
                        rs2 += a0 + a1;
                        pw[kt >> 1][2 * (kt & 1)] = pk2(a0.x, a0.y); pw[kt >> 1][2 * (kt & 1) + 1] = pk2(a1.x, a1.y);
                    }
                    rs = rs2.x + rs2.y;
                    pf[0] = __builtin_bit_cast(bf16x8, pw[0]); pf[1] = __builtin_bit_cast(bf16x8, pw[1]);
                }
                st.l[ct] += rs;
                if (T5_PRIO) __builtin_amdgcn_s_setprio(1);
#pragma unroll
                for (int dt = 0; dt < 4; ++dt)
#pragma unroll
                    for (int a = 0; a < 2; ++a) st.o[ct][dt] = MFMA16(va[dt][a], pf[a], st.o[ct][dt]);
                if (T5_PRIO) __builtin_amdgcn_s_setprio(0);
                if (ct == 0 && any1) { const float dep_ = st.o[0][3][3]; asm volatile("" :: "v"(dep_)); }
            }
        }
    }
    { const float dep_ = st.o[0][3][3] + st.o[1][3][3]; asm volatile("" :: "v"(dep_)); }
    if (SEL_NS > 4) { asm volatile("s_waitcnt lgkmcnt(0)" ::: "memory"); __builtin_amdgcn_s_barrier(); }
}

DI void nsa_tile(LAS unsigned char* lds, unsigned char* ws, int b, int g, int tq0) {
    const int tid = opaque_tid(), lane = tid & 63, wave = tid >> 6, c = lane & 31, h = lane >> 5, r = c & 3;
    const int tok_local = wave * 8 + (c >> 2), t_col = tq0 + tok_local, tokrow = b * S + t_col, head = g * 4 + r;
    const int cur = tq0 >> 6;
    const bf16_t* Q = (const bf16_t*)(ws + WS_Q);
    const size_t slab = (size_t)(b * NG + g) * S * 64;
    const bf16_t* KC = (const bf16_t*)(ws + WS_KC) + (size_t)(b * NG + g) * 1024 * 64;
    const bf16_t* VCT = (const bf16_t*)(ws + WS_VCT) + (size_t)(b * NG + g) * 64 * 1024;
    const bf16_t* K1 = (const bf16_t*)(ws + WS_KV + 2 * KVB) + slab;
    const bf16_t* V1T = (const bf16_t*)(ws + WS_KV + 3 * KVB) + slab;
    const bf16_t* K2 = (const bf16_t*)(ws + WS_KV + 4 * KVB) + slab;
    const bf16_t* V2T = (const bf16_t*)(ws + WS_KV + 5 * KVB) + slab;
    LAS float* imp = (LAS float*)(lds + AT_IMP_OFF);
    LAS unsigned* selm = (LAS unsigned*)(lds + AT_SEL_OFF);
    LAS float* imp_row = imp + tok_local * AT_IMP_STRIDE;
    bf16x8 qf[4];
    load_q(Q, tokrow, head, h, qf);
    const float* gp = (const float*)(ws + WS_G) + (size_t)tokrow * 48 + head * 3;
    float g_c = gp[0], g_s = gp[1], g_w = gp[2];
    if (!(CMP_FRAG && WIN_FRAG)) asm volatile("" : "+v"(g_c), "+v"(g_s), "+v"(g_w));
    if (CMP_FRAG) { asm volatile("s_waitcnt lgkmcnt(0)" ::: "memory"); __builtin_amdgcn_s_barrier(); }
    for (int i = lane; i < 8 * AT_IMP_STRIDE; i += 64) imp[wave * 8 * AT_IMP_STRIDE + i] = 0.f;
    LAS unsigned char* ob = lds + AT_IMP_OFF + wave * (8 * AT_IMP_STRIDE * 4);
    AttnSt st;
    const int hi_cmp = (t_col - 31) >> 4;
    const int ct_hi = ((tq0 + 32) >> 4) >> 6;
    st_reset(st);
    const int hiw_ = (tq0 + 8 * __builtin_amdgcn_readfirstlane(wave) + 7 - 31) >> 4, ct_hi_w = hiw_ >= 0 ? (hiw_ >> 6) : -1;
    if (!NSA_SKIP_CMP) { if (CMP_FRAG) attn_direct<1>(KC, VCT, 0, ct_hi_w, qf, 0, hi_cmp, st); else attn_loop<1, false>(lds, KC, VCT, 0, ct_hi, qf, 0, hi_cmp, st, 0.f, tok_local, t_col, imp_row); }
    if (!NSA_SKIP_CMP) {
        const float ltot = st.l + __shfl_xor(st.l, 32);
        const float inv_l = ltot > 0.f ? 1.f / ltot : 0.f;
        const float mfin = st.m;
        st_reset(st); st.m = mfin;
        if (CMP_FRAG) attn_direct<2>(KC, VCT, 0, ct_hi_w, qf, 0, hi_cmp, st, inv_l, imp_row); else attn_loop<2, false>(lds, KC, VCT, 0, ct_hi, qf, 0, hi_cmp, st, inv_l, tok_local, t_col, imp_row);
        asm volatile("s_waitcnt lgkmcnt(0)" ::: "memory");
    }
    if (SEL_PRIME && SEL16 && !NSA_SKIP_SEL && SEL_NS == 8) {
        const int wave_u = __builtin_amdgcn_readfirstlane(wave);
        const int srow = tid >> 3, lc = (tid & 7) ^ ((srow >> 1) & 7);
        const bf16_t* ksrc = K1 + (size_t)srow * 64 + lc * 8;
        const bf16_t* vsrc = V1T + (size_t)srow * 64 + lc * 8;
        LAS unsigned char* wbase = lds + wave_u * 1024;
        asm volatile("s_waitcnt lgkmcnt(0)" ::: "memory");
        __builtin_amdgcn_s_barrier();
#pragma unroll
        for (int i = 0; i < 4; ++i) if (i <= cur) AT_ISSUE(i, i);
    }
    if (cur <= 15 || NSA_SKIP_TOPK) {
        if (lane < 64) { const int tk = lane >> 3, wd = lane & 7; unsigned bits = 0u;
            if (wd == 0) bits = (cur >= 31) ? 0xffffffffu : ((2u << cur) - 1u);
            if (NSA_SKIP_TOPK && cur > 15) { bits = (wd == 0) ? 1u : 0u; if (((cur - 1) >> 5) == wd) bits |= 1u << ((cur - 1) & 31); if ((cur >> 5) == wd) bits |= 1u << (cur & 31); }
            selm[(wave * 8 + tk) * 8 + wd] = bits; }
    } else {
        unsigned key[8][4], words[8];
#pragma unroll
        for (int tk = 0; tk < 8; ++tk) {
            words[tk] = 0u;
#pragma unroll
            for (int i = 0; i < 4; ++i) { const int s = lane + 64 * i; const unsigned bits = __builtin_bit_cast(unsigned, imp[(wave * 8 + tk) * AT_IMP_STRIDE + s]);
                key[tk][i] = (s >= 1 && s <= cur - 2) ? (((bits & 0xffffff00u) | (unsigned)(255 - s)) + 1u) : 0u; }
        }
#pragma unroll 1
        for (int round = 0; round < 13; ++round) {
#pragma unroll
            for (int tk = 0; tk < 8; ++tk) {
                const unsigned mloc = max(max(key[tk][0], key[tk][1]), max(key[tk][2], key[tk][3]));
                const unsigned W = wave_umax(mloc);
#pragma unroll
                for (int i = 0; i < 4; ++i) key[tk][i] = (key[tk][i] == W) ? 0u : key[tk][i];
                const int bs = 255 - (int)((W - 1u) & 255u);
                if (W != 0u && (bs >> 5) == (lane & 7)) words[tk] |= 1u << (bs & 31);
            }
        }
#pragma unroll
        for (int tk = 0; tk < 8; ++tk) {
            unsigned wv = words[tk]; const int wd = lane & 7;
            if (wd == 0) wv |= 1u;
            if (((cur - 1) >> 5) == wd) wv |= 1u << ((cur - 1) & 31);
            if ((cur >> 5) == wd) wv |= 1u << (cur & 31);
            if (lane < 8) selm[(wave * 8 + tk) * 8 + wd] = wv;
        }
    }
    asm volatile("s_waitcnt lgkmcnt(0)" ::: "memory");
    constexpr bool OUT_LATE = SEL16 && !NSA_SKIP_SEL && SEL_NS > 4;
    if (!OUT_LATE) lds_out_set(ob, c, h, st, g_c);
    if (!OUT_LATE) st_reset(st);
    if (!NSA_SKIP_SEL && SEL16) {
        const int c16 = lane & 15, q16 = lane >> 4;
        bf16x8 qf16[2][2];
#pragma unroll
        for (int ct = 0; ct < 2; ++ct)
#pragma unroll
            for (int ks = 0; ks < 2; ++ks)
                qf16[ct][ks] = *(const bf16x8*)(Q + (size_t)(b * S + tq0 + wave * 8 + 4 * ct + (c16 >> 2)) * D + (g * 4 + (c16 & 3)) * 64 + 32 * ks + 8 * q16);
        float gs16[2];
#pragma unroll
        for (int ct = 0; ct < 2; ++ct) gs16[ct] = ((const float*)(ws + WS_G))[(size_t)(b * S + tq0 + wave * 8 + 4 * ct + (c16 >> 2)) * 48 + (g * 4 + (c16 & 3)) * 3 + 1];
#pragma unroll
        for (int ct = 0; ct < 2; ++ct) { asm volatile("" : "+v"(qf16[ct][0]), "+v"(qf16[ct][1])); asm volatile("" : "+v"(gs16[ct])); }
        Sel16St s16;
#pragma unroll
        for (int ct = 0; ct < 2; ++ct) { s16.m[ct] = -1e30f; s16.l[ct] = 0.f;
#pragma unroll
            for (int dt = 0; dt < 4; ++dt) s16.o[ct][dt] = (f32x4){0.f, 0.f, 0.f, 0.f}; }
        sel16_loop(lds, K1, V1T, cur, qf16, wave * 8, tq0 + wave * 8, s16, SEL_PRIME && SEL_NS == 8);
        if (OUT_LATE) lds_out_set(ob, c, h, st, g_c);
#pragma unroll
        for (int ct = 0; ct < 2; ++ct) {
            float ltot = s16.l[ct]; ltot += __shfl_xor(ltot, 16); ltot += __shfl_xor(ltot, 32);
            const float sc = AT_NO_BARRIER ? 0.f : (ltot > 0.f ? gs16[ct] / ltot : 0.f);
#pragma unroll
            for (int dt = 0; dt < 4; ++dt) {
                LAS f32x4* p = (LAS f32x4*)(ob + (((((dt >> 1) * 4 + 2 * (dt & 1) + (q16 >> 1)) * 2 + (q16 & 1)) * 32) + 16 * ct + c16) * 16);
                f32x4 v = *p; v = v + s16.o[ct][dt] * sc; *p = v;
            }
        }
    } else {
    if (!NSA_SKIP_SEL) { if (SEL_GATHER) sel_gather(lds, K1, V1T, qf, cur, tok_local, t_col, st); else attn_loop<0, true>(lds, K1, V1T, 0, cur, qf, 0, t_col, st, 0.f, tok_local, t_col, imp_row); }
    { const float ltot = st.l + __shfl_xor(st.l, 32); lds_out_add(ob, c, h, st, ltot > 0.f ? g_s / ltot : 0.f); }
    }
    st_reset(st);
    if (!NSA_SKIP_WIN) {
        if (WIN_FRAG) {
            const int wlo = tq0 + 8 * __builtin_amdgcn_readfirstlane(wave) - 511;
            attn_direct(K2, V2T, wlo > 0 ? wlo >> 6 : 0, cur, qf, t_col - 511, t_col, st);
        } else attn_loop<0, false>(lds, K2, V2T, cur >= 8 ? cur - 8 : 0, cur, qf, t_col - 511, t_col, st, 0.f, tok_local, t_col, imp_row);
    }
    { const float ltot = st.l + __shfl_xor(st.l, 32); lds_out_final_store(ob, c, h, st, ltot > 0.f ? g_w / ltot : 0.f, (bf16_t*)(ws + WS_AO), tokrow, head); }
}

DI void dil_tile(LAS unsigned char* lds, unsigned char* ws, int b, int g, int res16, int i0) {
    const int tid = opaque_tid(), lane = tid & 63, wave = tid >> 6, c = lane & 31, h = lane >> 5, r = c & 3;
    const int iq = i0 + wave * 8 + (c >> 2), t_col = 16 * iq + res16, tokrow = b * S + t_col, head = g * 4 + r;
    const bf16_t* Q = (const bf16_t*)(ws + WS_Q);
    const size_t slab = (size_t)(b * NG + g) * S * 64;
    bf16x8 qf[4];
    load_q(Q, tokrow, head, h, qf);
    AttnSt st; st_reset(st);
    if (DIL_FRAG) {
        const int wv = __builtin_amdgcn_readfirstlane(wave);
        const int res4 = res16 & 3, c4 = res16 >> 2;
        const bf16_t* K2b = (const bf16_t*)(ws + WS_KV + 4 * KVB) + slab + (size_t)res16 * 1024 * 64;
        const bf16_t* V2b = (const bf16_t*)(ws + WS_KV + 5 * KVB) + slab + (size_t)res16 * 64 * 1024;
        const bf16_t* K1b = (const bf16_t*)(ws + WS_KV + 2 * KVB) + slab + (size_t)res4 * 4096 * 64;
        const bf16_t* V1b = (const bf16_t*)(ws + WS_KV + 3 * KVB) + slab + (size_t)res4 * 64 * 4096;
        const bf16_t* K0b = (const bf16_t*)(ws + WS_KV + 0 * KVB) + slab;
        const bf16_t* V0b = (const bf16_t*)(ws + WS_KV + 1 * KVB) + slab;
        const int q2min = i0 + 8 * wv, q1min = 4 * q2min + c4, q0min = 16 * q2min + res16;
        attn_direct(K2b, V2b, q2min - 128 > 0 ? (q2min - 128) >> 6 : 0, (q2min + 7) >> 6, qf, iq - 128, iq, st);
        attn_direct(K1b, V1b, q1min - 128 > 0 ? (q1min - 128) >> 6 : 0, (q1min + 28) >> 6, qf, 4 * iq + c4 - 128, 4 * iq + c4, st);
        attn_direct(K0b, V0b, q0min - 128 > 0 ? (q0min - 128) >> 6 : 0, (q0min + 112) >> 6, qf, t_col - 128, t_col, st);
    } else {
    {
        const bf16_t* Kb = (const bf16_t*)(ws + WS_KV + 4 * KVB) + slab + (size_t)res16 * 1024 * 64;
        const bf16_t* Vb = (const bf16_t*)(ws + WS_KV + 5 * KVB) + slab + (size_t)res16 * 64 * 1024;
        const int lq = iq, lmin = i0 - 128;
        attn_loop<0, false, DIL_NS>(lds, Kb, Vb, lmin > 0 ? lmin >> 6 : 0, (i0 + 63) >> 6, qf, lq - 128, lq, st, 0.f, 0, 0, nullptr);
    }
    {
        const int res4 = res16 & 3, c4 = res16 >> 2;
        const bf16_t* Kb = (const bf16_t*)(ws + WS_KV + 2 * KVB) + slab + (size_t)res4 * 4096 * 64;
        const bf16_t* Vb = (const bf16_t*)(ws + WS_KV + 3 * KVB) + slab + (size_t)res4 * 64 * 4096;
        const int lq = 4 * iq + c4, lmin = 4 * i0 + c4 - 128;
        if (DIL_PRIV) {
            asm volatile("s_waitcnt lgkmcnt(0)" ::: "memory");
            __builtin_amdgcn_s_barrier();
            const int wv = __builtin_amdgcn_readfirstlane(wave), lqmin = 4 * (i0 + 8 * wv) + c4, lqmax = lqmin + 28;
            attn_private(lds, Kb, Vb, lqmin - 128 > 0 ? (lqmin - 128) >> 6 : 0, lqmax >> 6, qf, lq - 128, lq, st);
        } else
        attn_loop<0, false, DIL_NS>(lds, Kb, Vb, lmin > 0 ? lmin >> 6 : 0, (4 * (i0 + 63) + c4) >> 6, qf, lq - 128, lq, st, 0.f, 0, 0, nullptr);
    }
    {
        const bf16_t* Kb = (const bf16_t*)(ws + WS_KV + 0 * KVB) + slab;
        const bf16_t* Vb = (const bf16_t*)(ws + WS_KV + 1 * KVB) + slab;
        const int lq = t_col, lmin = 16 * i0 + res16 - 128;
        if (DIL_PRIV) {
            const int wv = __builtin_amdgcn_readfirstlane(wave), lqmin = 16 * (i0 + 8 * wv) + res16, lqmax = lqmin + 112;
            attn_private(lds, Kb, Vb, lqmin - 128 > 0 ? (lqmin - 128) >> 6 : 0, lqmax >> 6, qf, lq - 128, lq, st);
        } else
        attn_loop<0, false, DIL_NS>(lds, Kb, Vb, lmin > 0 ? lmin >> 6 : 0, (16 * (i0 + 63) + res16) >> 6, qf, lq - 128, lq, st, 0.f, 0, 0, nullptr);
    }
    }
    f32x16 out[2];
    const float ltot = st.l + __shfl_xor(st.l, 32), sc = ltot > 0.f ? 1.f / ltot : 0.f;
#pragma unroll
    for (int i = 0; i < 16; ++i) { out[0][i] = st.o[0][i] * sc; out[1][i] = st.o[1][i] * sc; }
    store_out((bf16_t*)(ws + WS_AO), tokrow, head, h, out);
}

constexpr int RT_RW_STRIDE = 128;
constexpr int RT_SC_OFF = 131072;
constexpr int RT_HIST_OFF = RT_SC_OFF + 8 * 8 * 32 * 4;
constexpr int MISC_OFF = 131072 + 12288;

DI void ln_router_phase(LAS unsigned char* lds, const Args& a, int layer, int G) {
    const int tid = opaque_tid(), lane = tid & 63, wave = tid >> 6;
    unsigned char* ws = a.ws;
    bf16_t* XB = (bf16_t*)(ws + WS_XB);
    bf16_t* HM = (bf16_t*)(ws + WS_HM);
    const float* modr = (const float*)(ws + WS_MOD) + (size_t)(layer * 2 + 1) * NB * 3072;
    const float* modm = (const float*)(ws + WS_MOD) + (size_t)(layer * 2 + 0) * NB * 3072;
    const float* xin = a.x;
#define LNR_LDX(tok_, j_) ((layer == 0) ? *(const f32x4*)(xin + (size_t)(tok_) * D + 4 * lane + 256 * (j_)) : bf4_to_f4(*(const u32x2*)(XB + (size_t)(tok_) * D + 4 * lane + 256 * (j_))))
    const bf16_t* Ym = (const bf16_t*)(ws + WS_Q);
    const float* lng = a.ln_g + (layer * 2 + 0) * D; const float* lnb = a.ln_b + (layer * 2 + 0) * D;
    int* eidx = (int*)(ws + WS_EIDX); float* ewt = (float*)(ws + WS_EWT);
    unsigned* ctl = (unsigned*)(ws + WS_CTL);
    LAS unsigned* hist = (LAS unsigned*)(lds + RT_HIST_OFF);
    LAS float* sc = (LAS float*)(lds + RT_SC_OFF) + wave * 256;
    constexpr int ROWB = 2064;
    LAS unsigned char* sthi = lds;
    LAS unsigned char* stlo = lds + 16 * ROWB;
    LAS float* part = (LAS float*)(lds + 2 * 16 * ROWB);
    f32x4 xn[4]; u32x2 yn[4];
    { const int tok0 = blockIdx.x * 16 + 2 * wave;
      if (tok0 < NTOK) {
#pragma unroll
        for (int j = 0; j < 4; ++j) { xn[j] = LNR_LDX(tok0, j); yn[j] = *(const u32x2*)(Ym + (size_t)tok0 * D + 4 * lane + 256 * j); } } }
    const int er = lane & 31, kh = lane >> 5;
    bf16x8 whi[8], wlo[8];
#pragma unroll
    for (int ks = 0; ks < 8; ++ks) {
        u32x4 hi, lo;
#pragma unroll
        for (int p = 0; p < 4; ++p) {
            const float w0 = a.router_w[(size_t)(128 * wave + 16 * ks + 8 * kh + 2 * p) * 32 + er], w1 = a.router_w[(size_t)(128 * wave + 16 * ks + 8 * kh + 2 * p + 1) * 32 + er];
            const unsigned hp = pk2(w0, w1);
            hi[p] = hp; lo[p] = pk2(w0 - bf2f((unsigned short)(hp & 0xffffu)), w1 - bf2f((unsigned short)(hp >> 16)));
        }
        whi[ks] = __builtin_bit_cast(bf16x8, hi); wlo[ks] = __builtin_bit_cast(bf16x8, lo);
    }
    const float rbias = a.router_b[lane & 31];
    LAS float* lgb = (LAS float*)(lds + 90112);
    for (int i = tid; i < 2 * D; i += NTHREADS) lgb[i] = i < D ? lng[i] : lnb[i - D];
    if (tid < 32) hist[tid] = 0u;
    __syncthreads();
    f32x4 gtv[4], shv[4], sclv[4]; int bcur = -1;
#pragma unroll
    for (int j = 0; j < 4; ++j) { gtv[j] = f32x4{0.f, 0.f, 0.f, 0.f}; shv[j] = gtv[j]; sclv[j] = gtv[j]; }
#pragma unroll 1
    for (int base = blockIdx.x * 16; base < NTOK; base += G * 16) {
#pragma unroll 1
        for (int ti = 0; ti < 2; ++ti) {
            const int tok = base + 2 * wave + ti, b = tok >> 14;
            bf16_t* xr = XB + (size_t)tok * D;
            f32x4 xc[4]; u32x2 yc[4];
#pragma unroll
            for (int j = 0; j < 4; ++j) { xc[j] = xn[j]; yc[j] = yn[j]; }
            if (b != bcur) { bcur = b;
#pragma unroll
                for (int j = 0; j < 4; ++j) { const int col = 4 * lane + 256 * j; gtv[j] = *(const f32x4*)(modm + b * 3072 + 2 * D + col);
                    shv[j] = *(const f32x4*)(modr + b * 3072 + col); sclv[j] = *(const f32x4*)(modr + b * 3072 + D + col) + 1.f; } }
            { const int tokn = ti == 0 ? tok + 1 : base + G * 16 + 2 * wave;
              if (tokn < NTOK) {
#pragma unroll
                for (int j = 0; j < 4; ++j) { xn[j] = LNR_LDX(tokn, j); yn[j] = *(const u32x2*)(Ym + (size_t)tokn * D + 4 * lane + 256 * j); } } }
            f32x4 v[4]; float s = 0.f;
#pragma unroll
            for (int j = 0; j < 4; ++j) {
                const int col = 4 * lane + 256 * j;
                const f32x4 x = xc[j], gt = gtv[j];
                const u32x2 yy = yc[j];
                f32x4 yf; yf.x = bf2f((unsigned short)(yy.x & 0xffffu)); yf.y = bf2f((unsigned short)(yy.x >> 16)); yf.z = bf2f((unsigned short)(yy.y & 0xffffu)); yf.w = bf2f((unsigned short)(yy.y >> 16));
                v[j] = x * ALPHA + gt * yf;
                s += (v[j].x + v[j].y) + (v[j].z + v[j].w);
            }
            const float mean = wave_sum(s) * (1.f / D); float s2 = 0.f;
#pragma unroll
            for (int j = 0; j < 4; ++j) { v[j] = v[j] - mean; s2 += (v[j].x * v[j].x + v[j].y * v[j].y) + (v[j].z * v[j].z + v[j].w * v[j].w); }
            const float rstd = 1.f / sqrtf(wave_sum(s2) * (1.f / D) + LN_EPS);
#pragma unroll
            for (int j = 0; j < 4; ++j) {
                const int col = 4 * lane + 256 * j;
                const f32x4 gg = *(const LAS f32x4*)(lgb + col), bb = *(const LAS f32x4*)(lgb + D + col);
                const f32x4 xnv = v[j] * rstd * gg + bb;
                { u32x2 xo; xo.x = pk2(xnv.x, xnv.y); xo.y = pk2(xnv.z, xnv.w); *(u32x2*)(xr + col) = xo; }
                const f32x4 hm = xnv * sclv[j] + shv[j];
                u32x2 o; o.x = pk2(hm.x, hm.y); o.y = pk2(hm.z, hm.w);
                *(u32x2*)(HM + (size_t)tok * D + col) = o;
                u32x2 l2;
                l2.x = pk2(hm.x - bf2f((unsigned short)(o.x & 0xffffu)), hm.y - bf2f((unsigned short)(o.x >> 16)));
                l2.y = pk2(hm.z - bf2f((unsigned short)(o.y & 0xffffu)), hm.w - bf2f((unsigned short)(o.y >> 16)));
                *(LAS u32x2*)(sthi + (2 * wave + ti) * ROWB + col * 2) = o;
                *(LAS u32x2*)(stlo + (2 * wave + ti) * ROWB + col * 2) = l2;
            }
        }
        __syncthreads();
        f32x16 acc;
#pragma unroll
        for (int i = 0; i < 16; ++i) acc[i] = 0.f;
        { const int rowo = (lane & 15) * ROWB;
#pragma unroll
          for (int ks = 0; ks < 8; ++ks) {
              const int kb = (128 * wave + 16 * ks + 8 * kh) * 2;
              const bf16x8 bh = *(const LAS bf16x8*)(sthi + rowo + kb), bl = *(const LAS bf16x8*)(stlo + rowo + kb);
              acc = MFMA32(whi[ks], bh, acc); acc = MFMA32(wlo[ks], bh, acc); acc = MFMA32(whi[ks], bl, acc);
          } }
        if ((lane & 31) < 16) {
#pragma unroll
            for (int jj = 0; jj < 4; ++jj) { const f32x4 pv = {acc[4 * jj], acc[4 * jj + 1], acc[4 * jj + 2], acc[4 * jj + 3]};
                *(LAS f32x4*)(part + ((wave * 16 + (lane & 31)) * 32 + 8 * jj + 4 * kh)) = pv; }
        }
        __syncthreads();
        {
            const int tl = 2 * wave + (lane >> 5), e = lane & 31; float lg = 0.f;
#pragma unroll
            for (int w2 = 0; w2 < 8; ++w2) lg += part[(w2 * 16 + tl) * 32 + e];
            const float sg = 1.f / (1.f + expf(-lg));
            const float x = sg + rbias;
            float g1 = x; g1 = fmx(g1, DPPF(g1, 0xB1, 0xf)); g1 = fmx(g1, DPPF(g1, 0x4E, 0xf)); { const float t_ = DPPF(g1, 0x141, 0xf); g1 = fmx(g1, DPPF(t_, 0x1B, 0xf)); }
            const unsigned long long b1 = __ballot(x == g1);
            const int first1 = __ffs((unsigned)(b1 >> (lane & ~7)) & 0xffu) - 1;
            const float x2 = ((lane & 7) == first1) ? -INFINITY : x;
            float g2 = x2; g2 = fmx(g2, DPPF(g2, 0xB1, 0xf)); g2 = fmx(g2, DPPF(g2, 0x4E, 0xf)); { const float t_ = DPPF(g2, 0x141, 0xf); g2 = fmx(g2, DPPF(t_, 0x1B, 0xf)); }
            const unsigned long long b2 = __ballot(x2 == g2);
            const int first2 = __ffs((unsigned)(b2 >> (lane & ~7)) & 0xffu) - 1;
            const float gs = g1 + g2;
            float bs = fmx(gs, DPPF(gs, 0x128, 0xf)); bs = xh16_max(bs);
            const unsigned long long bb = __ballot(gs == bs);
            const int best = (__ffs((unsigned)(bb >> (lane & 32))) - 1) >> 3;
            const int src = (lane & 32) + best * 8;
            const int i1 = __shfl(first1, src), i2 = __shfl(first2, src);
            const int e1 = best * 8 + i1, e2 = best * 8 + i2;
            const float w1 = __shfl(sg, (lane & 32) + e1), w2 = __shfl(sg, (lane & 32) + e2);
            if (e == 0) {
                const int tok = base + tl; const float inv = 1.f / (w1 + w2);
                eidx[tok * 2] = e1; eidx[tok * 2 + 1] = e2; ewt[tok * 2] = w1 * inv; ewt[tok * 2 + 1] = w2 * inv;
                (void)__hip_atomic_fetch_add(hist + e1, 1u, __ATOMIC_RELAXED, __HIP_MEMORY_SCOPE_WORKGROUP); (void)__hip_atomic_fetch_add(hist + e2, 1u, __ATOMIC_RELAXED, __HIP_MEMORY_SCOPE_WORKGROUP);
            }
        }
    }
    __syncthreads();
    if (tid < 32) { const unsigned hv = hist[tid]; if (hv) atomicAdd(ctl + CW_CNT + layer * 32 + tid, hv); }
}

DI void build_tile_table(LAS int* tstart, const unsigned* cnt) {
    if (threadIdx.x < 64) { const int e = threadIdx.x; int nt = 0;
        if (e < 32) nt = (int)((__hip_atomic_load(cnt + e, __ATOMIC_RELAXED, __HIP_MEMORY_SCOPE_AGENT) + 255u) >> 8);
        int inc = nt;
#pragma unroll
        for (int d = 1; d < 32; d <<= 1) { const int o = __shfl_up(inc, d); if (e >= d) inc += o; }
        if (e < 32) tstart[e] = inc - nt;
        if (e == 31) tstart[32] = inc; }
    __syncthreads();
    for (int t = threadIdx.x; t < 320; t += NTHREADS) { int e = 0;
#pragma unroll 1
        for (int j = 1; j < 32; ++j) e += (tstart[j] <= t) ? 1 : 0;
        ((LAS unsigned char*)tstart)[2048 + t] = (unsigned char)e; }
    __syncthreads();
}

DI void scatter_phase(LAS unsigned char* lds, const Args& a, int layer, int G) {
    const int tid = opaque_tid(), lane = tid & 63, wave = tid >> 6;
    unsigned char* ws = a.ws;
    unsigned* ctl = (unsigned*)(ws + WS_CTL);
    LAS int* tstart = (LAS int*)(lds + MISC_OFF);
    LAS unsigned* lh = (LAS unsigned*)(lds + MISC_OFF + 256);
    LAS unsigned* lbase = (LAS unsigned*)(lds + MISC_OFF + 512);
    LAS int* slots = (LAS int*)(lds + MISC_OFF + 1024);
    const int* eidx = (const int*)(ws + WS_EIDX); const float* ewt = (const float*)(ws + WS_EWT);
    int* row_tok = (int*)(ws + WS_ROWTOK) + layer * ROWS_PAD; float* row_w = (float*)(ws + WS_ROWW) + layer * ROWS_PAD;
    const bf16_t* HM = (const bf16_t*)(ws + WS_HM); bf16_t* HS = (bf16_t*)(ws + WS_HS);
    build_tile_table(tstart, ctl + CW_CNT + layer * 32);
    for (int chunk = blockIdx.x; chunk < NTOK / 128; chunk += G) {
        if (tid < 32) lh[tid] = 0u;
        __syncthreads();
        int e = 0; unsigned rank = 0;
        if (tid < 256) { e = eidx[chunk * 256 + tid]; rank = __hip_atomic_fetch_add(lh + e, 1u, __ATOMIC_RELAXED, __HIP_MEMORY_SCOPE_WORKGROUP); }
        __syncthreads();
        if (tid < 32) { const unsigned n = lh[tid]; lbase[tid] = n ? atomicAdd(ctl + CW_CUR + layer * 32 + tid, n) : 0u; }
        __syncthreads();
        if (tid < 256) {
            const int slot = tstart[e] * 256 + (int)(lbase[e] + rank);
            slots[tid] = slot;
            row_tok[slot] = chunk * 256 + tid;
            row_w[slot] = ewt[chunk * 256 + tid];
        }
        __syncthreads();
        if (!MOE_GATHER)
        for (int i0 = wave * 32; i0 < wave * 32 + 32; i0 += 8) {
            u32x4 v0[8], v1[8];
#pragma unroll
            for (int u = 0; u < 8; ++u) { const int tok = chunk * 128 + ((i0 + u) >> 1); const u32x4* src = (const u32x4*)(HM + (size_t)tok * D) + lane; v0[u] = src[0]; v1[u] = src[64]; }
#pragma unroll
            for (int u = 0; u < 8; ++u) { u32x4* dst = (u32x4*)(HS + (size_t)slots[i0 + u] * D) + lane; dst[0] = v0[u]; dst[64] = v1[u]; }
        }
        __syncthreads();
    }
}

DI void ln_moe_phase(const Args& a, int layer, int G, bool write_hm) {
    const int tid = opaque_tid(), lane = tid & 63, wave = tid >> 6;
    unsigned char* ws = a.ws;
    float* X = a.out; bf16_t* XB = (bf16_t*)(ws + WS_XB);
    const bf16_t* Y = (const bf16_t*)(ws + WS_Y);
    const float* modc = (const float*)(ws + WS_MOD) + (size_t)(layer * 2 + 1) * NB * 3072;
    const float* modn = (const float*)(ws + WS_MOD) + (size_t)((layer + 1) * 2 + 0) * NB * 3072;
    const float* lng = a.ln_g + (layer * 2 + 1) * D; const float* lnb = a.ln_b + (layer * 2 + 1) * D;
    bf16_t* HM = (bf16_t*)(ws + WS_HM);
    f32x4 ggv[4], bbv[4];
#pragma unroll
    for (int j = 0; j < 4; ++j) { const int col = 4 * lane + 256 * j; ggv[j] = *(const f32x4*)(lng + col); bbv[j] = *(const f32x4*)(lnb + col); }
    u32x2 nx[4], ny0[4], ny1[4];
    { const int tok0 = blockIdx.x * NWAVES + wave;
      if (tok0 < NTOK) {
#pragma unroll
        for (int j = 0; j < 4; ++j) { const int col = 4 * lane + 256 * j;
            nx[j] = *(const u32x2*)(XB + (size_t)tok0 * D + col); ny0[j] = *(const u32x2*)(Y + (size_t)tok0 * D + col); ny1[j] = *(const u32x2*)(Y + ((size_t)NTOK + tok0) * D + col); }
      } }
    f32x4 gtv[4], shv[4], sclv[4]; int bcur = -1;
#pragma unroll
    for (int j = 0; j < 4; ++j) { gtv[j] = f32x4{0.f, 0.f, 0.f, 0.f}; shv[j] = gtv[j]; sclv[j] = gtv[j]; }
    for (int tok = blockIdx.x * NWAVES + wave; tok < NTOK; tok += G * NWAVES) {
        const int b = tok >> 14;
        float* xr = X + (size_t)tok * D; bf16_t* xb = XB + (size_t)tok * D;
        u32x2 cx[4], cy0[4], cy1[4];
#pragma unroll
        for (int j = 0; j < 4; ++j) { cx[j] = nx[j]; cy0[j] = ny0[j]; cy1[j] = ny1[j]; }
        if (b != bcur) {
            bcur = b;
#pragma unroll
            for (int j = 0; j < 4; ++j) { const int col = 4 * lane + 256 * j; gtv[j] = *(const f32x4*)(modc + b * 3072 + 2 * D + col);
                if (write_hm) { shv[j] = *(const f32x4*)(modn + b * 3072 + col); sclv[j] = *(const f32x4*)(modn + b * 3072 + D + col); } }
        }
        { const int tn = tok + G * NWAVES;
          if (tn < NTOK) {
#pragma unroll
            for (int j = 0; j < 4; ++j) { const int col = 4 * lane + 256 * j;
                nx[j] = *(const u32x2*)(XB + (size_t)tn * D + col); ny0[j] = *(const u32x2*)(Y + (size_t)tn * D + col); ny1[j] = *(const u32x2*)(Y + ((size_t)NTOK + tn) * D + col); }
          } }
        f32x4 v[4]; float s = 0.f;
#pragma unroll
        for (int j = 0; j < 4; ++j) {
            const int col = 4 * lane + 256 * j;
            const f32x4 x = bf4_to_f4(cx[j]), gt = gtv[j];
            const u32x2 y0 = cy0[j], y1 = cy1[j];
            f32x4 ys;
            ys.x = bf2f((unsigned short)(y0.x & 0xffffu)) + bf2f((unsigned short)(y1.x & 0xffffu));
            ys.y = bf2f((unsigned short)(y0.x >> 16)) + bf2f((unsigned short)(y1.x >> 16));
            ys.z = bf2f((unsigned short)(y0.y & 0xffffu)) + bf2f((unsigned short)(y1.y & 0xffffu));
            ys.w = bf2f((unsigned short)(y0.y >> 16)) + bf2f((unsigned short)(y1.y >> 16));
            v[j] = x * ALPHA + gt * ys;
            s += (v[j].x + v[j].y) + (v[j].z + v[j].w);
        }
        const float mean = wave_sum(s) * (1.f / D); float s2 = 0.f;
#pragma unroll
        for (int j = 0; j < 4; ++j) { v[j] = v[j] - mean; s2 += (v[j].x * v[j].x + v[j].y * v[j].y) + (v[j].z * v[j].z + v[j].w * v[j].w); }
        const float rstd = 1.f / sqrtf(wave_sum(s2) * (1.f / D) + LN_EPS);
#pragma unroll
        for (int j = 0; j < 4; ++j) {
            const int col = 4 * lane + 256 * j;
            const f32x4 xn = v[j] * rstd * ggv[j] + bbv[j];
            if (layer == 1) __builtin_nontemporal_store(xn, (f32x4*)(xr + col));
            else { u32x2 xo; xo.x = pk2(xn.x, xn.y); xo.y = pk2(xn.z, xn.w); *(u32x2*)(xb + col) = xo; }
            if (write_hm) {
                const f32x4 hm = xn * (sclv[j] + 1.f) + shv[j];
                u32x2 o; o.x = pk2(hm.x, hm.y); o.y = pk2(hm.z, hm.w);
                *(u32x2*)(HM + (size_t)tok * D + col) = o;
            }
        }
    }
}

DI void cmp2_phase(LAS unsigned char* lds, const Args& a, int G) {
    const int tid = opaque_tid(), lane = tid & 63, wave = tid >> 6;
    unsigned char* ws = a.ws;
    const bf16_t* hid = (const bf16_t*)(ws + WS_HID);
    const float* rope = (const float*)(ws + WS_ROPE);
    bf16_t* KC = (bf16_t*)(ws + WS_KC); bf16_t* VCT = (bf16_t*)(ws + WS_VCT);
    LAS float* w2s = (LAS float*)lds;
    LAS unsigned char* hs = lds + 65536 + wave * 4096;
    for (int rg0 = blockIdx.x * NWAVES; rg0 < 2048; rg0 += G * NWAVES) {
        const int R0 = (rg0 + wave) * 8;
        const int kv = (rg0 * 8) >> 13, bg = (R0 >> 10) & 7, n0 = R0 & 1023;
        const float* w2 = kv ? a.cw2_v : a.cw2_k;
        __syncthreads();
        for (int i = tid; i < 256 * 16; i += NTHREADS) *(LAS f32x4*)(w2s + 4 * i) = *(const f32x4*)(w2 + 4 * i);
#pragma unroll
        for (int i = 0; i < 4; ++i) *(LAS u32x4*)(hs + (lane + 64 * i) * 16) = *(const u32x4*)(hid + (size_t)R0 * 256 + (lane + 64 * i) * 8);
        __syncthreads();
        float acc[8];
#pragma unroll
        for (int i = 0; i < 8; ++i) acc[i] = 0.f;
#pragma unroll 4
        for (int k = 0; k < 256; k += 8) {
            float w[8];
#pragma unroll
            for (int j = 0; j < 8; ++j) w[j] = w2s[(k + j) * 64 + lane];
#pragma unroll
            for (int i = 0; i < 8; ++i) {
                const u32x4 hp = *(const LAS u32x4*)(hs + i * 512 + k * 2);
#pragma unroll
                for (int j = 0; j < 4; ++j) { acc[i] += bf2f((unsigned short)(hp[j] & 0xffffu)) * w[2 * j]; acc[i] += bf2f((unsigned short)(hp[j] >> 16)) * w[2 * j + 1]; }
            }
        }
#pragma unroll
        for (int i = 0; i < 8; ++i) {
            const int n = n0 + i;
            float v = n < 1023 ? acc[i] : 0.f;
            if (kv == 0) {
                const float partner = __shfl_xor(v, 8);
                if (lane < 16 && n < 1023) {
                    const int b = bg >> 2; const float* cs = rope + ((size_t)b * S + 16 * n + 31) * 16; const int f = lane & 7;
                    v = (lane < 8) ? v * cs[f] - partner * cs[8 + f] : partner * cs[8 + f] + v * cs[f];
                }
                KC[CMP_FRAG ? (size_t)bg * 65536 + (size_t)(n >> 6) * 4096 + dil_koff(n & 63, lane) : ((size_t)bg * 1024 + n) * 64 + lane] = (bf16_t)(pk2(v, 0.f) & 0xffffu);
            } else {
                VCT[(size_t)bg * 65536 + (size_t)(n >> 6) * 4096 + (CMP_FRAG ? dil_voff(vperm(n & 63), lane) : lane * 64 + vperm(n & 63))] = (bf16_t)(pk2(v, 0.f) & 0xffffu);
            }
        }
    }
}

#define XB_TMO      128
#define XB_XCNT(j)  (256  + 64 * (j))
#define XB_XSUB(j)  (1280 + 64 * (j))
#define XB_XGEN(j)  (2304 + 64 * (j))
#define XB_TOP      3328
#define XB_TOPGEN   3392
#define XCD_BAR_WORDS 3456
#define XB_SPIN_CAP (1u << 22)

__device__ __forceinline__ unsigned xb_ld(unsigned* p)              { return __hip_atomic_load(p, __ATOMIC_RELAXED, __HIP_MEMORY_SCOPE_AGENT); }
__device__ __forceinline__ unsigned xb_add(unsigned* p, unsigned v) { return __hip_atomic_fetch_add(p, v, __ATOMIC_RELAXED, __HIP_MEMORY_SCOPE_AGENT); }
__device__ __forceinline__ unsigned xb_xcc_id() { return (unsigned)__builtin_amdgcn_s_getreg((3 << 11) | 20) & 0xFu; }
#define XB_SPIN(cond, bar) do { unsigned _sp = 0; while (cond) { __builtin_amdgcn_s_sleep(1); \
    if ((++_sp & 255u) == 0u) { if (xb_ld(&(bar)[XB_TMO])) break; if (_sp > XB_SPIN_CAP) { atomicAdd(&(bar)[XB_TMO], 1u); break; } } } } while (0)

struct XcdBarrier {
    unsigned* bar; unsigned x;
    volatile LAS unsigned* st;
};

__device__ __forceinline__ XcdBarrier xcd_barrier_post(unsigned* bar, volatile LAS unsigned* st) {
    XcdBarrier b; b.bar = bar; b.x = xb_xcc_id(); b.st = st;
    if (threadIdx.x == 0) (void)xb_add(&bar[XB_XCNT(b.x)], 1u);
    return b;
}
__device__ __forceinline__ void xcd_barrier_complete(unsigned* bar, unsigned x, unsigned& nloc, unsigned& nx) {
    const unsigned G = gridDim.x * gridDim.y * gridDim.z;
    unsigned sum, cnt, mine, sp = 0u;
    for (;;) {
        sum = 0u; cnt = 0u; mine = 0u;
#pragma unroll
        for (unsigned j = 0; j < 16; ++j) { const unsigned c = xb_ld(&bar[XB_XCNT(j)]); sum += c; cnt += (c > 0u) ? 1u : 0u; mine = (j == x) ? c : mine; }
        if (sum == G) break;
        __builtin_amdgcn_s_sleep(1);
        if ((++sp & 255u) == 0u) { if (xb_ld(&bar[XB_TMO])) break; if (sp > XB_SPIN_CAP) { atomicAdd(&bar[XB_TMO], 1u); break; } }
    }
    nloc = mine > 0u ? mine : 1u; nx = cnt > 0u ? cnt : 1u;
}

__device__ __forceinline__ void xcd_barrier(const XcdBarrier& b) {
    asm volatile("s_waitcnt vmcnt(0)" ::: "memory");
    __syncthreads();
    if (threadIdx.x == 0) {
        unsigned* bar = b.bar;
        __builtin_amdgcn_s_waitcnt(0);
        unsigned nloc = b.st[0], nx = b.st[1];
        if (nloc == 0u) { xcd_barrier_complete(bar, b.x, nloc, nx); b.st[0] = nloc; b.st[1] = nx; }
        const unsigned old = xb_add(&bar[XB_XSUB(b.x)], 1u);
        const unsigned gen = old / nloc;
        if (old + 1u == (gen + 1u) * nloc) {
            __builtin_amdgcn_fence(__ATOMIC_RELEASE, "agent");
            asm volatile("s_waitcnt vmcnt(0)" ::: "memory");
            const unsigned og = xb_add(&bar[XB_TOP], 1u);
            const unsigned tg = og / nx;
            if (og + 1u == (tg + 1u) * nx) xb_add(&bar[XB_TOPGEN], 1u);
            else XB_SPIN(xb_ld(&bar[XB_TOPGEN]) == tg, bar);
            __builtin_amdgcn_fence(__ATOMIC_ACQUIRE, "agent");
            xb_add(&bar[XB_XGEN(b.x)], 1u);
            asm volatile("s_waitcnt vmcnt(0)" ::: "memory");
        } else {
            XB_SPIN(xb_ld(&bar[XB_XGEN(b.x)]) == gen, bar);
            __builtin_amdgcn_fence(__ATOMIC_ACQUIRE, "agent");
            asm volatile("s_waitcnt vmcnt(0)" ::: "memory");
        }
    }
    __syncthreads();
}

DI void prologue_phase(LAS unsigned char* lds, const Args& a, int G) {
    const int tid = opaque_tid(), lane = tid & 63, wave = tid >> 6;
    unsigned char* ws = a.ws;
    LAS float* red = (LAS float*)(lds + 131072);
    LAS float* sil = (LAS float*)lds;
    if ((int)blockIdx.x < 200) {
        for (int i = tid; i < 2 * D; i += NTHREADS) { const float cv = a.c[i]; sil[i] = cv / (1.f + expf(-cv)); }
        __syncthreads();
    }
    for (int bt = blockIdx.x; bt < 200; bt += G) {
        float a0 = 0.f, a1 = 0.f;
        if (bt < 192) {
            const int is = bt / 48, col = (bt % 48) * 64 + lane;
            const float* W = a.ada_w + (size_t)is * D * 3072;
#pragma unroll 16
            for (int k = wave * 128; k < wave * 128 + 128; ++k) {
                const float w = W[(size_t)k * 3072 + col];
                a0 += sil[k] * w; a1 += sil[D + k] * w;
            }
        } else {
            const int kv = (bt - 192) >> 2, col = ((bt - 192) & 3) * 64 + lane;
            const float* pe = kv ? a.cpos_v : a.cpos_k; const float* w1 = kv ? a.cw1_v : a.cw1_k;
            for (int k = wave * 256; k < wave * 256 + 256; ++k) a0 += pe[k] * w1[(size_t)k * 256 + col];
        }
        red[(wave * 2 + 0) * 64 + lane] = a0; red[(wave * 2 + 1) * 64 + lane] = a1;
        __syncthreads();
        if (wave < 2) {
            float s = 0.f;
#pragma unroll
            for (int w = 0; w < 8; ++w) s += red[(w * 2 + wave) * 64 + lane];
            if (bt < 192) { const int is = bt / 48, col = (bt % 48) * 64 + lane; ((float*)(ws + WS_MOD))[((size_t)is * NB + wave) * 3072 + col] = s + a.ada_b[is * 3072 + col]; }
            else if (wave == 0) { const int kv = (bt - 192) >> 2, col = ((bt - 192) & 3) * 64 + lane; ((float*)(ws + WS_CBIAS))[kv * 256 + col] = s; }
        }
        __syncthreads();
    }
    const int gtid = blockIdx.x * NTHREADS + tid, gn = G * NTHREADS;
    for (int idx = gtid; idx < NTOK * 8; idx += gn) {
        const int tok = idx >> 3, i = idx & 7;
        const float inv = powf(500000.0f, -(float)i * 0.125f);
        const float ang = (float)a.pos[tok] * inv;
        float sn, cs; sincosf(ang, &sn, &cs);
        float* rp = (float*)(ws + WS_ROPE) + (size_t)tok * 16;
        rp[i] = cs; rp[8 + i] = sn;
    }
    for (int idx = gtid; idx < 2 * ROWS_PAD; idx += gn) ((int*)(ws + WS_ROWTOK))[idx] = -1;
    LAS float* scr = (LAS float*)(lds + wave * 16384);
    const int gw = blockIdx.x * NWAVES + wave, NGW = G * NWAVES;
    constexpr int I_IN0 = 16 * (NSA_NP / 32), I_O = 16 * 32, I_IN1 = 16 * (DIL_N / 32), I_C1 = 32 * 8;
    constexpr int NITEMS = I_IN0 + 2 * I_O + I_IN1 + 2 * I_C1 + MOE_ITEMS;
    for (int it = gw; it < NITEMS; it += NGW) {
        int r = it;
        if (r < I_IN0) { transpose_plain(a.nsa_w_in, D, NSA_N, NSA_NP, (bf16_t*)(ws + WS_WIN0T), scr, r, lane, 1); continue; } r -= I_IN0;
        if (r < I_O) { transpose_plain(a.nsa_w_o, D, D, D, (bf16_t*)(ws + WS_WO0T), scr, r, lane); continue; } r -= I_O;
        if (r < I_IN1) { transpose_plain(a.dil_w_in, D, DIL_N, DIL_N, (bf16_t*)(ws + WS_WIN1T), scr, r, lane, 2); continue; } r -= I_IN1;
        if (r < I_O) { transpose_plain(a.dil_w_o, D, D, D, (bf16_t*)(ws + WS_WO1T), scr, r, lane); continue; } r -= I_O;
        if (r < I_C1) { transpose_plain(a.cw1_k, 2048, 256, 256, (bf16_t*)(ws + WS_CW1T), scr, r, lane); continue; } r -= I_C1;
        if (r < I_C1) { transpose_plain(a.cw1_v, 2048, 256, 256, (bf16_t*)(ws + WS_CW1T) + (size_t)256 * 2048, scr, r, lane); continue; } r -= I_C1;
        moe_convert_item(a.moe_wg, a.moe_wu, a.moe_wd, (bf16_t*)(ws + WS_GUT), (bf16_t*)(ws + WS_DNT), scr, r, lane);
    }
}

template <int layer>
DI void layer_body(LAS unsigned char* lds, const Args& a, const XcdBarrier& bar, int G) {
    unsigned char* ws = a.ws;
    const float* rope = (const float*)(ws + WS_ROPE);
    const float* mod = (const float*)(ws + WS_MOD);
    unsigned* ctl = (unsigned*)(ws + WS_CTL);
    LAS int* tstart = (LAS int*)(lds + MISC_OFF);

#if PH_PROJ
        if (layer == 0) {
            pg8::Gemm g{(const bf16_t*)(ws + WS_HM), (const bf16_t*)(ws + WS_WIN0T)}; pg8::StaticOrder So; So.init(NTOK, (GATES_SPLIT && G > 64) ? 2560 : NSA_NP, G, (int)blockIdx.x);
            EpiProj<0> E{ws, rope};
            pg8::gemm_phase<D, D, EpiProj<0>, pg8::StaticOrder, true, true>(lds, g, So, E);
        } else {
            pg8::Gemm g{(const bf16_t*)(ws + WS_HM), (const bf16_t*)(ws + WS_WIN1T)}; pg8::StaticOrder So; So.init(NTOK, DIL_N, G, (int)blockIdx.x);
            EpiProj<1> E{ws, rope};
#if PROJ1_PERM
            { const int tid3 = opaque_tid(); LAS unsigned* rtl = (LAS unsigned*)(lds + pg8::AG_RT_OFF);
              __syncthreads();
              for (int idx = tid3; idx < 12 * 256; idx += NTHREADS) { pg8::Unit uu; if (So.next(idx >> 8, uu)) rtl[idx] = (unsigned)proj1_tok(uu.pm * 256 + (idx & 255), proj1_sh(uu.pn)) * (unsigned)(D * 2); }
              __syncthreads(); }
            pg8::gemm_phase<D, D, EpiProj<1>, pg8::StaticOrder, true, true, true>(lds, g, So, E);
#else
            pg8::gemm_phase<D, D, EpiProj<1>, pg8::StaticOrder, true, true>(lds, g, So, E);
#endif
        }
#endif
        xcd_barrier(bar); STAMP(layer == 0 ? 3 : 13);
        if (layer == 0) {
#if PH_CMP
            { pg8::Gemm g{(const bf16_t*)(ws + WS_KV), (const bf16_t*)(ws + WS_CW1T)}; CmpOrder So{G, (int)blockIdx.x};
              EpiCmp1 E{(bf16_t*)(ws + WS_HID), (const float*)(ws + WS_CBIAS)};
              pg8::gemm_phase<1024, 2048, EpiCmp1, CmpOrder, true, true>(lds, g, So, E); }
            if (GATES_SPLIT && G > 64) {
                pg8::Gemm g{(const bf16_t*)(ws + WS_HM), (const bf16_t*)(ws + WS_WIN0T)}; GateOrder So{G, (int)blockIdx.x};
                EpiProj<0> E{ws, rope};
                pg8::gemm_phase<D, D, EpiProj<0>, GateOrder, true, true>(lds, g, So, E);
            }
            xcd_barrier(bar); STAMP(4);
            cmp2_phase(lds, a, G);
#endif
            xcd_barrier(bar); STAMP(5);
#if PH_NSA
            if (T5_STATIC && __builtin_amdgcn_readfirstlane(threadIdx.x) >= 256) __builtin_amdgcn_s_setprio(1);
            { int it = 0; for (int T = blockIdx.x; T < 2048; T += G, ++it) { const int bg = T & 7; int qt = T >> 3;
                if (G == 256 && (it & 1)) qt = (qt & ~31) + (31 - (qt & 31));
                nsa_tile(lds, ws, bg >> 2, bg & 3, qt * 64); } }
            if (T5_STATIC) __builtin_amdgcn_s_setprio(0);
#endif
        } else {
#if PH_DIL
            for (int T = blockIdx.x; T < 2048; T += G) { const int bg = T & 7, rest = T >> 3; dil_tile(lds, ws, bg >> 2, bg & 3, rest >> 4, (rest & 15) * 64); }
#endif
        }
        xcd_barrier(bar); STAMP(layer == 0 ? 6 : 14);
#if PH_WO
        {
            pg8::Gemm g{(const bf16_t*)(ws + WS_AO), (const bf16_t*)(ws + (layer == 0 ? WS_WO0T : WS_WO1T))}; pg8::StaticOrder So; So.init(NTOK, D, G, (int)blockIdx.x);
            EpiWo E{(bf16_t*)(ws + WS_Q)};
            pg8::gemm_phase<D, D, EpiWo, pg8::StaticOrder, true, true>(lds, g, So, E);
        }
#endif
        xcd_barrier(bar); STAMP(layer == 0 ? 7 : 15);
#if PH_LNR
        ln_router_phase(lds, a, layer, G);
#endif
        xcd_barrier(bar); STAMP(layer == 0 ? 8 : 16);
#if PH_SCAT
        scatter_phase(lds, a, layer, G);
#endif
        xcd_barrier(bar); STAMP(layer == 0 ? 9 : 17);
        build_tile_table(tstart, ctl + CW_CNT + layer * 32);
#if PH_GU
#if MOE_GATHER
        { const int tid3 = opaque_tid(); __syncthreads(); const int ntl = tstart[32]; const int* rowtok = (const int*)(ws + WS_ROWTOK) + layer * ROWS_PAD;
          LAS unsigned* rtl = (LAS unsigned*)(lds + pg8::AG_RT_OFF);
          for (int idx = tid3; idx < 12 * 256; idx += NTHREADS) { const int L = (idx >> 8) * G + (int)blockIdx.x;
              if (L < ntl * 4) { unsigned tok = (unsigned)rowtok[(L >> 2) * 256 + (idx & 255)] >> 1; tok = tok < (unsigned)NTOK ? tok : 0u; rtl[idx] = tok * (unsigned)(D * 2); } }
          __syncthreads(); }
        { pg8::Gemm g{(const bf16_t*)(ws + WS_HM), (const bf16_t*)(ws + WS_GUT)}; MoeOrder So{tstart, G, (int)blockIdx.x};
          EpiGU E{(bf16_t*)(ws + WS_HH)};
          pg8::gemm_phase<D, D, EpiGU, MoeOrder, true, true, true>(lds, g, So, E); }
#else
        { pg8::Gemm g{(const bf16_t*)(ws + WS_HS), (const bf16_t*)(ws + WS_GUT)}; MoeOrder So{tstart, G, (int)blockIdx.x};
          EpiGU E{(bf16_t*)(ws + WS_HH)};
          pg8::gemm_phase<D, D, EpiGU, MoeOrder, true, true>(lds, g, So, E); }
#endif
#endif
        xcd_barrier(bar); STAMP(layer == 0 ? 10 : 18);
#if PH_DN
        { const int tid3 = opaque_tid(); __syncthreads(); const int ntl = tstart[32];
          const int* rt_ = (const int*)(ws + WS_ROWTOK) + layer * ROWS_PAD; const int* rw_ = (const int*)(ws + WS_ROWW) + layer * ROWS_PAD;
          LAS int* lt = (LAS int*)(lds + pg8::AG_RT_OFF);
          for (int idx = tid3; idx < 6 * 256; idx += NTHREADS) { const int L = (idx >> 8) * G + (int)blockIdx.x;
              if (L < ntl * 4) { const int row = (L >> 2) * 256 + (idx & 255); lt[idx * 2] = rt_[row]; lt[idx * 2 + 1] = rw_[row]; } }
          __syncthreads(); }
        { pg8::Gemm g{(const bf16_t*)(ws + WS_HH), (const bf16_t*)(ws + WS_DNT)}; MoeOrder So{tstart, G, (int)blockIdx.x};
          EpiDown E{(bf16_t*)(ws + WS_Y), (const int*)(ws + WS_ROWTOK) + layer * ROWS_PAD, (const float*)(ws + WS_ROWW) + layer * ROWS_PAD, (const LAS int*)(lds + pg8::AG_RT_OFF)};
          pg8::gemm_phase<FE, FE, EpiDown, MoeOrder, true, true>(lds, g, So, E); }
#endif
        xcd_barrier(bar); STAMP(layer == 0 ? 11 : 19);
#if PH_LNM
        ln_moe_phase(a, layer, G, layer == 0);
#endif
        if (layer == 0) {
            const int tid2 = opaque_tid(), lane = tid2 & 63, wave = tid2 >> 6;
            LAS float* scr = (LAS float*)(lds + wave * 16384);
            const size_t wo = (size_t)NE * D * FE;
            for (int it = blockIdx.x * NWAVES + wave; it < MOE_ITEMS; it += G * NWAVES)
                moe_convert_item(a.moe_wg + wo, a.moe_wu + wo, a.moe_wd + wo, (bf16_t*)(ws + WS_GUT), (bf16_t*)(ws + WS_DNT), scr, it, lane);
            xcd_barrier(bar); STAMP(12);
        }
}

__global__ void __launch_bounds__(NTHREADS, 2) mega_fwd(Args a) {
    extern __shared__ __attribute__((aligned(16))) unsigned char lds_raw[];
    LAS unsigned char* lds = (LAS unsigned char*)lds_raw;
    cg::grid_group grid = cg::this_grid();
    { volatile LAS unsigned* st0 = (volatile LAS unsigned*)(lds + 146432); if (threadIdx.x < 2) st0[threadIdx.x] = 0u; }
    __syncthreads();
    const XcdBarrier bar = xcd_barrier_post((unsigned*)(a.ws + WS_CTL) + CW_BAR, (volatile LAS unsigned*)(lds + 146432));
    const int G = gridDim.x, tid = opaque_tid(), lane = tid & 63, wave = tid >> 6;
    unsigned char* ws = a.ws;
    const float* rope = (const float*)(ws + WS_ROPE);
    const float* mod = (const float*)(ws + WS_MOD);
    unsigned* ctl = (unsigned*)(ws + WS_CTL);
    LAS int* tstart = (LAS int*)(lds + MISC_OFF);

    STAMP(0);
#if PH_PRO
    prologue_phase(lds, a, G);
#endif
    grid.sync(); STAMP(1);
    {
        const int wv = blockIdx.x * NWAVES + wave, NW = G * NWAVES;
        for (int b = 0; b < NB; ++b) {
            f32x4 sh[4], sc1[4];
#pragma unroll
            for (int j = 0; j < 4; ++j) { const int col = 4 * lane + 256 * j; sh[j] = *(const f32x4*)(mod + (size_t)b * 3072 + col); sc1[j] = *(const f32x4*)(mod + (size_t)b * 3072 + D + col) + 1.f; }
            for (int tok0 = b * S + wv; tok0 < (b + 1) * S; tok0 += 4 * NW) {
                f32x4 v[4][4];
#pragma unroll
                for (int u = 0; u < 4; ++u) { const int tok = tok0 + u * NW;
                    if (tok < (b + 1) * S) {
#pragma unroll
                        for (int j = 0; j < 4; ++j) v[u][j] = *(const f32x4*)(a.x + (size_t)tok * D + 4 * lane + 256 * j); } }
#pragma unroll
                for (int u = 0; u < 4; ++u) { const int tok = tok0 + u * NW;
                    if (tok < (b + 1) * S) {
#pragma unroll
                        for (int j = 0; j < 4; ++j) { const f32x4 h4 = v[u][j] * sc1[j] + sh[j];
                            u32x2 o; o.x = pk2(h4.x, h4.y); o.y = pk2(h4.z, h4.w);
                            *(u32x2*)((bf16_t*)(ws + WS_HM) + (size_t)tok * D + 4 * lane + 256 * j) = o; } } }
            }
        }
    }
    xcd_barrier(bar); STAMP(2);

    layer_body<0>(lds, a, bar, G);
#ifdef EXTRA_SYNCS
    for (int i = 0; i < 20; ++i) xcd_barrier(bar);
#endif
    layer_body<1>(lds, a, bar, G);
#if PROBE_A || PROBE_B
    xcd_barrier(bar); STAMP(20);
    if (blockIdx.x == 0 && threadIdx.x == 0) {
        const unsigned long long* ts = (const unsigned long long*)(a.ws + 2048);
#ifdef PROBE_CLK
        if (PROBE_A) { const float us = (float)(ts[PROBE_A] - ts[PROBE_A - 1]) * 0.01f; const float cyc = (float)(ts[32 + PROBE_A] - ts[32 + PROBE_A - 1]); a.out[0] += 4.f + cyc / us * 0.01f; }
#else
        if (PROBE_A) { const float us = (float)(ts[PROBE_A] - ts[PROBE_A - 1]) * 0.01f; a.out[0] += 4.f + (us - (float)PROBE_OFF) / (float)PROBE_DIV; }
#endif
        if (PROBE_B) { const float us = (float)(ts[PROBE_B] - ts[PROBE_B - 1]) * 0.01f; const int n = (int)(us * 0.5f); for (int i = 1; i <= n && i < NTOK; ++i) a.out[(size_t)i * D] += 3.0f; }
    }
#endif
}

extern "C" void kernel_launch(void* const* d_in, const int* in_sizes, int n_in, void* d_out, int out_size, void* d_ws, size_t ws_size, hipStream_t stream) {
    static int grid = 0;
    if (grid == 0) {
        if (n_in != 22 || out_size != NTOK * D || ws_size < WS_END) { fprintf(stderr, "kernel_launch: unexpected shapes (n_in %d, out %d, ws %zu)\n", n_in, out_size, ws_size); grid = -1; return; }
        int dev = 0, cus = 0, per_cu = 0;
        if (hipGetDevice(&dev) != hipSuccess || hipDeviceGetAttribute(&cus, hipDeviceAttributeMultiprocessorCount, dev) != hipSuccess) { grid = -1; return; }
        if (hipFuncSetAttribute((const void*)mega_fwd, hipFuncAttributeMaxDynamicSharedMemorySize, LDS_BYTES) != hipSuccess) { fprintf(stderr, "kernel_launch: hipFuncSetAttribute failed\n"); grid = -1; return; }
        if (hipOccupancyMaxActiveBlocksPerMultiprocessor(&per_cu, (const void*)mega_fwd, NTHREADS, LDS_BYTES) != hipSuccess || per_cu < 1) { fprintf(stderr, "kernel_launch: occupancy query failed (%d)\n", per_cu); grid = -1; return; }
        grid = cus * per_cu;
    }
    if (grid < 0) return;
    (void)hipMemsetAsync((char*)d_ws + WS_CTL, 0, CTL_ZERO_BYTES, stream);
    Args a{};
    a.x = (const float*)d_in[0]; a.c = (const float*)d_in[1]; a.pos = (const int*)d_in[2]; a.ada_w = (const float*)d_in[3]; a.ada_b = (const float*)d_in[4];
    a.ln_g = (const float*)d_in[5]; a.ln_b = (const float*)d_in[6]; a.nsa_w_in = (const float*)d_in[7]; a.cpos_k = (const float*)d_in[8]; a.cw1_k = (const float*)d_in[9];
    a.cw2_k = (const float*)d_in[10]; a.cpos_v = (const float*)d_in[11]; a.cw1_v = (const float*)d_in[12]; a.cw2_v = (const float*)d_in[13]; a.nsa_w_o = (const float*)d_in[14];
    a.dil_w_in = (const float*)d_in[15]; a.dil_w_o = (const float*)d_in[16]; a.router_w = (const float*)d_in[17]; a.router_b = (const float*)d_in[18];
    a.moe_wg = (const float*)d_in[19]; a.moe_wu = (const float*)d_in[20]; a.moe_wd = (const float*)d_in[21];
    a.out = (float*)d_out; a.ws = (unsigned char*)d_ws;
    void* args[] = {&a};
    const hipError_t e = hipLaunchCooperativeKernel((const void*)mega_fwd, dim3(grid), dim3(NTHREADS), args, LDS_BYTES, stream);
    if (e != hipSuccess) fprintf(stderr, "kernel_launch: cooperative launch failed: %s (grid %d)\n", hipGetErrorString(e), grid);
}
```
